# Optimizing an MI355X kernel written in HIP

```python
import jax, jax.numpy as jnp
from jax import lax
import numpy as np

D_MODEL = 1024
BATCH = 8
SEQ = 8192
DEPTH = 1

CHUNK = 64
EPS = 1e-6

MLA_HEADS = D_MODEL // 128
MLA_NOPE = 64
MLA_ROPE = 32
MLA_V = 64
Q_LORA = D_MODEL // 4
KV_LORA = D_MODEL // 8
ROPE_THETA = 10000.0
Q_BLOCK = 128

CA_HEADS = D_MODEL // 128
CA_DIM = 64
CA_LEFT = 8
CA_BAND = (CA_LEFT + 1) * CHUNK
REL_MAX = 256
REL_SIZE = CHUNK + REL_MAX

MIX_WIDTH = MLA_HEADS * MLA_V + CA_HEADS * CA_DIM
IN_WIDTH = Q_LORA + KV_LORA + MLA_ROPE + 3 * CA_HEADS * CA_DIM

N_EXPERTS = 32
TOP_K = 4
D_EXPERT = D_MODEL
SWIGLU_LIMIT = 7.0
SWIGLU_ALPHA = 1.702
ROW_BLOCK = 256

kernel_name = 'hybrid_mla_chunkattn_moe'


def _rmsnorm(x, g):
    xf = x.astype(jnp.float32)
    y = xf * lax.rsqrt(jnp.mean(xf * xf, axis=-1, keepdims=True) + EPS)
    return (y * g.astype(jnp.float32)).astype(x.dtype)


def _rope(x, cos, sin):
    xf = x.astype(jnp.float32)
    x1, x2 = jnp.split(xf, 2, axis=-1)
    return jnp.concatenate([x1 * cos - x2 * sin, x2 * cos + x1 * sin], axis=-1).astype(x.dtype)


def _mla_attention(q_nope, q_rope, k_nope, k_rope, v):
    bsz, seq, heads, _ = q_nope.shape
    nq = seq // Q_BLOCK
    qn = q_nope.reshape(bsz, nq, Q_BLOCK, heads, MLA_NOPE).transpose(1, 0, 2, 3, 4)
    qr = q_rope.reshape(bsz, nq, Q_BLOCK, heads, MLA_ROPE).transpose(1, 0, 2, 3, 4)
    k_chunk = jnp.arange(seq) // CHUNK
    scale = (MLA_NOPE + MLA_ROPE) ** -0.5

    def block(args):
        qn_b, qr_b, bi = args
        s = (jnp.einsum('bqhd,bkhd->bhqk', qn_b, k_nope)
             + jnp.einsum('bqhr,bkr->bhqk', qr_b, k_rope)).astype(jnp.float32) * scale
        q_chunk = (bi * Q_BLOCK + jnp.arange(Q_BLOCK)) // CHUNK
        mask = k_chunk[None, :] <= q_chunk[:, None]
        s = jnp.where(mask, s, -1e30)
        p = jax.nn.softmax(s, axis=-1).astype(v.dtype)
        return jnp.einsum('bhqk,bkhd->bqhd', p, v)

    o = lax.map(block, (qn, qr, jnp.arange(nq)))
    return o.transpose(1, 0, 2, 3, 4).reshape(bsz, seq, heads * MLA_V)


def _chunk_attention(q, k, v, rel_bias):
    bsz, seq, heads, dh = q.shape
    nc = seq // CHUNK
    qi = jnp.arange(CHUNK)[:, None]
    kk = jnp.arange(CA_BAND)[None, :]
    rel = qi - kk % CHUNK + (CA_LEFT - kk // CHUNK) * CHUNK
    idx = jnp.clip(rel, -(CHUNK - 1), REL_MAX) + (CHUNK - 1)
    bias = rel_bias.astype(jnp.float32)[:, idx]
    chunk_valid = (jnp.arange(nc)[:, None] - CA_LEFT + jnp.arange(CA_LEFT + 1)[None, :]) >= 0
    key_valid = jnp.repeat(chunk_valid, CHUNK, axis=1)
    scale = dh ** -0.5

    def per_seq(args):
        qs, ks, vs = args
        qc = qs.reshape(nc, CHUNK, heads, dh)
        pad = jnp.zeros((CA_LEFT * CHUNK, heads, dh), ks.dtype)
        kp = jnp.concatenate([pad, ks], axis=0).reshape(nc + CA_LEFT, CHUNK, heads, dh)
        vp = jnp.concatenate([pad, vs], axis=0).reshape(nc + CA_LEFT, CHUNK, heads, dh)
        kb = jnp.stack([kp[j:j + nc] for j in range(CA_LEFT + 1)], axis=1).reshape(nc, CA_BAND, heads, dh)
        vb = jnp.stack([vp[j:j + nc] for j in range(CA_LEFT + 1)], axis=1).reshape(nc, CA_BAND, heads, dh)
        s = jnp.einsum('cqhd,ckhd->chqk', qc, kb).astype(jnp.float32) * scale + bias[None]
        s = jnp.where(key_valid[:, None, None, :], s, -1e30)
        p = jax.nn.softmax(s, axis=-1).astype(vs.dtype)
        o = jnp.einsum('chqk,ckhd->cqhd', p, vb)
        return o.reshape(seq, heads * dh)

    return lax.map(per_seq, (q, k, v))


def _moe(h, w_router, b_router, w_gu, b_gu, w_down, b_down):
    bsz, seq, d = h.shape
    t = bsz * seq
    xt = h.reshape(t, d)
    logits = (xt @ w_router + b_router).astype(jnp.float32)
    top_val, top_idx = lax.top_k(logits, TOP_K)
    gates = jax.nn.softmax(top_val, axis=-1)
    m = t * TOP_K
    e = top_idx.reshape(m).astype(jnp.int32)
    tok = jnp.repeat(jnp.arange(t, dtype=jnp.int32), TOP_K)
    g = gates.reshape(m)
    order = jnp.argsort(e, stable=True)
    e_s, tok_s, g_s = e[order], tok[order], g[order]
    counts = jax.ops.segment_sum(jnp.ones((m,), jnp.int32), e, num_segments=N_EXPERTS)
    padded = ((counts + ROW_BLOCK - 1) // ROW_BLOCK) * ROW_BLOCK
    start = jnp.cumsum(counts) - counts
    pend = jnp.cumsum(padded)
    pstart = pend - padded
    dest = pstart[e_s] + jnp.arange(m, dtype=jnp.int32) - start[e_s]
    p_rows = m + N_EXPERTS * ROW_BLOCK
    nb = p_rows // ROW_BLOCK
    row_tok = jnp.full((p_rows,), t, jnp.int32).at[dest].set(tok_s)
    row_gate = jnp.zeros((p_rows,), g_s.dtype).at[dest].set(g_s)
    block_exp = jnp.minimum(jnp.searchsorted(pend, jnp.arange(nb, dtype=jnp.int32) * ROW_BLOCK, side='right'),
                            N_EXPERTS - 1)
    x_pad = jnp.concatenate([xt, jnp.zeros((1, d), xt.dtype)], axis=0)
    xin = x_pad[row_tok].reshape(nb, ROW_BLOCK, d)

    def expert_block(args):
        xb, eb = args
        gu = xb @ w_gu[eb] + b_gu[eb]
        gate = jnp.minimum(gu[:, :D_EXPERT], SWIGLU_LIMIT)
        up = jnp.clip(gu[:, D_EXPERT:], -SWIGLU_LIMIT, SWIGLU_LIMIT)
        glu = gate * jax.nn.sigmoid(gate * SWIGLU_ALPHA)
        return ((up + 1) * glu) @ w_down[eb] + b_down[eb]

    y = lax.map(expert_block, (xin, block_exp)).reshape(p_rows, d)
    y = y * row_gate[:, None].astype(y.dtype)
    out = jax.ops.segment_sum(y, row_tok, num_segments=t + 1)[:t]
    return out.reshape(bsz, seq, d)


def setup_inputs(seed: int = 0) -> dict:
    key = jax.random.key(seed)
    ks = jax.random.split(key, 24)
    L, D, E, F = DEPTH, D_MODEL, N_EXPERTS, D_EXPERT
    nrm = lambda k, shape, s: jax.random.normal(k, shape, jnp.float32) * s
    gain = lambda k, shape: 1.0 + 0.02 * jax.random.normal(k, shape, jnp.float32)
    return {
        'x': nrm(ks[0], (BATCH, SEQ, D), 1.0),
        'c': nrm(ks[1], (BATCH, D), 1.0),
        'w_ada': nrm(ks[2], (L, D, 6 * D), D ** -0.5),
        'b_ada': nrm(ks[3], (L, 6 * D), 0.02),
        'g_pre_mix': gain(ks[4], (L, D)),
        'g_post_mix': gain(ks[5], (L, D)),
        'g_pre_ffn': gain(ks[6], (L, D)),
        'g_post_ffn': gain(ks[7], (L, D)),
        'w_in': nrm(ks[8], (L, D, IN_WIDTH), D ** -0.5),
        'g_q': gain(ks[9], (L, Q_LORA)),
        'w_qb': nrm(ks[10], (L, Q_LORA, MLA_HEADS * (MLA_NOPE + MLA_ROPE)), Q_LORA ** -0.5),
        'g_kv': gain(ks[11], (L, KV_LORA)),
        'w_kvb': nrm(ks[12], (L, KV_LORA, MLA_HEADS * (MLA_NOPE + MLA_V)), KV_LORA ** -0.5),
        'rel_bias': nrm(ks[13], (L, CA_HEADS, REL_SIZE), 0.5),
        'w_o': nrm(ks[14], (L, MIX_WIDTH, D), MIX_WIDTH ** -0.5),
        'w_router': nrm(ks[15], (L, D, E), D ** -0.5),
        'b_router': nrm(ks[16], (L, E), 0.01),
        'w_gu': nrm(ks[17], (L, E, D, 2 * F), D ** -0.5),
        'b_gu': nrm(ks[18], (L, E, 2 * F), 0.02),
        'w_down': nrm(ks[19], (L, E, F, D), F ** -0.5),
        'b_down': nrm(ks[20], (L, E, D), 0.02),
    }


def reference(x, c, w_ada, b_ada, g_pre_mix, g_post_mix, g_pre_ffn, g_post_ffn, w_in, g_q, w_qb,
              g_kv, w_kvb, rel_bias, w_o, w_router, b_router, w_gu, b_gu, w_down, b_down):
    bsz, seq, _ = x.shape
    half = MLA_ROPE // 2
    inv_freq = ROPE_THETA ** (-jnp.arange(half, dtype=jnp.float32) / half)
    ang = jnp.arange(seq, dtype=jnp.float32)[:, None] * inv_freq[None, :]
    cos, sin = jnp.cos(ang), jnp.sin(ang)
    cut = np.cumsum([Q_LORA, KV_LORA, MLA_ROPE, CA_HEADS * CA_DIM, CA_HEADS * CA_DIM]).tolist()
    ca_shape = (bsz, seq, CA_HEADS, CA_DIM)
    for l in range(DEPTH):
        mod = jax.nn.silu(c) @ w_ada[l] + b_ada[l]
        sh1, sc1, gt1, sh2, sc2, gt2 = jnp.split(mod, 6, axis=-1)
        h = _rmsnorm(x, g_pre_mix[l]) * (1 + sc1[:, None, :]) + sh1[:, None, :]
        z = h @ w_in[l]
        cq, ckv, kr, qc, kc, vc = jnp.split(z, cut, axis=-1)
        q = (_rmsnorm(cq, g_q[l]) @ w_qb[l]).reshape(bsz, seq, MLA_HEADS, MLA_NOPE + MLA_ROPE)
        q_nope = q[..., :MLA_NOPE]
        q_rope = _rope(q[..., MLA_NOPE:], cos[:, None, :], sin[:, None, :])
        kv = (_rmsnorm(ckv, g_kv[l]) @ w_kvb[l]).reshape(bsz, seq, MLA_HEADS, MLA_NOPE + MLA_V)
        k_nope, v_mla = kv[..., :MLA_NOPE], kv[..., MLA_NOPE:]
        k_rope = _rope(kr, cos, sin)
        o_a = _mla_attention(q_nope, q_rope, k_nope, k_rope, v_mla)
        o_b = _chunk_attention(qc.reshape(ca_shape), kc.reshape(ca_shape), vc.reshape(ca_shape), rel_bias[l])
        o = jnp.concatenate([o_a, o_b], axis=-1) @ w_o[l]
        x = x + gt1[:, None, :] * _rmsnorm(o, g_post_mix[l])
        h = _rmsnorm(x, g_pre_ffn[l]) * (1 + sc2[:, None, :]) + sh2[:, None, :]
        f = _moe(h, w_router[l], b_router[l], w_gu[l], b_gu[l], w_down[l], b_down[l])
        x = x + gt2[:, None, :] * _rmsnorm(f, g_post_ffn[l])
    return x
```

```cpp
#include <hip/hip_runtime.h>
#include <cstdio>
#include <cstdint>

#ifndef MK_DEBUG
#define MK_DEBUG 0
#endif
#ifndef MK_ONE_LAUNCH
#define MK_ONE_LAUNCH 1
#endif

#define GAS __attribute__((address_space(1)))
#define LAS __attribute__((address_space(3)))
typedef unsigned short bf16;
typedef short bf16x8 __attribute__((ext_vector_type(8)));
typedef short s16x4 __attribute__((ext_vector_type(4)));
typedef float f32x4 __attribute__((ext_vector_type(4)));
typedef float f32x2 __attribute__((ext_vector_type(2)));
typedef float f32x16 __attribute__((ext_vector_type(16)));
typedef unsigned u32x4 __attribute__((ext_vector_type(4)));
typedef unsigned u32x2 __attribute__((ext_vector_type(2)));
typedef __bf16 bf16x2_t __attribute__((ext_vector_type(2)));

constexpr int NB = 8, SEQ = 8192, DM = 1024, T = NB * SEQ;
constexpr int NIN = 2048, IN_W = 1952;
constexpr int C_CKV = 256, C_KR = 384, C_QC = 416, C_KC = 928, C_VC = 1440;
constexpr int NE = 32;
constexpr int KQKV = 384, NQKV = 1792;
constexpr float EPS = 1e-6f;
constexpr float LOG2E = 1.4426950408889634f;
constexpr float C2M = 0.10206207261596577f * 1.4426950408889634f;
constexpr float C2C = 0.125f * 1.4426950408889634f;
constexpr int MODW = 6 * DM;

constexpr size_t MiB = 1u << 20;
constexpr size_t WS_CTL = 0, CTL_ZERO_BYTES = 1 * MiB;
constexpr size_t WS_MOD = 1 * MiB;
constexpr size_t WS_WRT = 1 * MiB + 256 * 1024;
constexpr size_t WS_GATE = 2 * MiB;
constexpr size_t WS_ROPE = 3 * MiB;
constexpr size_t WS_WQKV = 4 * MiB;
constexpr size_t WS_TINFO = 6 * MiB;
constexpr size_t WS_LIST = 8 * MiB;
constexpr size_t WS_WIN = 24 * MiB;
constexpr size_t WS_WO = 28 * MiB;
constexpr size_t WS_DBG = 30 * MiB;
constexpr size_t WS_WDN = 40 * MiB;
constexpr size_t WS_WGU = 104 * MiB;
constexpr size_t WS_H = 232 * MiB;
constexpr size_t WS_YB = 104 * MiB;
constexpr size_t WS_Z = 360 * MiB;
constexpr size_t WS_QM = 616 * MiB;
constexpr size_t WS_KM = 712 * MiB;
constexpr size_t WS_VM = 808 * MiB;
constexpr size_t WS_O = 872 * MiB;
constexpr size_t WS_OP = 360 * MiB;
constexpr size_t WS_ACT = 360 * MiB;
constexpr size_t WS_YA = 632 * MiB;
constexpr size_t WS_END = 1024 * MiB;
constexpr int LIST_CAP = 65536;

constexpr int CW_TMO = 0, CW_CODE = 1;
constexpr int CW_BAR = 4096;
constexpr int CW_CNT = 8192;
constexpr int CW_DIAG = 8320;

constexpr int LDS_BYTES = 147456;
constexpr int MISC_OFF = LDS_BYTES - 256;
constexpr int TAB_OFF = 139264;

__device__ __forceinline__ unsigned f2bf(float f) { unsigned u = __builtin_bit_cast(unsigned, f); return (u + 0x7fffu + ((u >> 16) & 1u)) >> 16; }
__device__ __forceinline__ float bf2f(unsigned b) { return __builtin_bit_cast(float, (b & 0xffffu) << 16); }
__device__ __forceinline__ unsigned pk2(float lo, float hi) { f32x2 v = {lo, hi}; bf16x2_t b = __builtin_convertvector(v, bf16x2_t); return __builtin_bit_cast(unsigned, b); }
__device__ __forceinline__ float wave_sum(float v) {
#pragma unroll
    for (int o = 1; o < 64; o <<= 1) v += __shfl_xor(v, o);
    return v;
}
#define LDS_WAIT() asm volatile("s_waitcnt lgkmcnt(0)" ::: "memory")
#define VM_WAIT() asm volatile("s_waitcnt vmcnt(0)" ::: "memory")

namespace pg8 {
typedef unsigned short bf16_t;
constexpr int BM = 256, BK = 64, HALF = 128, HTB = HALF * BK * 2, STAGE_BYTES = 8 * HTB;
__host__ __device__ __forceinline__ int lds_byte(int r, int c) { const int st = (r >> 4) * 2 + (c >> 5), rr = r & 15, cc = c & 31, ob = rr * 64 + cc * 2; return st * 1024 + (ob ^ (((ob >> 9) & 1) << 5)); }
__host__ __device__ __forceinline__ void stage_rc(int b, int& R, int& C) { const int st = b / 1024, sb = b % 1024, swz = sb ^ (((sb >> 9) & 1) << 5); R = (st >> 1) * 16 + swz / 64; C = (st & 1) * 32 + (swz % 64) / 2; }
__host__ __device__ __forceinline__ int perm32(int rho) { const int n = rho >> 4, i = rho & 15; return 8 * (i >> 2) + 4 * n + (i & 3); }

struct Unit { int pm, pn, brow, e, nvalid, orow; };
struct Gemm { const bf16_t* A; const bf16_t* Bt; int K; };

template <class Epi, class Sched, bool ALIGN_EPI>
__device__ __forceinline__ void gemm_phase(LAS unsigned char* lds, const Gemm g, const Sched& S, const Epi& E) {
    const int tid = threadIdx.x, wid = __builtin_amdgcn_readfirstlane(tid >> 6), lane = tid & 63, wr = wid >> 2, wc = wid & 3, fr = lane & 15, fq = lane >> 4;
    const int K = g.K, nt = K / BK;
    int RA[2]; unsigned CA2[2], voffB[2];
#pragma unroll
    for (int i = 0; i < 2; ++i) { int R, C; stage_rc(tid * 16 + i * 8192, R, C); const int Rb = (R & ~31) + perm32(R & 31);
        RA[i] = R; CA2[i] = (unsigned)C * 2u; voffB[i] = (unsigned)(Rb * K + C) * 2u; }
    const size_t kstep = (size_t)(BK * 2);
    const size_t hstep = (size_t)HALF * K * 2;
    const unsigned ldsw = (unsigned)wid * 1024u;
    const int aoff = lds_byte(wr * 64 + fr, fq * 8), boff = lds_byte(wc * 32 + fr, fq * 8);
#define PG8_SA(b, h) (((b) * 2 + (h)) * HTB)
#define PG8_SB(b, h) ((4 + (b) * 2 + (h)) * HTB)
#define PG8_STAGE(bufoff, gbase, voff) do { _Pragma("unroll") for (int _i = 0; _i < 2; ++_i) \
        __builtin_amdgcn_global_load_lds((const unsigned*)((const char*)(gbase) + (voff)[_i]), (LAS unsigned*)(lds + (bufoff) + ldsw + _i * 8192), 16, 0, 0); } while (0)
#define PG8_LDA(dst, b, h) do { _Pragma("unroll") for (int m = 0; m < 4; ++m) _Pragma("unroll") for (int k = 0; k < 2; ++k) dst[m][k] = *(const LAS bf16x8*)(lds + PG8_SA(b, h) + aoff + m * 2048 + k * 1024); } while (0)
#define PG8_LDB(dst, b, h) do { _Pragma("unroll") for (int n = 0; n < 2; ++n) _Pragma("unroll") for (int k = 0; k < 2; ++k) dst[n][k] = *(const LAS bf16x8*)(lds + PG8_SB(b, h) + boff + n * 2048 + k * 1024); } while (0)
#define PG8_MMA(ai, bj, At, Bt) do { __builtin_amdgcn_s_setprio(1); _Pragma("unroll") for (int m = 0; m < 4; ++m) _Pragma("unroll") for (int n = 0; n < 2; ++n) _Pragma("unroll") for (int k = 0; k < 2; ++k) \
        acc[ai][bj][m][n] = __builtin_amdgcn_mfma_f32_16x16x32_bf16(Bt[n][k], At[m][k], acc[ai][bj][m][n], 0, 0, 0); __builtin_amdgcn_s_setprio(0); } while (0)
#define PG8_WAIT_V(n) asm volatile("s_waitcnt vmcnt(" #n ")" ::: "memory")
#define PG8_WAIT_L(n) asm volatile("s_waitcnt lgkmcnt(" #n ")" ::: "memory")
#define PG8_BAR __builtin_amdgcn_s_barrier()
#define PG8_SCHED __builtin_amdgcn_sched_barrier(0)
#define PG8_OFFS(dst, u) do { _Pragma("unroll") for (int _h = 0; _h < 2; ++_h) _Pragma("unroll") for (int _i = 0; _i < 2; ++_i) dst[_h][_i] = S.arow_off(u, _h * HALF + RA[_i]) + CA2[_i]; } while (0)
    Unit cur, nxt; int ui = 0;
    if (!S.next(0, cur)) return;
    bool has_next = S.next(1, nxt);
    unsigned cvo[2][2], nvo[2][2];
    PG8_OFFS(cvo, cur);
    if (has_next) PG8_OFFS(nvo, nxt); else { nvo[0][0] = cvo[0][0]; nvo[0][1] = cvo[0][1]; nvo[1][0] = cvo[1][0]; nvo[1][1] = cvo[1][1]; }
    f32x4 acc[2][2][4][2];
#pragma unroll
    for (int a = 0; a < 2; ++a)
#pragma unroll
        for (int b = 0; b < 2; ++b)
#pragma unroll
            for (int m = 0; m < 4; ++m)
#pragma unroll
                for (int n = 0; n < 2; ++n) acc[a][b][m][n] = (f32x4){0.f, 0.f, 0.f, 0.f};
    bf16x8 At[4][2], B0[2][2], B1[2][2];
    const char* const Ab = (const char*)g.A;
    const char* cB = (const char*)g.Bt + (size_t)cur.brow * K * 2;
    VM_WAIT();
    PG8_STAGE(PG8_SB(0, 0), cB, voffB); PG8_STAGE(PG8_SB(0, 1), cB + hstep, voffB); PG8_STAGE(PG8_SA(0, 0), Ab, cvo[0]); PG8_STAGE(PG8_SA(0, 1), Ab, cvo[1]);
    if (wr == 1) PG8_BAR;
    PG8_WAIT_V(2); PG8_BAR;
    PG8_STAGE(PG8_SB(1, 0), cB + kstep, voffB); PG8_STAGE(PG8_SA(1, 0), Ab + kstep, cvo[0]); PG8_STAGE(PG8_SB(1, 1), cB + hstep + kstep, voffB);
    PG8_WAIT_V(6); PG8_BAR;
    for (;;) {
        const char* nB = has_next ? (const char*)g.Bt + (size_t)nxt.brow * K * 2 : cB;
#pragma unroll 1
        for (int t = 0; t < nt; t += 2) {
            const bool last = (t == nt - 2);
            const char* a1 = Ab + (size_t)(t + 1) * kstep;
            const char* a2 = last ? Ab : Ab + (size_t)(t + 2) * kstep; const char* b2 = last ? nB : cB + (size_t)(t + 2) * kstep;
            const char* a3 = a2 + kstep; const char* b3 = b2 + kstep;
            unsigned vo2[2][2];
#pragma unroll
            for (int _h = 0; _h < 2; ++_h)
#pragma unroll
                for (int _i = 0; _i < 2; ++_i) vo2[_h][_i] = last ? nvo[_h][_i] : cvo[_h][_i];
            PG8_LDB(B0, 0, 0); PG8_LDB(B1, 0, 1); PG8_SCHED; PG8_LDA(At, 0, 0); PG8_STAGE(PG8_SA(1, 1), a1, cvo[1]);
            PG8_WAIT_V(8); PG8_WAIT_L(0); PG8_BAR; PG8_MMA(0, 0, At, B0); PG8_MMA(0, 1, At, B1); PG8_BAR; PG8_SCHED;
            PG8_LDA(At, 0, 1); PG8_STAGE(PG8_SB(0, 0), b2, voffB); PG8_STAGE(PG8_SB(0, 1), b2 + hstep, voffB); PG8_STAGE(PG8_SA(0, 0), a2, vo2[0]);
            PG8_WAIT_V(8); PG8_WAIT_L(0); PG8_BAR; PG8_MMA(1, 0, At, B0); PG8_MMA(1, 1, At, B1); PG8_BAR; PG8_SCHED;
            PG8_LDB(B0, 1, 0); PG8_LDB(B1, 1, 1); PG8_SCHED; PG8_LDA(At, 1, 0); PG8_STAGE(PG8_SA(0, 1), a2, vo2[1]);
            PG8_WAIT_V(8); PG8_WAIT_L(0); PG8_BAR; PG8_MMA(0, 0, At, B0); PG8_MMA(0, 1, At, B1); PG8_BAR; PG8_SCHED;
            PG8_LDA(At, 1, 1); PG8_STAGE(PG8_SB(1, 0), b3, voffB); PG8_STAGE(PG8_SB(1, 1), b3 + hstep, voffB); PG8_STAGE(PG8_SA(1, 0), a3, vo2[0]);
            PG8_WAIT_V(8); PG8_WAIT_L(0); PG8_BAR; PG8_MMA(1, 0, At, B0); PG8_MMA(1, 1, At, B1); PG8_BAR; PG8_SCHED;
        }
        if constexpr (ALIGN_EPI) { if (wr == 0) PG8_BAR; }
        E(acc, cur, wr, wc, fr, fq);
        if (!has_next) break;
#pragma unroll
        for (int a = 0; a < 2; ++a)
#pragma unroll
            for (int b = 0; b < 2; ++b)
#pragma unroll
                for (int m = 0; m < 4; ++m)
#pragma unroll
                    for (int n = 0; n < 2; ++n) acc[a][b][m][n] = (f32x4){0.f, 0.f, 0.f, 0.f};
        cur = nxt; cB = nB; ++ui;
#pragma unroll
        for (int _h = 0; _h < 2; ++_h)
#pragma unroll
            for (int _i = 0; _i < 2; ++_i) cvo[_h][_i] = nvo[_h][_i];
        has_next = S.next(ui + 1, nxt);
        if (has_next) PG8_OFFS(nvo, nxt);
        if constexpr (ALIGN_EPI) { if (wr == 1) PG8_BAR; }
    }
    PG8_WAIT_V(0);
    if constexpr (!ALIGN_EPI) { if (wr == 0) PG8_BAR; }
    PG8_BAR;
#undef PG8_SA
#undef PG8_SB
#undef PG8_STAGE
#undef PG8_LDA
#undef PG8_LDB
#undef PG8_MMA
#undef PG8_WAIT_V
#undef PG8_WAIT_L
#undef PG8_BAR
#undef PG8_SCHED
#undef PG8_OFFS
}

struct DenseSched {
    int nN, nwg, G, c, K2;
    __device__ __forceinline__ bool next(int i, Unit& u) const {
        const int L = i * G + c; if (L >= nwg) return false;
        const int nig = 8 * nN, gid = L / nig, r = L % nig;
        u.pm = gid * 8 + (r & 7); u.pn = r >> 3; u.brow = u.pn * BM; u.e = 0; u.nvalid = BM; u.orow = u.pm * BM; return true;
    }
    __device__ __forceinline__ unsigned arow_off(const Unit& u, int r) const { return (unsigned)(u.pm * BM + r) * (unsigned)K2; }
};
struct MoeSched {
    const LAS int* tstart;
    const LAS int* cnt;
    const unsigned* list;
    int NT, G, c, nexp_rows;
    __device__ __forceinline__ bool next(int i, Unit& u) const {
        const int L = i * G + c; const int total = tstart[32] * NT; if (L >= total) return false;
        const int rt = L / NT, pn = L % NT;
        int e = 0;
#pragma unroll
        for (int st = 16; st; st >>= 1) if (tstart[e + st] <= rt) e += st;
        e = __builtin_amdgcn_readfirstlane(e);
        u.e = e; u.pm = rt - tstart[e]; u.pn = pn; u.nvalid = cnt[e] - u.pm * BM; u.orow = rt * BM; u.brow = e * nexp_rows + pn * BM; return true;
    }
    __device__ __forceinline__ unsigned arow_off(const Unit& u, int r) const {
        if (list) { int idx = u.pm * BM + r; const int c1 = cnt[u.e] - 1; idx = idx < c1 ? idx : c1; const unsigned ent = list[(size_t)u.e * LIST_CAP + idx]; return (ent >> 1) * 2048u; }
        return (unsigned)(u.orow + r) * 2048u;
    }
};

struct EpiPlain {
    bf16_t* O; int ldc;
    __device__ __forceinline__ void operator()(const f32x4 (&acc)[2][2][4][2], const Unit& u, int wr, int wc, int fr, int fq) const {
        const int row0 = u.orow + wr * 64 + fr, col0 = u.pn * BM + wc * 32 + 8 * fq;
#pragma unroll
        for (int ai = 0; ai < 2; ++ai)
#pragma unroll
            for (int m = 0; m < 4; ++m) { bf16_t* rowp = O + (size_t)(row0 + ai * HALF + m * 16) * ldc + col0;
#pragma unroll
                for (int bj = 0; bj < 2; ++bj) { const f32x4 v0 = acc[ai][bj][m][0], v1 = acc[ai][bj][m][1];
                    u32x4 w; w.x = pk2(v0[0], v0[1]); w.y = pk2(v0[2], v0[3]); w.z = pk2(v1[0], v1[1]); w.w = pk2(v1[2], v1[3]);
                    *(u32x4*)(rowp + bj * HALF) = w; } }
    }
};
struct EpiQKV {
    bf16_t* Qm; unsigned char* Km; unsigned char* Vm; const f32x2* rope;
    __device__ __forceinline__ void operator()(const f32x4 (&acc)[2][2][4][2], const Unit& u, int wr, int wc, int fr, int fq) const {
#pragma unroll
        for (int bj = 0; bj < 2; ++bj) {
            const int cb = u.pn * BM + bj * HALF + wc * 32;
            const int c0 = cb + 8 * fq;
#pragma unroll
            for (int ai = 0; ai < 2; ++ai)
#pragma unroll
                for (int m = 0; m < 4; ++m) {
                    int row = u.orow + ai * HALF + wr * 64 + m * 16 + fr;
                    asm volatile("" : "+v"(row) :: "memory");
                    const int b = row >> 13, s = row & (SEQ - 1);
                    f32x4 v0 = acc[ai][bj][m][0], v1 = acc[ai][bj][m][1];
                    if (cb < 768) {
                        const int h = cb / 96, d = c0 - h * 96;
                        v0 = v0 * C2M; v1 = v1 * C2M;
                        if (d >= 64) { const int gq = (d - 64) >> 3; const f32x2* rp = rope + s * 16 + 4 * gq;
                            const f32x2 t0 = rp[0], t1 = rp[1], t2 = rp[2], t3 = rp[3];
                            const f32x4 cs = {t0.x, t1.x, t2.x, t3.x}, sn = {t0.y, t1.y, t2.y, t3.y};
                            const f32x4 o0 = v0 * cs - v1 * sn, o1 = v1 * cs + v0 * sn; v0 = o0; v1 = o1; }
                        u32x4 w; w.x = pk2(v0[0], v0[1]); w.y = pk2(v0[2], v0[3]); w.z = pk2(v1[0], v1[1]); w.w = pk2(v1[2], v1[3]);
                        *(u32x4*)(Qm + ((size_t)(b * 8 + h) * SEQ + s) * 96 + d) = w;
                    } else {
                        const int cc = c0 - 768, h = cc >> 7, dd = cc & 127;
                        u32x4 w; w.x = pk2(v0[0], v0[1]); w.y = pk2(v0[2], v0[3]); w.z = pk2(v1[0], v1[1]); w.w = pk2(v1[2], v1[3]);
                        const size_t tile = (size_t)(b * 8 + h) * 128 + (s >> 6);
                        if (dd < 64) *(u32x4*)(Km + tile * 12288 + (dd >> 3) * 1024 + (s & 63) * 16) = w;
                        else { const int d = dd - 64; *(u32x4*)(Vm + tile * 8192 + (d >> 5) * 4096 + ((s & 63) >> 4) * 1024 + (s & 15) * 64 + (d & 31) * 2) = w; }
                    }
                }
        }
    }
};
struct EpiGU {
    bf16_t* act; const float* bgu;
    __device__ __forceinline__ void operator()(const f32x4 (&acc)[2][2][4][2], const Unit& u, int wr, int wc, int fr, int fq) const {
        const int cl = u.pn * 128 + wc * 32 + 8 * fq;
        const float* bg = bgu + (size_t)u.e * 2048 + cl; const float* bu = bg + 1024;
        const f32x4 bg0 = *(const f32x4*)bg, bg1 = *(const f32x4*)(bg + 4), bu0 = *(const f32x4*)bu, bu1 = *(const f32x4*)(bu + 4);
#pragma unroll
        for (int ai = 0; ai < 2; ++ai)
#pragma unroll
            for (int m = 0; m < 4; ++m) {
                const int row = u.orow + ai * HALF + wr * 64 + m * 16 + fr;
                float r8[8];
#pragma unroll
                for (int n = 0; n < 2; ++n)
#pragma unroll
                    for (int j = 0; j < 4; ++j) {
                        float gt = acc[ai][0][m][n][j] + (n ? bg1[j] : bg0[j]); float up = acc[ai][1][m][n][j] + (n ? bu1[j] : bu0[j]);
                        gt = fminf(gt, 7.f); up = fminf(fmaxf(up, -7.f), 7.f);
                        const float sg = __builtin_amdgcn_rcpf(1.f + __builtin_amdgcn_exp2f(gt * (-1.702f * LOG2E)));
                        r8[n * 4 + j] = (up + 1.f) * (gt * sg);
                    }
                u32x4 w; w.x = pk2(r8[0], r8[1]); w.y = pk2(r8[2], r8[3]); w.z = pk2(r8[4], r8[5]); w.w = pk2(r8[6], r8[7]);
                *(u32x4*)(act + (size_t)row * 1024 + cl) = w;
            }
    }
};
struct EpiDN {
    bf16_t* y; const float* bdn; const unsigned* list;
    __device__ __forceinline__ void operator()(const f32x4 (&acc)[2][2][4][2], const Unit& u, int wr, int wc, int fr, int fq) const {
        const int col0 = u.pn * BM + wc * 32 + 8 * fq;
        const float* bp = bdn + (size_t)u.e * 1024 + col0;
        f32x4 bv[2][2];
#pragma unroll
        for (int bj = 0; bj < 2; ++bj) { bv[bj][0] = *(const f32x4*)(bp + bj * HALF); bv[bj][1] = *(const f32x4*)(bp + bj * HALF + 4); }
#pragma unroll
        for (int ai = 0; ai < 2; ++ai)
#pragma unroll
            for (int m = 0; m < 4; ++m) {
                const int r = ai * HALF + wr * 64 + m * 16 + fr;
                if (r < u.nvalid) {
                    const unsigned ent = list[(size_t)u.e * LIST_CAP + u.pm * BM + r];
                    bf16_t* rowp = y + (size_t)ent * 1024 + col0;
#pragma unroll
                    for (int bj = 0; bj < 2; ++bj) { const f32x4 v0 = acc[ai][bj][m][0] + bv[bj][0], v1 = acc[ai][bj][m][1] + bv[bj][1];
                        u32x4 w; w.x = pk2(v0[0], v0[1]); w.y = pk2(v0[2], v0[3]); w.z = pk2(v1[0], v1[1]); w.w = pk2(v1[2], v1[3]);
                        *(u32x4*)(rowp + bj * HALF) = w; }
                }
            }
    }
};
}

namespace att {
constexpr int LK = 0, KSL = 12288, LV = 3 * KSL, VSL = 8192, LWS = LV + 3 * VSL, LOST = LWS + 8 * 256, LBT = LOST + 8 * 4096, LEND = LBT + 320 * 4;
constexpr float THR = 8.f;
__device__ __forceinline__ int crow(int r, int hi) { return (r & 3) + 8 * (r >> 2) + 4 * hi; }
__device__ __forceinline__ void glds16(const void* gsrc, unsigned lds_dst) { unsigned keep;
    asm volatile("s_mov_b32 %0, m0\n\ts_mov_b32 m0, %2\n\ts_nop 0\n\tglobal_load_lds_dwordx4 %1, off\n\ts_mov_b32 m0, %0" : "=&s"(keep) : "v"(gsrc), "s"(lds_dst) : "memory"); }
#define ATT_WAITBAR(N) asm volatile("s_waitcnt vmcnt(" #N ") lgkmcnt(0)\n\ts_barrier" ::: "memory")
__device__ __forceinline__ float rowmax(const f32x16& p0, const f32x16& p1) {
    float a = fmaxf(p0[0], p1[0]);
#pragma unroll
    for (int r = 1; r < 16; ++r) a = fmaxf(a, fmaxf(p0[r], p1[r]));
    auto rr = __builtin_amdgcn_permlane32_swap(__float_as_uint(a), __float_as_uint(a), false, false);
    return fmaxf(__uint_as_float(rr[0]), __uint_as_float(rr[1]));
}
template <int ND0> __device__ __forceinline__ void qkt(f32x16& p0, f32x16& p1, const LAS char* kb, const bf16x8* qr) {
    const f32x16 z = {0.f, 0.f, 0.f, 0.f, 0.f, 0.f, 0.f, 0.f, 0.f, 0.f, 0.f, 0.f, 0.f, 0.f, 0.f, 0.f};
#pragma unroll
    for (int d0 = 0; d0 < ND0; ++d0) {
        const bf16x8 b0 = *(const LAS bf16x8*)(kb + d0 * 2048);
        const bf16x8 b1 = *(const LAS bf16x8*)(kb + d0 * 2048 + 512);
        if (d0 == 0) { p0 = __builtin_amdgcn_mfma_f32_32x32x16_bf16(b0, qr[0], z, 0, 0, 0); p1 = __builtin_amdgcn_mfma_f32_32x32x16_bf16(b1, qr[0], z, 0, 0, 0); }
        else { p0 = __builtin_amdgcn_mfma_f32_32x32x16_bf16(b0, qr[d0], p0, 0, 0, 0); p1 = __builtin_amdgcn_mfma_f32_32x32x16_bf16(b1, qr[d0], p1, 0, 0, 0); }
    }
}
__device__ __forceinline__ void pv(f32x16& o0, f32x16& o1, int vb, bf16x8 pa0, bf16x8 pa1, bf16x8 pa2, bf16x8 pa3) {
#pragma unroll
    for (int d0 = 0; d0 < 2; ++d0) { s16x4 lo[4], hi[4];
#pragma unroll
        for (int ks = 0; ks < 4; ++ks) {
            asm volatile("ds_read_b64_tr_b16 %0,%1 offset:%c2" : "=&v"(lo[ks]) : "v"(vb), "i"(d0 * 4096 + ks * 1024) : "memory");
            asm volatile("ds_read_b64_tr_b16 %0,%1 offset:%c2" : "=&v"(hi[ks]) : "v"(vb), "i"(d0 * 4096 + ks * 1024 + 512) : "memory"); }
        asm volatile("s_waitcnt lgkmcnt(0)" ::: "memory"); __builtin_amdgcn_sched_barrier(0);
#define ATT_PK(k) (bf16x8){lo[k][0], lo[k][1], lo[k][2], lo[k][3], hi[k][0], hi[k][1], hi[k][2], hi[k][3]}
        f32x16& o = d0 ? o1 : o0;
        o = __builtin_amdgcn_mfma_f32_32x32x16_bf16(pa0, ATT_PK(0), o, 0, 0, 0);
        o = __builtin_amdgcn_mfma_f32_32x32x16_bf16(pa1, ATT_PK(1), o, 0, 0, 0);
        o = __builtin_amdgcn_mfma_f32_32x32x16_bf16(pa2, ATT_PK(2), o, 0, 0, 0);
        o = __builtin_amdgcn_mfma_f32_32x32x16_bf16(pa3, ATT_PK(3), o, 0, 0, 0);
#undef ATT_PK
    }
}
__device__ __forceinline__ void softmax_pv(f32x16& p0, f32x16& p1, bool first, float& mref, float& l, f32x16& o0, f32x16& o1, LAS float* wsf, int r32, int hi, int vb) {
    const float rm = rowmax(p0, p1);
    bool resc = false;
    if (first) mref = rm;
    else if (__any(rm > mref + THR)) { const float mn = fmaxf(mref, rm); const float f = __builtin_amdgcn_exp2f(mref - mn); l *= f; if (hi == 0) wsf[r32] = f; mref = mn; resc = true; }
    float sacc = 0.f;
#pragma unroll
    for (int r = 0; r < 16; ++r) { p0[r] = __builtin_amdgcn_exp2f(p0[r] - mref); p1[r] = __builtin_amdgcn_exp2f(p1[r] - mref); sacc += p0[r] + p1[r]; }
    l += sacc;
    u32x4 w0, w1, w2, w3;
    w0 = (u32x4){pk2(p0[0], p0[1]), pk2(p0[2], p0[3]), pk2(p0[4], p0[5]), pk2(p0[6], p0[7])};
    w1 = (u32x4){pk2(p0[8], p0[9]), pk2(p0[10], p0[11]), pk2(p0[12], p0[13]), pk2(p0[14], p0[15])};
    w2 = (u32x4){pk2(p1[0], p1[1]), pk2(p1[2], p1[3]), pk2(p1[4], p1[5]), pk2(p1[6], p1[7])};
    w3 = (u32x4){pk2(p1[8], p1[9]), pk2(p1[10], p1[11]), pk2(p1[12], p1[13]), pk2(p1[14], p1[15])};
    if (resc) { LDS_WAIT();
#pragma unroll
        for (int r = 0; r < 16; ++r) { const float f = wsf[crow(r, hi)]; o0[r] *= f; o1[r] *= f; } }
    pv(o0, o1, vb, __builtin_bit_cast(bf16x8, w0), __builtin_bit_cast(bf16x8, w1), __builtin_bit_cast(bf16x8, w2), __builtin_bit_cast(bf16x8, w3));
}
__device__ __forceinline__ void attn_store(f32x16& o0, f32x16& o1, float l, bf16* Ow, LAS char* shm, int wid, int lane, int r32, int hi) {
    LAS float* wsf = (LAS float*)(shm + LWS) + wid * 64;
    { auto rr = __builtin_amdgcn_permlane32_swap(__float_as_uint(l), __float_as_uint(l), false, false); l = __uint_as_float(rr[0]) + __uint_as_float(rr[1]); }
    if (hi == 0) wsf[32 + r32] = l;
    LDS_WAIT();
    LAS bf16* stg = (LAS bf16*)(shm + LOST) + wid * 2048;
#pragma unroll
    for (int r = 0; r < 16; ++r) { const int orow = crow(r, hi); const float rl = __builtin_amdgcn_rcpf(wsf[32 + orow]);
        stg[orow * 64 + r32] = (bf16)f2bf(o0[r] * rl); stg[orow * 64 + 32 + r32] = (bf16)f2bf(o1[r] * rl); }
    LDS_WAIT();
#pragma unroll
    for (int i = 0; i < 4; ++i) { const int row = i * 8 + (lane >> 3), ch = lane & 7; const u32x4 v = *(const LAS u32x4*)(stg + row * 64 + ch * 8); *(u32x4*)(Ow + (size_t)row * 1024 + ch * 8) = v; }
}

__device__ __forceinline__ void mla_unit(int bh, int qb, const bf16* Qm, const unsigned char* Km, const unsigned char* Vm, bf16* O, LAS char* shm) {
    const int tid = threadIdx.x, lane = tid & 63, r32 = lane & 31, hi = lane >> 5; const int wid = __builtin_amdgcn_readfirstlane(tid >> 6);
    const unsigned lds0 = (unsigned)(uintptr_t)shm;
    const bf16* Qw = Qm + ((size_t)bh * SEQ + qb * 256 + wid * 32) * 96;
    const unsigned char* ksrc = Km + (size_t)bh * 128 * 12288 + wid * 1024 + lane * 16;
    const unsigned char* vsrc = Vm + (size_t)bh * 128 * 8192 + wid * 1024 + lane * 16;
    const unsigned kdst = lds0 + LK + wid * 1024, vdst = lds0 + LV + wid * 1024;
    const int NT = 4 * qb + 4, mychunk = 4 * qb + (wid >> 1);
    bf16x8 qr[6];
#pragma unroll
    for (int d0 = 0; d0 < 6; ++d0) qr[d0] = *(const bf16x8*)(Qw + (size_t)r32 * 96 + d0 * 16 + hi * 8);
    VM_WAIT();
#define MLA_DMA(t, s) do { glds16(ksrc + (size_t)(t) * 12288, (unsigned)__builtin_amdgcn_readfirstlane(kdst + (s) * KSL)); \
        if (wid < 4) glds16(ksrc + (size_t)(t) * 12288 + 8192, (unsigned)__builtin_amdgcn_readfirstlane(kdst + (s) * KSL + 8192)); \
        glds16(vsrc + (size_t)(t) * 8192, (unsigned)__builtin_amdgcn_readfirstlane(vdst + (s) * VSL)); } while (0)
    MLA_DMA(0, 0); MLA_DMA(1, 1);
    float mref = 0.f, l = 0.f; f32x16 o0, o1;
#pragma unroll
    for (int r = 0; r < 16; ++r) { o0[r] = 0.f; o1[r] = 0.f; }
    LAS float* wsf = (LAS float*)(shm + LWS) + wid * 64;
    const LAS char* kp0 = (const LAS char*)shm + LK + hi * 1024 + r32 * 16;
    const int vb0 = (int)(lds0 + LV) + ((lane >> 4) & 1) * 32 + (lane & 3) * 8 + (4 * hi + ((lane & 15) >> 2)) * 64;
    int sc = 0, sn = 2;
    for (int t = 0; t < NT; ++t) {
        if (t + 1 < NT) { if (wid < 4) ATT_WAITBAR(3); else ATT_WAITBAR(2); } else ATT_WAITBAR(0);
        if (t + 2 < NT) MLA_DMA(t + 2, sn);
        if (t <= mychunk) {
            f32x16 p0, p1;
            qkt<6>(p0, p1, kp0 + sc * KSL, qr);
            softmax_pv(p0, p1, t == 0, mref, l, o0, o1, wsf, r32, hi, vb0 + sc * VSL);
        }
        sc = (sc == 2) ? 0 : sc + 1; sn = (sn == 2) ? 0 : sn + 1;
    }
#undef MLA_DMA
    const int b = bh >> 3, h = bh & 7;
    attn_store(o0, o1, l, O + ((size_t)b * SEQ + qb * 256 + wid * 32) * 1024 + h * 64, shm, wid, lane, r32, hi);
    asm volatile("s_waitcnt lgkmcnt(0)\n\ts_barrier" ::: "memory");
}

__device__ __forceinline__ void ca_unit(int bh, int g4, const bf16* Z, const float* rel_bias, bf16* O, LAS char* shm) {
    const int tid = threadIdx.x, lane = tid & 63, r32 = lane & 31, hi = lane >> 5; const int wid = __builtin_amdgcn_readfirstlane(tid >> 6);
    const unsigned lds0 = (unsigned)(uintptr_t)shm;
    const int b = bh >> 3, h = bh & 7;
    const int c0 = 4 * g4, cq = c0 + (wid >> 1), kc_lo = c0 >= 8 ? c0 - 8 : 0, NT = c0 + 4 - kc_lo;
    const size_t rowb = (size_t)b * SEQ;
    LAS float* bt = (LAS float*)(shm + LBT);
    if (tid < 320) bt[tid] = rel_bias[h * 320 + tid] * LOG2E;
    const bf16* Qw = Z + (rowb + c0 * 64 + wid * 32 + r32) * NIN + C_QC + h * 64;
    bf16x8 qr[4];
#pragma unroll
    for (int d0 = 0; d0 < 4; ++d0) qr[d0] = *(const bf16x8*)(Qw + d0 * 16 + hi * 8);
    VM_WAIT();
    const bf16* ksrc = Z + (rowb + kc_lo * 64 + lane) * NIN + C_KC + h * 64 + wid * 8;
    const bf16* vsrc = Z + (rowb + kc_lo * 64 + 16 * (wid & 3) + (lane >> 2)) * NIN + C_VC + h * 64 + (wid >> 2) * 32 + (lane & 3) * 8;
    const unsigned kdst = lds0 + LK + wid * 1024, vdst = lds0 + LV + wid * 1024;
#define CA_DMA(t, s) do { glds16(ksrc + (size_t)(t) * 64 * NIN, (unsigned)__builtin_amdgcn_readfirstlane(kdst + (s) * KSL)); \
        glds16(vsrc + (size_t)(t) * 64 * NIN, (unsigned)__builtin_amdgcn_readfirstlane(vdst + (s) * VSL)); } while (0)
    CA_DMA(0, 0); CA_DMA(1, 1);
    float mref = 0.f, l = 0.f; f32x16 o0, o1;
#pragma unroll
    for (int r = 0; r < 16; ++r) { o0[r] = 0.f; o1[r] = 0.f; }
    LAS float* wsf = (LAS float*)(shm + LWS) + wid * 64;
    const LAS char* kp0 = (const LAS char*)shm + LK + hi * 1024 + r32 * 16;
    const int vb0 = (int)(lds0 + LV) + ((lane >> 4) & 1) * 32 + (lane & 3) * 8 + (4 * hi + ((lane & 15) >> 2)) * 64;
    const int qi = (wid & 1) * 32 + r32;
    bool first = true;
    int sc = 0, sn = 2;
    for (int t = 0; t < NT; ++t) {
        if (t + 1 < NT) ATT_WAITBAR(2); else ATT_WAITBAR(0);
        if (t + 2 < NT) CA_DMA(t + 2, sn);
        const int dist = cq - (kc_lo + t);
        if (dist >= 0 && dist <= 8) {
            f32x16 p0, p1;
            qkt<4>(p0, p1, kp0 + sc * KSL, qr);
            if (dist >= 5) { const float bc = bt[319];
#pragma unroll
                for (int r = 0; r < 16; ++r) { p0[r] = p0[r] * C2C + bc; p1[r] = p1[r] * C2C + bc; } }
            else { const int rb = dist * 64 + qi + 63;
#pragma unroll
                for (int r = 0; r < 16; ++r) { const int k0 = crow(r, hi); int i0 = rb - k0, i1 = rb - k0 - 32; i0 = i0 < 319 ? i0 : 319; i1 = i1 < 319 ? i1 : 319;
                    p0[r] = p0[r] * C2C + bt[i0]; p1[r] = p1[r] * C2C + bt[i1]; } }
            softmax_pv(p0, p1, first, mref, l, o0, o1, wsf, r32, hi, vb0 + sc * VSL);
            first = false;
        }
        sc = (sc == 2) ? 0 : sc + 1; sn = (sn == 2) ? 0 : sn + 1;
    }
#undef CA_DMA
    attn_store(o0, o1, l, O + (rowb + c0 * 64 + wid * 32) * 1024 + 512 + h * 64, shm, wid, lane, r32, hi);
    asm volatile("s_waitcnt lgkmcnt(0)\n\ts_barrier" ::: "memory");
}
}

#define XB_TMO      128
#define XB_XCNT(j)  (256  + 64 * (j))
#define XB_XSUB(j)  (1280 + 64 * (j))
#define XB_XGEN(j)  (2304 + 64 * (j))
#define XB_TOP      3328
#define XB_TOPGEN   3392
#define XCD_BAR_WORDS 3456
#define XB_SPIN_CAP (1u << 18)
__device__ __forceinline__ unsigned xb_ld(unsigned* p)              { return __hip_atomic_load(p, __ATOMIC_RELAXED, __HIP_MEMORY_SCOPE_AGENT); }
__device__ __forceinline__ unsigned xb_add(unsigned* p, unsigned v) { return __hip_atomic_fetch_add(p, v, __ATOMIC_RELAXED, __HIP_MEMORY_SCOPE_AGENT); }
__device__ __forceinline__ unsigned xb_xcc_id() { return (unsigned)__builtin_amdgcn_s_getreg((3 << 11) | 20) & 0xFu; }
#define XB_SPIN(cond, bar) do { unsigned _sp = 0; while (cond) { __builtin_amdgcn_s_sleep(1); \
    if ((++_sp & 255u) == 0u) { if (xb_ld(&(bar)[XB_TMO])) break; if (_sp > XB_SPIN_CAP) { atomicAdd(&(bar)[XB_TMO], 1u); break; } } } } while (0)
struct XcdBarrier { unsigned* bar; unsigned x; volatile LAS unsigned* st; };
__device__ __forceinline__ XcdBarrier xcd_barrier_post(unsigned* bar, volatile LAS unsigned* st) {
    XcdBarrier b; b.bar = bar; b.x = xb_xcc_id(); b.st = st;
    if (threadIdx.x == 0) (void)xb_add(&bar[XB_XCNT(b.x)], 1u);
    return b;
}
__device__ __forceinline__ void xcd_barrier_complete(unsigned* bar, unsigned x, unsigned& nloc, unsigned& nx) {
    const unsigned G = gridDim.x * gridDim.y * gridDim.z;
    unsigned sum, cnt, mine, sp = 0u;
    for (;;) {
        sum = 0u; cnt = 0u; mine = 0u;
#pragma unroll
        for (unsigned j = 0; j < 16; ++j) { const unsigned c = xb_ld(&bar[XB_XCNT(j)]); sum += c; cnt += (c > 0u) ? 1u : 0u; mine = (j == x) ? c : mine; }
        if (sum == G) break;
        __builtin_amdgcn_s_sleep(1);
        if ((++sp & 255u) == 0u) { if (xb_ld(&bar[XB_TMO])) break; if (sp > XB_SPIN_CAP) { atomicAdd(&bar[XB_TMO], 1u); break; } }
    }
    nloc = mine > 0u ? mine : 1u; nx = cnt > 0u ? cnt : 1u;
}
__device__ __forceinline__ void xcd_barrier(const XcdBarrier& b) {
    asm volatile("s_waitcnt vmcnt(0)" ::: "memory");
    __syncthreads();
    if (threadIdx.x == 0) {
        unsigned* bar = b.bar;
        __builtin_amdgcn_s_waitcnt(0);
        unsigned nloc = b.st[0], nx = b.st[1];
        if (nloc == 0u) { xcd_barrier_complete(bar, b.x, nloc, nx); b.st[0] = nloc; b.st[1] = nx; }
        const unsigned old = xb_add(&bar[XB_XSUB(b.x)], 1u);
        const unsigned gen = old / nloc;
        if (old + 1u == (gen + 1u) * nloc) {
            __builtin_amdgcn_fence(__ATOMIC_RELEASE, "agent");
            asm volatile("s_waitcnt vmcnt(0)" ::: "memory");
            const unsigned og = xb_add(&bar[XB_TOP], 1u);
            const unsigned tg = og / nx;
            if (og + 1u == (tg + 1u) * nx) xb_add(&bar[XB_TOPGEN], 1u);
            else XB_SPIN(xb_ld(&bar[XB_TOPGEN]) == tg, bar);
            __builtin_amdgcn_fence(__ATOMIC_ACQUIRE, "agent");
            xb_add(&bar[XB_XGEN(b.x)], 1u);
            asm volatile("s_waitcnt vmcnt(0)" ::: "memory");
        } else {
            XB_SPIN(xb_ld(&bar[XB_XGEN(b.x)]) == gen, bar);
            __builtin_amdgcn_fence(__ATOMIC_ACQUIRE, "agent");
            asm volatile("s_waitcnt vmcnt(0)" ::: "memory");
        }
    }
    __syncthreads();
}

struct Args { const float* in[21]; float* out; unsigned char* ws; int ph_lo, ph_hi; };
enum { I_X = 0, I_C, I_WADA, I_BADA, I_GPRE1, I_GPOST1, I_GPRE2, I_GPOST2, I_WIN, I_GQ, I_WQB, I_GKV, I_WKVB, I_RELB, I_WO, I_WR, I_BR, I_WGU, I_BGU, I_WDN, I_BDN };

__device__ __forceinline__ int qperm(int n) { const int h = n / 96, d = n - 96 * h; if (d < 64) return n; const int j = d - 64, i = j & 15, x2 = j >> 4; return h * 96 + 64 + 8 * (i >> 2) + 4 * x2 + (i & 3); }
__device__ __forceinline__ void tr_item(const float* W, int ldw, bf16* WT, int ldt, int k0, int kdst0, int nsrc0, int mode, int ndst0, LAS float* scr, int lane) {
#pragma unroll 8
    for (int i = 0; i < 32; ++i) { const int kk = 2 * i + (lane >> 5); scr[kk * 33 + (lane & 31)] = W[(size_t)(k0 + kk) * ldw + nsrc0 + (lane & 31)]; }
    LDS_WAIT(); asm volatile("" ::: "memory");
    const int c = lane & 7;
#pragma unroll
    for (int j = 0; j < 4; ++j) { const int n = (lane >> 3) + 8 * j; const LAS float* s = scr + (8 * c) * 33 + n;
        u32x4 o; o.x = pk2(s[0 * 33], s[1 * 33]); o.y = pk2(s[2 * 33], s[3 * 33]); o.z = pk2(s[4 * 33], s[5 * 33]); o.w = pk2(s[6 * 33], s[7 * 33]);
        const int dr = mode ? qperm(nsrc0 + n) : ndst0 + n;
        *(u32x4*)(WT + (size_t)dr * ldt + kdst0 + k0 + 8 * c) = o; }
    LDS_WAIT(); asm volatile("" ::: "memory");
}

__global__ void __launch_bounds__(512, 2) fwd(Args args) {
    extern __shared__ __attribute__((aligned(16))) unsigned char lds_raw[];
    LAS unsigned char* lds = (LAS unsigned char*)lds_raw;
    const int tid = threadIdx.x, lane = tid & 63, wave = __builtin_amdgcn_readfirstlane(tid >> 6);
    const int G = gridDim.x; const int bx = blockIdx.x; const int vcu = (G % 8 == 0) ? (bx % 8) * (G / 8) + bx / 8 : bx;
    unsigned char* ws = args.ws;
    unsigned* ctl = (unsigned*)(ws + WS_CTL);
    volatile LAS unsigned* MISC = (volatile LAS unsigned*)(lds + MISC_OFF);
    if (tid < 64) MISC[tid] = 0u;
    __syncthreads();
#if MK_ONE_LAUNCH
    XcdBarrier bar = xcd_barrier_post(ctl + CW_BAR, MISC + 8);
#define GRID_BAR() xcd_barrier(bar)
#else
#define GRID_BAR() do {} while (0)
#endif
    const int lo = args.ph_lo, hi_ph = args.ph_hi;
#ifndef PHM
#define PHM 0x1fff
#endif
#define IN(k) (((PHM >> (k)) & 1) && lo <= (k) && (k) < hi_ph)
#define BOTH(k) (IN(k) && IN((k) + 1))
    const float* x = args.in[I_X]; float* out = args.out;
    float* mod = (float*)(ws + WS_MOD); float* wrT = (float*)(ws + WS_WRT); float* gates = (float*)(ws + WS_GATE); f32x2* rope = (f32x2*)(ws + WS_ROPE);
    bf16* WQKV = (bf16*)(ws + WS_WQKV); unsigned* tinfo = (unsigned*)(ws + WS_TINFO); unsigned* lists = (unsigned*)(ws + WS_LIST);
    bf16* WIN = (bf16*)(ws + WS_WIN); bf16* WOt = (bf16*)(ws + WS_WO); bf16* WDN = (bf16*)(ws + WS_WDN); bf16* WGU = (bf16*)(ws + WS_WGU);
    bf16* Hb = (bf16*)(ws + WS_H); bf16* Z = (bf16*)(ws + WS_Z); bf16* Qm = (bf16*)(ws + WS_QM); unsigned char* Km = ws + WS_KM; unsigned char* Vm = ws + WS_VM;
    bf16* Ob = (bf16*)(ws + WS_O); bf16* OP = (bf16*)(ws + WS_OP); bf16* ACT = (bf16*)(ws + WS_ACT); bf16* YA = (bf16*)(ws + WS_YA); bf16* YB = (bf16*)(ws + WS_YB);
    const int gw = vcu * 8 + wave, NGW = G * 8, gt = vcu * 512 + tid, NGT = G * 512;

    if (IN(0)) {
        LAS float* scr = (LAS float*)(lds + wave * 16384);
        constexpr int I_GU = 32 * 16 * 64, I_DN = 32 * 16 * 32, I_IN = 16 * 61, I_O = 16 * 32, I_QB = 4 * 24, I_KVB = 2 * 32;
        constexpr int NITEMS = I_GU + I_DN + I_IN + I_O + I_QB + I_KVB;
        for (int it = gw; it < NITEMS; it += NGW) {
            int r = it;
            if (r < I_GU) { const int e = r >> 10, q = r & 1023, kb = q >> 6, nb = q & 63, nsrc0 = nb * 32, bj = nsrc0 >> 10, rem = nsrc0 & 1023, pn = rem >> 7, j0 = rem & 127;
                tr_item(args.in[I_WGU] + (size_t)e * 1024 * 2048, 2048, WGU, 1024, kb * 64, 0, nsrc0, 0, e * 2048 + pn * 256 + bj * 128 + j0, scr, lane); continue; } r -= I_GU;
            if (r < I_DN) { const int e = r >> 9, q = r & 511, kb = q >> 5, nb = q & 31;
                tr_item(args.in[I_WDN] + (size_t)e * 1024 * 1024, 1024, WDN, 1024, kb * 64, 0, nb * 32, 0, e * 1024 + nb * 32, scr, lane); continue; } r -= I_DN;
            if (r < I_IN) { const int kb = r / 61, nb = r % 61; tr_item(args.in[I_WIN], IN_W, WIN, 1024, kb * 64, 0, nb * 32, 0, nb * 32, scr, lane); continue; } r -= I_IN;
            if (r < I_O) { const int kb = r >> 5, nb = r & 31; tr_item(args.in[I_WO], 1024, WOt, 1024, kb * 64, 0, nb * 32, 0, nb * 32, scr, lane); continue; } r -= I_O;
            if (r < I_QB) { const int kb = r / 24, nb = r % 24; tr_item(args.in[I_WQB], 768, WQKV, KQKV, kb * 64, 0, nb * 32, 1, 0, scr, lane); continue; } r -= I_QB;
            { const int kb = r >> 5, nb = r & 31; tr_item(args.in[I_WKVB], 1024, WQKV, KQKV, kb * 64, 256, nb * 32, 0, 768 + nb * 32, scr, lane); }
        }
        const u32x4 z4 = {0u, 0u, 0u, 0u};
        for (int i = gt; i < 12288; i += NGT) *(u32x4*)((unsigned char*)WIN + (size_t)IN_W * 2048 + (size_t)i * 16) = z4;
        for (int i = gt; i < 768 * 16; i += NGT) { const int rr = i >> 4, cc = i & 15; *(u32x4*)((unsigned char*)WQKV + (size_t)rr * 768 + 512 + cc * 16) = z4; }
        for (int i = gt; i < 1024 * 32; i += NGT) { const int rr = 768 + (i >> 5), cc = i & 31; *(u32x4*)((unsigned char*)WQKV + (size_t)rr * 768 + cc * 16) = z4; }
        for (int i = gt; i < SEQ * 16; i += NGT) { const int pos = i >> 4, fi = i & 15;
            const float invf = __builtin_amdgcn_exp2f(-(float)fi * (13.287712379549449f / 16.f)); const float ang = (float)pos * invf;
            const double rev = (double)ang * 0.15915494309189535; const float fr = (float)(rev - __builtin_rint(rev));
            rope[i] = (f32x2){__builtin_amdgcn_cosf(fr), __builtin_amdgcn_sinf(fr)}; }
        for (int i = gt; i < 32 * 1024; i += NGT) { const int e = i >> 10, d = i & 1023; wrT[i] = args.in[I_WR][d * 32 + e]; }
        { const float* c = args.in[I_C] + wave * 1024; float sc[16];
#pragma unroll
            for (int i = 0; i < 16; ++i) { const float v = c[lane + 64 * i]; sc[i] = v / (1.f + __expf(-v)); }
            for (int cb = vcu; cb < 256; cb += G)
                for (int j = 0; j < 24; ++j) { const int col = cb * 24 + j; float s = 0.f;
#pragma unroll
                    for (int i = 0; i < 16; ++i) s += sc[i] * args.in[I_WADA][(size_t)(lane + 64 * i) * MODW + col];
                    s = wave_sum(s); if (lane == 0) mod[wave * MODW + col] = s + args.in[I_BADA][col]; } }
        if (BOTH(0)) GRID_BAR();
    }

    if (IN(1)) {
        for (int tile = vcu; tile < T / 256; tile += G) {
            const int row0 = tile * 256, b = row0 >> 13; const float* mb = mod + b * MODW;
            f32x4 a[4], s[4];
#pragma unroll
            for (int j = 0; j < 4; ++j) { const int d = 4 * lane + 256 * j; const f32x4 g = *(const f32x4*)(args.in[I_GPRE1] + d), sc1 = *(const f32x4*)(mb + 1024 + d); a[j] = g * (1.f + sc1); s[j] = *(const f32x4*)(mb + d); }
            for (int i = 0; i < 32; ++i) { const int row = row0 + wave * 32 + i; const f32x4* xr = (const f32x4*)(x + (size_t)row * DM) + lane;
                f32x4 v[4]; float ss = 0.f;
#pragma unroll
                for (int j = 0; j < 4; ++j) { v[j] = xr[64 * j]; ss += (v[j].x * v[j].x + v[j].y * v[j].y) + (v[j].z * v[j].z + v[j].w * v[j].w); }
                const float rstd = 1.f / sqrtf(wave_sum(ss) * (1.f / DM) + EPS);
                u32x2* o8 = (u32x2*)(Hb + (size_t)row * DM) + lane;
#pragma unroll
                for (int j = 0; j < 4; ++j) { const f32x4 hv = v[j] * rstd * a[j] + s[j]; o8[64 * j] = (u32x2){pk2(hv.x, hv.y), pk2(hv.z, hv.w)}; } }
        }
        if (BOTH(1)) GRID_BAR();
    }

    if (IN(2)) {
        pg8::Gemm g{Hb, WIN, 1024}; pg8::DenseSched S{NIN / 256, (T / 256) * (NIN / 256), G, vcu, 2048}; pg8::EpiPlain E{Z, NIN};
        pg8::gemm_phase<pg8::EpiPlain, pg8::DenseSched, true>(lds, g, S, E);
        if (BOTH(2)) GRID_BAR();
    }

    if (IN(3)) {
        bf16* AQ = Hb;
        const u32x2 gq2 = *(const u32x2*)(args.in[I_GQ] + 4 * lane), gq3 = *(const u32x2*)(args.in[I_GQ] + 4 * lane + 2);
        const float gq[4] = {__uint_as_float(gq2.x), __uint_as_float(gq2.y), __uint_as_float(gq3.x), __uint_as_float(gq3.y)};
        const float gk0 = args.in[I_GKV][2 * lane], gk1 = args.in[I_GKV][2 * lane + 1];
        for (int row = gw; row < T; row += NGW) {
            const bf16* zr = Z + (size_t)row * NIN;
            const u32x2 q2 = *(const u32x2*)(zr + 4 * lane); const unsigned k2 = *(const unsigned*)(zr + C_CKV + 2 * lane);
            const float q0 = bf2f(q2.x), q1 = bf2f(q2.x >> 16), q2f = bf2f(q2.y), q3 = bf2f(q2.y >> 16), c0 = bf2f(k2), c1 = bf2f(k2 >> 16);
            float x1 = 0.f, x2 = 0.f; if (lane < 16) { x1 = bf2f(zr[C_KR + lane]); x2 = bf2f(zr[C_KR + 16 + lane]); }
            const float rq = 1.f / sqrtf(wave_sum(q0 * q0 + q1 * q1 + q2f * q2f + q3 * q3) * (1.f / 256.f) + EPS);
            const float rk = 1.f / sqrtf(wave_sum(c0 * c0 + c1 * c1) * (1.f / 128.f) + EPS);
            *(u32x2*)(AQ + (size_t)row * KQKV + 4 * lane) = (u32x2){pk2(q0 * rq * gq[0], q1 * rq * gq[1]), pk2(q2f * rq * gq[2], q3 * rq * gq[3])};
            *(unsigned*)(AQ + (size_t)row * KQKV + 256 + 2 * lane) = pk2(c0 * rk * gk0, c1 * rk * gk1);
            const int pos = row & (SEQ - 1), b = row >> 13;
            const f32x2 cs = rope[pos * 16 + (lane & 15)];
            const float o1 = x1 * cs.x - x2 * cs.y, o2 = x2 * cs.x + x1 * cs.y;
            const int gq4 = lane & 3, hh = (lane >> 2) & 7;
            float v8[8];
#pragma unroll
            for (int t = 0; t < 4; ++t) { v8[t] = __shfl(o1, 4 * gq4 + t); v8[4 + t] = __shfl(o2, 4 * gq4 + t); }
            if (lane < 32) { const u32x4 w = {pk2(v8[0], v8[1]), pk2(v8[2], v8[3]), pk2(v8[4], v8[5]), pk2(v8[6], v8[7])};
                *(u32x4*)(Km + ((size_t)(b * 8 + hh) * 128 + (pos >> 6)) * 12288 + (8 + gq4) * 1024 + (pos & 63) * 16) = w; }
        }
        if (BOTH(3)) GRID_BAR();
    }

    if (IN(4)) {
        pg8::Gemm g{Hb, WQKV, KQKV}; pg8::DenseSched S{NQKV / 256, (T / 256) * (NQKV / 256), G, vcu, KQKV * 2}; pg8::EpiQKV E{Qm, Km, Vm, rope};
        pg8::gemm_phase<pg8::EpiQKV, pg8::DenseSched, true>(lds, g, S, E);
        if (BOTH(4)) GRID_BAR();
    }

    if (IN(5)) {
        for (int v = vcu; v < 256; v += G) {
            const int bh = v >> 2, s4 = v & 3;
#pragma unroll 1
            for (int i = 0; i < 8; ++i) { const int qb = 8 * (i >> 1) + ((i & 1) ? 7 - s4 : s4); att::mla_unit(bh, qb, Qm, Km, Vm, Ob, (LAS char*)lds); }
#pragma unroll 1
            for (int i = 0; i < 8; ++i) { const int id = v * 8 + i; att::ca_unit(id >> 5, id & 31, Z, args.in[I_RELB], Ob, (LAS char*)lds); }
        }
        if (BOTH(5)) GRID_BAR();
    }

    if (IN(6)) {
        pg8::Gemm g{Ob, WOt, 1024}; pg8::DenseSched S{4, (T / 256) * 4, G, vcu, 2048}; pg8::EpiPlain E{OP, 1024};
        pg8::gemm_phase<pg8::EpiPlain, pg8::DenseSched, true>(lds, g, S, E);
        if (BOTH(6)) GRID_BAR();
    }

    if (IN(7)) {
        constexpr int HS = 1028;
        LAS float* Hs = (LAS float*)lds;
        LAS float* part = (LAS float*)lds;
        LAS float* Lg = (LAS float*)(lds + 132096);
        LAS int* hist = (LAS int*)(lds + 132096 + 4352);
        LAS int* gbase = hist + 64;
        unsigned* gcnt = ctl + CW_CNT;
        for (int tile = vcu; tile < T / 256; tile += G) {
            const int row0 = tile * 256, b = row0 >> 13; const float* mb = mod + b * MODW;
            f32x4 A1[4], A2[4], S2[4];
#pragma unroll
            for (int j = 0; j < 4; ++j) { const int d = 4 * lane + 256 * j;
                A1[j] = *(const f32x4*)(mb + 2048 + d) * *(const f32x4*)(args.in[I_GPOST1] + d);
                A2[j] = *(const f32x4*)(args.in[I_GPRE2] + d) * (1.f + *(const f32x4*)(mb + 4096 + d));
                S2[j] = *(const f32x4*)(mb + 3072 + d); }
            for (int grp = 0; grp < 8; ++grp) {
                const int tok0 = row0 + grp * 32;
                if (tid < 64) hist[tid] = 0;
                for (int i = 0; i < 4; ++i) { const int tl = wave * 4 + i, row = tok0 + tl;
                    const f32x4* xr = (const f32x4*)(x + (size_t)row * DM) + lane; const u32x2* pr = (const u32x2*)(OP + (size_t)row * DM) + lane;
                    f32x4 xv[4], ov[4]; float ss = 0.f;
#pragma unroll
                    for (int j = 0; j < 4; ++j) { xv[j] = xr[64 * j]; const u32x2 p = pr[64 * j]; ov[j] = (f32x4){bf2f(p.x), bf2f(p.x >> 16), bf2f(p.y), bf2f(p.y >> 16)};
                        ss += (ov[j].x * ov[j].x + ov[j].y * ov[j].y) + (ov[j].z * ov[j].z + ov[j].w * ov[j].w); }
                    const float r1 = 1.f / sqrtf(wave_sum(ss) * (1.f / DM) + EPS); float ss2 = 0.f;
                    f32x4* outr = (f32x4*)(out + (size_t)row * DM) + lane;
#pragma unroll
                    for (int j = 0; j < 4; ++j) { xv[j] = xv[j] + A1[j] * (ov[j] * r1); outr[64 * j] = xv[j]; ss2 += (xv[j].x * xv[j].x + xv[j].y * xv[j].y) + (xv[j].z * xv[j].z + xv[j].w * xv[j].w); }
                    const float r2 = 1.f / sqrtf(wave_sum(ss2) * (1.f / DM) + EPS);
                    u32x2* h8 = (u32x2*)(Hb + (size_t)row * DM) + lane;
#pragma unroll
                    for (int j = 0; j < 4; ++j) { const f32x4 hv = xv[j] * r2 * A2[j] + S2[j]; h8[64 * j] = (u32x2){pk2(hv.x, hv.y), pk2(hv.z, hv.w)};
                        *(LAS f32x4*)(Hs + tl * HS + 4 * lane + 256 * j) = hv; } }
                __syncthreads();
                f32x16 pl;
#pragma unroll
                for (int r = 0; r < 16; ++r) pl[r] = 0.f;
                { const int tk = lane & 31, hi = lane >> 5; const LAS float* ap = Hs + tk * HS + wave * 128 + 4 * hi; const float* bp = wrT + tk * 1024 + wave * 128 + 4 * hi;
#pragma unroll 4
                    for (int m = 0; m < 16; ++m) { const f32x4 av = *(const LAS f32x4*)(ap + 8 * m); const f32x4 bv = *(const f32x4*)(bp + 8 * m);
                        pl = __builtin_amdgcn_mfma_f32_32x32x2f32(av.x, bv.x, pl, 0, 0, 0); pl = __builtin_amdgcn_mfma_f32_32x32x2f32(av.y, bv.y, pl, 0, 0, 0);
                        pl = __builtin_amdgcn_mfma_f32_32x32x2f32(av.z, bv.z, pl, 0, 0, 0); pl = __builtin_amdgcn_mfma_f32_32x32x2f32(av.w, bv.w, pl, 0, 0, 0); } }
                __syncthreads();
                { const int e = lane & 31, hi = lane >> 5;
#pragma unroll
                    for (int r = 0; r < 16; ++r) part[(wave * 32 + att::crow(r, hi)) * 33 + e] = pl[r]; }
                __syncthreads();
                { const int tk = tid & 31, e0 = (tid >> 5) * 2;
#pragma unroll
                    for (int q = 0; q < 2; ++q) { const int e = e0 + q; float s = args.in[I_BR][e];
#pragma unroll
                        for (int w = 0; w < 8; ++w) s += part[(w * 32 + tk) * 33 + e];
                        Lg[tk * 33 + e] = s; } }
                __syncthreads();
                if (wave == 0) {
                    const int tk = lane & 31, tok = tok0 + tk; int ei[4]; float ev[4]; int li[4];
                    { int c0 = -1, c1 = -1, c2 = -1;
#pragma unroll
                        for (int k = 0; k < 4; ++k) { float best = -INFINITY; int bi = 0;
                            for (int e = 0; e < 32; ++e) { const float v = Lg[tk * 33 + e]; if (e != c0 && e != c1 && e != c2 && v > best) { best = v; bi = e; } }
                            ei[k] = bi; ev[k] = best; if (k == 0) c0 = bi; else if (k == 1) c1 = bi; else if (k == 2) c2 = bi; } }
                    float gsum = 0.f, gv[4];
#pragma unroll
                    for (int k = 0; k < 4; ++k) { gv[k] = __expf(ev[k] - ev[0]); gsum += gv[k]; }
                    const float ginv = 1.f / gsum;
                    if (lane < 32) {
#pragma unroll
                        for (int k = 0; k < 4; ++k) li[k] = __hip_atomic_fetch_add(hist + (k >> 1) * 32 + ei[k], 1, __ATOMIC_RELAXED, __HIP_MEMORY_SCOPE_WORKGROUP);
                        *(f32x4*)(gates + (size_t)tok * 4) = (f32x4){gv[0] * ginv, gv[1] * ginv, gv[2] * ginv, gv[3] * ginv};
                    }
                    LDS_WAIT(); asm volatile("" ::: "memory");
                    { const int c = hist[lane]; int gb = 0; if (c > 0) gb = (int)__hip_atomic_fetch_add(gcnt + lane, (unsigned)c, __ATOMIC_RELAXED, __HIP_MEMORY_SCOPE_AGENT); gbase[lane] = gb; }
                    LDS_WAIT(); asm volatile("" ::: "memory");
                    if (lane < 32) {
#pragma unroll
                        for (int k = 0; k < 4; ++k) { const int p = k >> 1, e = ei[k], idx = gbase[p * 32 + e] + li[k];
                            lists[((size_t)p * 32 + e) * LIST_CAP + idx] = (unsigned)tok * 2u + (unsigned)(k & 1);
                            tinfo[(size_t)tok * 4 + k] = ((unsigned)e << 16) | (unsigned)idx; }
                    }
                }
                __syncthreads();
            }
        }
        if (BOTH(7)) GRID_BAR();
    }

#define MOE_TABLES(p) do { LAS int* tst = (LAS int*)(lds + TAB_OFF); LAS int* cn = tst + 40; \
        if (tid < 32) cn[tid] = (int)__hip_atomic_load(ctl + CW_CNT + (p) * 32 + tid, __ATOMIC_RELAXED, __HIP_MEMORY_SCOPE_AGENT); \
        __syncthreads(); \
        if (tid == 0) { int acc_ = 0; for (int e = 0; e < 32; ++e) { tst[e] = acc_; acc_ += (cn[e] + 255) >> 8; } tst[32] = acc_; } \
        __syncthreads(); } while (0)
#define MOE_G1(p) do { MOE_TABLES(p); \
        pg8::Gemm g{Hb, WGU, 1024}; pg8::MoeSched S{(const LAS int*)(lds + TAB_OFF), (const LAS int*)(lds + TAB_OFF) + 40, lists + (size_t)(p) * 32 * LIST_CAP, 8, G, vcu, 2048}; \
        pg8::EpiGU E{ACT, args.in[I_BGU]}; pg8::gemm_phase<pg8::EpiGU, pg8::MoeSched, true>(lds, g, S, E); } while (0)
#define MOE_G2(p, Y) do { MOE_TABLES(p); \
        pg8::Gemm g{ACT, WDN, 1024}; pg8::MoeSched S{(const LAS int*)(lds + TAB_OFF), (const LAS int*)(lds + TAB_OFF) + 40, nullptr, 4, G, vcu, 1024}; \
        pg8::EpiDN E{Y, args.in[I_BDN], lists + (size_t)(p) * 32 * LIST_CAP}; pg8::gemm_phase<pg8::EpiDN, pg8::MoeSched, true>(lds, g, S, E); } while (0)
    if (IN(8)) { MOE_G1(0); if (BOTH(8)) GRID_BAR(); }
    if (IN(9)) { MOE_G2(0, YA); if (BOTH(9)) GRID_BAR(); }
    if (IN(10)) { MOE_G1(1); if (BOTH(10)) GRID_BAR(); }
    if (IN(11)) { MOE_G2(1, YB); if (BOTH(11)) GRID_BAR(); }

    if (IN(12)) {
        for (int tile = vcu; tile < T / 256; tile += G) {
            const int row0 = tile * 256, b = row0 >> 13; const float* mb = mod + b * MODW;
            f32x4 A3[4];
#pragma unroll
            for (int j = 0; j < 4; ++j) { const int d = 4 * lane + 256 * j; A3[j] = *(const f32x4*)(mb + 5120 + d) * *(const f32x4*)(args.in[I_GPOST2] + d); }
            for (int i = 0; i < 32; ++i) { const int row = row0 + wave * 32 + i;
                const f32x4 gv = *(const f32x4*)(gates + (size_t)row * 4);
                const u32x2* ya = (const u32x2*)(YA + (size_t)row * 2048) + lane; const u32x2* yb = (const u32x2*)(YB + (size_t)row * 2048) + lane;
                f32x4 f[4]; float ss = 0.f;
#pragma unroll
                for (int j = 0; j < 4; ++j) { const u32x2 p0 = ya[64 * j], p1 = ya[256 + 64 * j], p2 = yb[64 * j], p3 = yb[256 + 64 * j];
                    f[j] = (f32x4){bf2f(p0.x), bf2f(p0.x >> 16), bf2f(p0.y), bf2f(p0.y >> 16)} * gv.x + (f32x4){bf2f(p1.x), bf2f(p1.x >> 16), bf2f(p1.y), bf2f(p1.y >> 16)} * gv.y
                         + (f32x4){bf2f(p2.x), bf2f(p2.x >> 16), bf2f(p2.y), bf2f(p2.y >> 16)} * gv.z + (f32x4){bf2f(p3.x), bf2f(p3.x >> 16), bf2f(p3.y), bf2f(p3.y >> 16)} * gv.w;
                    ss += (f[j].x * f[j].x + f[j].y * f[j].y) + (f[j].z * f[j].z + f[j].w * f[j].w); }
                const float rs = 1.f / sqrtf(wave_sum(ss) * (1.f / DM) + EPS);
                f32x4* outr = (f32x4*)(out + (size_t)row * DM) + lane;
#pragma unroll
                for (int j = 0; j < 4; ++j) outr[64 * j] = outr[64 * j] + A3[j] * (f[j] * rs); }
        }
    }
#undef IN
#undef BOTH
}


#if MK_DEBUG
__device__ __forceinline__ unsigned hsh(unsigned x) { x ^= x >> 16; x *= 0x7feb352dU; x ^= x >> 15; x *= 0x846ca68bU; x ^= x >> 16; return x; }
__device__ __forceinline__ void diag_max(unsigned* ctl, int slot, float err) { if (!(err == err)) err = 1e30f; if (err < 0.f) err = -err; atomicMax(ctl + CW_DIAG + slot, __float_as_uint(err)); }
__device__ __forceinline__ float relerr(float got, float want, float flo) { return fabsf(got - want) / (fabsf(want) + flo); }
__device__ __forceinline__ float kimg(const unsigned char* Km, int bh, int key, int d) { return bf2f(*(const bf16*)(Km + ((size_t)bh * 128 + (key >> 6)) * 12288 + (d >> 3) * 1024 + (key & 63) * 16 + (d & 7) * 2)); }
__device__ __forceinline__ float vimg(const unsigned char* Vm, int bh, int key, int d) { return bf2f(*(const bf16*)(Vm + ((size_t)bh * 128 + (key >> 6)) * 8192 + (d >> 5) * 4096 + ((key & 63) >> 4) * 1024 + (key & 15) * 64 + (d & 31) * 2)); }
__device__ __forceinline__ float dotbf(const bf16* a, const bf16* b, int n) { float s = 0.f; for (int k = 0; k < n; ++k) s += bf2f(a[k]) * bf2f(b[k]); return s; }

__global__ void __launch_bounds__(256) dbg_chk(Args a, int which, int p) {
    unsigned char* ws = a.ws; unsigned* ctl = (unsigned*)(ws + WS_CTL);
    const int gt = blockIdx.x * 256 + threadIdx.x, NGT = gridDim.x * 256, lane = threadIdx.x & 63, gwv = gt >> 6;
    float* mod = (float*)(ws + WS_MOD); float* wrT = (float*)(ws + WS_WRT); float* gates = (float*)(ws + WS_GATE); f32x2* rope = (f32x2*)(ws + WS_ROPE);
    bf16* WQKV = (bf16*)(ws + WS_WQKV); unsigned* tinfo = (unsigned*)(ws + WS_TINFO); unsigned* lists = (unsigned*)(ws + WS_LIST);
    bf16* WIN = (bf16*)(ws + WS_WIN); bf16* WOt = (bf16*)(ws + WS_WO); bf16* WDN = (bf16*)(ws + WS_WDN); bf16* WGU = (bf16*)(ws + WS_WGU);
    bf16* Hb = (bf16*)(ws + WS_H); bf16* Z = (bf16*)(ws + WS_Z); bf16* Qm = (bf16*)(ws + WS_QM); unsigned char* Km = ws + WS_KM; unsigned char* Vm = ws + WS_VM;
    bf16* Ob = (bf16*)(ws + WS_O); bf16* OP = (bf16*)(ws + WS_OP); bf16* ACT = (bf16*)(ws + WS_ACT); bf16* YA = (bf16*)(ws + WS_YA); bf16* YB = (bf16*)(ws + WS_YB);
    float* dbgv = (float*)(ws + WS_DBG); unsigned* gcnt = ctl + CW_CNT;
    const float* x = a.in[I_X];
    if (which == 0) {
        for (int i = gt; i < 65536; i += NGT) { const unsigned h = hsh(i), h2 = hsh(i + 77777u);
            { const int n = h & 2047, k = (h >> 11) & 1023; const unsigned want = n < IN_W ? f2bf(a.in[I_WIN][(size_t)k * IN_W + n]) : 0u; if (want != WIN[(size_t)n * 1024 + k]) diag_max(ctl, 0, 10.f); }
            { const int n = h & 1023, k = (h >> 10) & 1023; if (f2bf(a.in[I_WO][(size_t)k * 1024 + n]) != WOt[(size_t)n * 1024 + k]) diag_max(ctl, 0, 11.f); }
            { const int e = h2 & 31, rr = (h2 >> 5) & 2047, k = (h2 >> 16) & 1023, pn = rr >> 8, bj = (rr >> 7) & 1, j = rr & 127, col = bj * 1024 + pn * 128 + j;
              if (f2bf(a.in[I_WGU][((size_t)e * 1024 + k) * 2048 + col]) != WGU[((size_t)e * 2048 + rr) * 1024 + k]) diag_max(ctl, 0, 12.f); }
            { const int e = h2 & 31, n = (h2 >> 5) & 1023, k = (h2 >> 16) & 1023; if (f2bf(a.in[I_WDN][((size_t)e * 1024 + k) * 1024 + n]) != WDN[((size_t)e * 1024 + n) * 1024 + k]) diag_max(ctl, 0, 13.f); }
            { const int ns = h % 768, k = (h >> 10) % 384; const unsigned want = k < 256 ? f2bf(a.in[I_WQB][(size_t)k * 768 + ns]) : 0u; if (want != WQKV[(size_t)qperm(ns) * KQKV + k]) diag_max(ctl, 0, 14.f); }
            { const int n = h2 & 1023, k = (h2 >> 10) % 384; const unsigned want = k >= 256 ? f2bf(a.in[I_WKVB][(size_t)(k - 256) * 1024 + n]) : 0u; if (want != WQKV[(size_t)(768 + n) * KQKV + k]) diag_max(ctl, 0, 15.f); }
        }
    } else if (which == 1) {
        for (int i = gt; i < 2048; i += NGT) { const unsigned h = hsh(i); const int b = h & 7, j = (h >> 3) % MODW; float s = 0.f;
            for (int k = 0; k < 1024; ++k) { const float v = a.in[I_C][b * 1024 + k]; s += (v / (1.f + expf(-v))) * a.in[I_WADA][(size_t)k * MODW + j]; }
            diag_max(ctl, 1, relerr(mod[b * MODW + j], s + a.in[I_BADA][j], 0.1f) * 30.f); }
        for (int i = gt; i < 4096; i += NGT) { const unsigned h = hsh(i + 999u); const int pos = h & 8191, fi = (h >> 13) & 15;
            const float invf = __builtin_amdgcn_exp2f(-(float)fi * (13.287712379549449f / 16.f)); const float ang = (float)pos * invf;
            const double tp = 6.283185307179586; double r = (double)ang; r -= tp * __builtin_rint(r / tp); const double r2 = r * r; double sn = r, cs = 1.0, ts = r, tc = 1.0;
            for (int n = 1; n <= 14; ++n) { tc *= -r2 / (double)((2 * n - 1) * (2 * n)); cs += tc; ts *= -r2 / (double)((2 * n) * (2 * n + 1)); sn += ts; }
            const f32x2 g = rope[pos * 16 + fi]; diag_max(ctl, 1, (fabsf(g.x - (float)cs) + fabsf(g.y - (float)sn)) * 30.f); }
        for (int i = gt; i < 32768; i += NGT) { const int e = i >> 10, d = i & 1023; if (wrT[i] != a.in[I_WR][d * 32 + e]) diag_max(ctl, 1, 9.f); }
    } else if (which == 2) {
        for (int i = gt; i < 2048; i += NGT) { const unsigned h = hsh(i); const int row = h & 65535, col = (h >> 16) & 1023, b = row >> 13; float ss = 0.f;
            for (int k = 0; k < 1024; ++k) { const float v = x[(size_t)row * 1024 + k]; ss += v * v; }
            const float rstd = 1.f / sqrtf(ss / 1024.f + EPS); const float want = x[(size_t)row * 1024 + col] * rstd * a.in[I_GPRE1][col] * (1.f + mod[b * MODW + 1024 + col]) + mod[b * MODW + col];
            diag_max(ctl, 2, relerr(bf2f(Hb[(size_t)row * 1024 + col]), want, 0.5f)); }
    } else if (which == 3) {
        for (int i = gt; i < 4096; i += NGT) { const unsigned h = hsh(i); const int row = h & 65535, n = (h >> 16) % IN_W;
            diag_max(ctl, 3, relerr(bf2f(Z[(size_t)row * NIN + n]), dotbf(Hb + (size_t)row * 1024, WIN + (size_t)n * 1024, 1024), 0.5f)); }
    } else if (which == 4) {
        bf16* AQ = Hb;
        for (int i = gt; i < 2048; i += NGT) { const unsigned h = hsh(i); const int row = h & 65535, col = (h >> 16) % 384; const bf16* zr = Z + (size_t)row * NIN; float ss = 0.f, want;
            if (col < 256) { for (int k = 0; k < 256; ++k) { const float v = bf2f(zr[k]); ss += v * v; } want = bf2f(zr[col]) / sqrtf(ss / 256.f + EPS) * a.in[I_GQ][col]; }
            else { for (int k = 256; k < 384; ++k) { const float v = bf2f(zr[k]); ss += v * v; } want = bf2f(zr[col]) / sqrtf(ss / 128.f + EPS) * a.in[I_GKV][col - 256]; }
            diag_max(ctl, 4, relerr(bf2f(AQ[(size_t)row * KQKV + col]), want, 0.3f));
            const int hh = (h >> 16) & 7, jp = (h >> 19) & 31, g = jp >> 3, t = jp & 7, fi = 4 * g + (t & 3), x2s = t >> 2, pos = row & 8191, b = row >> 13;
            const float x1 = bf2f(zr[C_KR + fi]), x2 = bf2f(zr[C_KR + 16 + fi]); const f32x2 cs = rope[pos * 16 + fi];
            const float wk = x2s ? x2 * cs.x + x1 * cs.y : x1 * cs.x - x2 * cs.y;
            diag_max(ctl, 4, relerr(kimg(Km, b * 8 + hh, pos, 64 + jp), wk, 0.3f)); }
    } else if (which == 5) {
        bf16* AQ = Hb;
        for (int i = gt; i < 4096; i += NGT) { const unsigned h = hsh(i); const int row = h & 65535, c = (h >> 16) % NQKV, b = row >> 13, s = row & 8191; const bf16* ar = AQ + (size_t)row * KQKV;
            if (c < 768) { const int hh = c / 96, d = c % 96; float want, got = bf2f(Qm[((size_t)(b * 8 + hh) * SEQ + s) * 96 + d]);
                if (d < 64) want = dotbf(ar, WQKV + (size_t)c * KQKV, KQKV) * C2M;
                else { const int jp = d - 64, g = jp >> 3, t = jp & 7, fi = 4 * g + (t & 3), x2s = t >> 2, cpart = hh * 96 + 64 + 8 * g + (t & 3) + (x2s ? 0 : 4);
                    const float dc = dotbf(ar, WQKV + (size_t)c * KQKV, KQKV) * C2M, dp = dotbf(ar, WQKV + (size_t)cpart * KQKV, KQKV) * C2M; const float x1 = x2s ? dp : dc, x2 = x2s ? dc : dp; const f32x2 cs = rope[s * 16 + fi];
                    want = x2s ? x2 * cs.x + x1 * cs.y : x1 * cs.x - x2 * cs.y; }
                diag_max(ctl, 5, relerr(got, want, 0.1f)); }
            else { const int cc = c - 768, hh = cc >> 7, dd = cc & 127; const float want = dotbf(ar, WQKV + (size_t)c * KQKV, KQKV);
                const float got = dd < 64 ? kimg(Km, b * 8 + hh, s, dd) : vimg(Vm, b * 8 + hh, s, dd - 64); diag_max(ctl, 5, relerr(got, want, 0.3f)); } }
    } else if (which == 6) {
        for (int smp = gwv; smp < 256; smp += NGT / 64) { const unsigned h = hsh(smp * 3 + 1); const int b = h & 7, hh = (h >> 3) & 7; int s = (h >> 6) & 8191; if (smp < 16) s = smp * 17; const int bh = b * 8 + hh, nk = ((s >> 6) + 1) * 64;
            const bf16* q = Qm + ((size_t)bh * SEQ + s) * 96; float m = -INFINITY;
            for (int k = lane; k < nk; k += 64) { float sc = 0.f; for (int d = 0; d < 96; ++d) sc += bf2f(q[d]) * kimg(Km, bh, k, d); m = fmaxf(m, sc); }
            for (int o = 1; o < 64; o <<= 1) m = fmaxf(m, __shfl_xor(m, o));
            float l = 0.f; float acc[64];
#pragma unroll
            for (int d = 0; d < 64; ++d) acc[d] = 0.f;
            for (int k = lane; k < nk; k += 64) { float sc = 0.f; for (int d = 0; d < 96; ++d) sc += bf2f(q[d]) * kimg(Km, bh, k, d); const float e = exp2f(sc - m); l += e;
#pragma unroll
                for (int d = 0; d < 64; ++d) acc[d] += e * vimg(Vm, bh, k, d); }
            l = wave_sum(l); float mine = 0.f, sq = 0.f;
#pragma unroll
            for (int d = 0; d < 64; ++d) { const float v = wave_sum(acc[d]) / l; sq += v * v; if (lane == d) mine = v; }
            const float rms = sqrtf(sq / 64.f); const float got = bf2f(Ob[((size_t)b * SEQ + s) * 1024 + hh * 64 + lane]);
            diag_max(ctl, 6, fabsf(got - mine) / (fabsf(mine) + 0.3f * rms + 1e-6f)); }
    } else if (which == 7) {
        for (int smp = gwv; smp < 256; smp += NGT / 64) { const unsigned h = hsh(smp * 5 + 2); const int b = h & 7, hh = (h >> 3) & 7; int s = (h >> 6) & 8191; if (smp < 16) s = smp * 41; const int cq = s >> 6, k0 = (cq >= 8 ? cq - 8 : 0) * 64, k1 = (cq + 1) * 64;
            const bf16* q = Z + ((size_t)b * SEQ + s) * NIN + C_QC + hh * 64; float m = -INFINITY;
            for (int k = k0 + lane; k < k1; k += 64) { const bf16* kr = Z + ((size_t)b * SEQ + k) * NIN + C_KC + hh * 64; float sc = 0.f; for (int d = 0; d < 64; ++d) sc += bf2f(q[d]) * bf2f(kr[d]);
                int rel = s - k; rel = rel < -63 ? -63 : (rel > 256 ? 256 : rel); sc = sc * 0.125f + a.in[I_RELB][hh * 320 + rel + 63]; m = fmaxf(m, sc); }
            for (int o = 1; o < 64; o <<= 1) m = fmaxf(m, __shfl_xor(m, o));
            float l = 0.f; float acc[64];
#pragma unroll
            for (int d = 0; d < 64; ++d) acc[d] = 0.f;
            for (int k = k0 + lane; k < k1; k += 64) { const bf16* kr = Z + ((size_t)b * SEQ + k) * NIN + C_KC + hh * 64; const bf16* vr = Z + ((size_t)b * SEQ + k) * NIN + C_VC + hh * 64; float sc = 0.f; for (int d = 0; d < 64; ++d) sc += bf2f(q[d]) * bf2f(kr[d]);
                int rel = s - k; rel = rel < -63 ? -63 : (rel > 256 ? 256 : rel); sc = sc * 0.125f + a.in[I_RELB][hh * 320 + rel + 63]; const float e = expf(sc - m); l += e;
#pragma unroll
                for (int d = 0; d < 64; ++d) acc[d] += e * bf2f(vr[d]); }
            l = wave_sum(l); float mine = 0.f, sq = 0.f;
#pragma unroll
            for (int d = 0; d < 64; ++d) { const float v = wave_sum(acc[d]) / l; sq += v * v; if (lane == d) mine = v; }
            const float rms = sqrtf(sq / 64.f); const float got = bf2f(Ob[((size_t)b * SEQ + s) * 1024 + 512 + hh * 64 + lane]);
            diag_max(ctl, 7, fabsf(got - mine) / (fabsf(mine) + 0.3f * rms + 1e-6f)); }
    } else if (which == 8) {
        for (int i = gt; i < 4096; i += NGT) { const unsigned h = hsh(i); const int row = h & 65535, n = (h >> 16) & 1023;
            diag_max(ctl, 8, relerr(bf2f(OP[(size_t)row * 1024 + n]), dotbf(Ob + (size_t)row * 1024, WOt + (size_t)n * 1024, 1024), 0.2f)); }
    } else if (which == 9 || which == 10) {
        for (int i = gt; i < 1024; i += NGT) { const unsigned h = hsh(i + 31u * which); const int row = h & 65535, col = (h >> 16) & 1023, b = row >> 13; const float* mb = mod + b * MODW;
            float ss = 0.f; for (int k = 0; k < 1024; ++k) { const float v = bf2f(OP[(size_t)row * 1024 + k]); ss += v * v; }
            const float r1 = 1.f / sqrtf(ss / 1024.f + EPS); float ss2 = 0.f;
            for (int k = 0; k < 1024; ++k) { const float v = x[(size_t)row * 1024 + k] + mb[2048 + k] * (bf2f(OP[(size_t)row * 1024 + k]) * r1 * a.in[I_GPOST1][k]); ss2 += v * v; }
            const float r2 = 1.f / sqrtf(ss2 / 1024.f + EPS);
            if (which == 9) { const float x1 = x[(size_t)row * 1024 + col] + mb[2048 + col] * (bf2f(OP[(size_t)row * 1024 + col]) * r1 * a.in[I_GPOST1][col]);
                const float h2 = x1 * r2 * a.in[I_GPRE2][col] * (1.f + mb[4096 + col]) + mb[3072 + col];
                diag_max(ctl, 9, relerr(a.out[(size_t)row * 1024 + col], x1, 0.5f) * 30.f); diag_max(ctl, 9, relerr(bf2f(Hb[(size_t)row * 1024 + col]), h2, 0.5f)); }
            else { float lg[32];
#pragma unroll
                for (int e = 0; e < 32; ++e) lg[e] = a.in[I_BR][e];
                for (int k = 0; k < 1024; ++k) { const float x1 = x[(size_t)row * 1024 + k] + mb[2048 + k] * (bf2f(OP[(size_t)row * 1024 + k]) * r1 * a.in[I_GPOST1][k]);
                    const float h2 = x1 * r2 * a.in[I_GPRE2][k] * (1.f + mb[4096 + k]) + mb[3072 + k];
#pragma unroll
                    for (int e = 0; e < 32; ++e) lg[e] += h2 * a.in[I_WR][k * 32 + e]; }
                int ci[5]; float cv[5];
#pragma unroll
                for (int k = 0; k < 5; ++k) { float best = -INFINITY; int bi = 0;
#pragma unroll
                    for (int e = 0; e < 32; ++e) { bool used = false;
#pragma unroll
                        for (int q = 0; q < 5; ++q) if (q < k && ci[q] == e) used = true;
                        if (!used && lg[e] > best) { best = lg[e]; bi = e; } }
                    ci[k] = bi; cv[k] = best; }
                bool tie = false;
#pragma unroll
                for (int k = 0; k < 4; ++k) if (cv[k] - cv[k + 1] < 2e-4f) tie = true;
                if (!tie) { float gs = 0.f, gv[4];
#pragma unroll
                    for (int k = 0; k < 4; ++k) { gv[k] = expf(cv[k] - cv[0]); gs += gv[k]; }
#pragma unroll
                    for (int k = 0; k < 4; ++k) { const unsigned ti = tinfo[(size_t)row * 4 + k]; const int e = ti >> 16, idx = ti & 0xffff, pp = k >> 1;
                        if (e != ci[k]) diag_max(ctl, 10, 1.f);
                        else { diag_max(ctl, 10, fabsf(gates[(size_t)row * 4 + k] - gv[k] / gs) * 10.f);
                            if (idx >= (int)gcnt[pp * 32 + e]) diag_max(ctl, 10, 2.f);
                            else if (lists[((size_t)pp * 32 + e) * LIST_CAP + idx] != (unsigned)row * 2u + (k & 1)) diag_max(ctl, 10, 3.f); } } } } }
        if (which == 10 && gt == 0) { unsigned s0 = 0, s1 = 0; for (int e = 0; e < 32; ++e) { s0 += gcnt[e]; s1 += gcnt[32 + e]; } if (s0 != 131072u || s1 != 131072u) diag_max(ctl, 10, 4.f); }
    } else if (which == 11 || which == 12) {
        bf16* Y = p ? YB : YA;
        for (int i = gt; i < 4096; i += NGT) { const unsigned h = hsh(i + 7u * which + 13u * p); const int e = h & 31, cnt = (int)gcnt[p * 32 + e]; if (cnt <= 0) continue;
            const int idx = (int)(((h >> 5) & 0xffff) % (unsigned)cnt), col = (h >> 21) & 1023; int ts = 0; for (int q = 0; q < e; ++q) ts += ((int)gcnt[p * 32 + q] + 255) >> 8;
            const int row = ts * 256 + idx; const unsigned ent = lists[((size_t)p * 32 + e) * LIST_CAP + idx]; const int tok = ent >> 1;
            if (which == 11) { const int pn = col >> 7, j = col & 127;
                float gte = dotbf(Hb + (size_t)tok * 1024, WGU + ((size_t)e * 2048 + pn * 256 + j) * 1024, 1024) + a.in[I_BGU][e * 2048 + col];
                float up = dotbf(Hb + (size_t)tok * 1024, WGU + ((size_t)e * 2048 + pn * 256 + 128 + j) * 1024, 1024) + a.in[I_BGU][e * 2048 + 1024 + col];
                gte = fminf(gte, 7.f); up = fminf(fmaxf(up, -7.f), 7.f); const float want = (up + 1.f) * (gte / (1.f + expf(-1.702f * gte)));
                diag_max(ctl, 11 + 2 * p, relerr(bf2f(ACT[(size_t)row * 1024 + col]), want, 0.2f)); }
            else { const float want = dotbf(ACT + (size_t)row * 1024, WDN + ((size_t)e * 1024 + col) * 1024, 1024) + a.in[I_BDN][e * 1024 + col];
                diag_max(ctl, 12 + 2 * p, relerr(bf2f(Y[(size_t)ent * 1024 + col]), want, 0.2f)); } }
    } else if (which == 15 || which == 16) {
        for (int i = gt; i < 1024; i += NGT) { const unsigned h = hsh(i + 4242u); const int row = h & 65535, col = (h >> 16) & 1023, b = row >> 13;
            if (which == 15) { const f32x4 gv = *(const f32x4*)(gates + (size_t)row * 4); float ss = 0.f, fc = 0.f;
                for (int k = 0; k < 1024; ++k) { const float f = gv.x * bf2f(YA[(size_t)row * 2048 + k]) + gv.y * bf2f(YA[(size_t)row * 2048 + 1024 + k]) + gv.z * bf2f(YB[(size_t)row * 2048 + k]) + gv.w * bf2f(YB[(size_t)row * 2048 + 1024 + k]); ss += f * f; if (k == col) fc = f; }
                dbgv[i] = a.out[(size_t)row * 1024 + col] + mod[b * MODW + 5120 + col] * (fc / sqrtf(ss / 1024.f + EPS) * a.in[I_GPOST2][col]); }
            else diag_max(ctl, 15, relerr(a.out[(size_t)row * 1024 + col], dbgv[i], 0.5f) * 30.f); }
    }
}
__global__ void __launch_bounds__(256) dbg_report(Args a) {
    unsigned* ctl = (unsigned*)(a.ws + WS_CTL); int fs = -1; float fe = 0.f;
    for (int s = 15; s >= 0; --s) { const float e = __uint_as_float(ctl[CW_DIAG + s]); if (e > 0.03f) { fs = s; fe = e; } }
    if (fs < 0) return;
    int lvl = 1; float e = fe / 0.03f; while (e >= 2.f && lvl < 8) { e *= 0.5f; ++lvl; }
    float V = (float)(1 + lvl) * 1000.f; for (int s = 0; s < fs; ++s) V *= 10.f;
    const size_t n = (size_t)T * DM;
    for (size_t i = (size_t)blockIdx.x * 256 + threadIdx.x; i < n; i += (size_t)gridDim.x * 256) a.out[i] = (i == 0) ? V : 0.f;
}
static void dbg_before(int ph, const Args& a, hipStream_t st) { if (ph == 12) hipLaunchKernelGGL(dbg_chk, dim3(64), dim3(256), 0, st, a, 15, 0); }
static void dbg_after(int ph, const Args& a, hipStream_t st) {
#define CHK(w, p) hipLaunchKernelGGL(dbg_chk, dim3(64), dim3(256), 0, st, a, w, p)
    switch (ph) {
        case 0: CHK(0, 0); CHK(1, 0); break; case 1: CHK(2, 0); break; case 2: CHK(3, 0); break; case 3: CHK(4, 0); break; case 4: CHK(5, 0); break;
        case 5: CHK(6, 0); CHK(7, 0); break; case 6: CHK(8, 0); break; case 7: CHK(9, 0); CHK(10, 0); break;
        case 8: CHK(11, 0); break; case 9: CHK(12, 0); break; case 10: CHK(11, 1); break; case 11: CHK(12, 1); break;
        case 12: CHK(16, 0); hipLaunchKernelGGL(dbg_report, dim3(2048), dim3(256), 0, st, a); break;
    }
#undef CHK
}
#endif


extern "C" void kernel_launch(void* const* d_in, const int* in_sizes, int n_in, void* d_out, int out_size, void* d_ws, size_t ws_size, hipStream_t stream) {
    static int grid = 0;
    if (grid == 0) {
        if (n_in != 21 || in_sizes[0] != T * DM || out_size != T * DM || ws_size < WS_END) { fprintf(stderr, "kernel_launch: unexpected shapes (n_in %d, in0 %d, out %d, ws %zu); nothing launched\n", n_in, n_in > 0 ? in_sizes[0] : -1, out_size, ws_size); grid = -1; return; }
        int dev = 0, cus = 0, per_cu = 0;
        if (hipGetDevice(&dev) != hipSuccess || hipDeviceGetAttribute(&cus, hipDeviceAttributeMultiprocessorCount, dev) != hipSuccess) { grid = -1; return; }
        if (hipFuncSetAttribute((const void*)fwd, hipFuncAttributeMaxDynamicSharedMemorySize, LDS_BYTES) != hipSuccess) { fprintf(stderr, "kernel_launch: hipFuncSetAttribute failed\n"); grid = -1; return; }
        if (hipOccupancyMaxActiveBlocksPerMultiprocessor(&per_cu, (const void*)fwd, 512, LDS_BYTES) != hipSuccess || per_cu < 1) fprintf(stderr, "kernel_launch: occupancy query reports %d\n", per_cu);
        (void)hipGetLastError();
        grid = cus;
    }
    if (grid < 0) return;
    if (hipMemsetAsync((char*)d_ws + WS_CTL, 0, CTL_ZERO_BYTES, stream) != hipSuccess) return;
    Args a{};
    for (int i = 0; i < 21; ++i) a.in[i] = (const float*)d_in[i];
    a.out = (float*)d_out; a.ws = (unsigned char*)d_ws;
#if MK_ONE_LAUNCH
    a.ph_lo = 0; a.ph_hi = 13;
    hipLaunchKernelGGL(fwd, dim3(grid), dim3(512), LDS_BYTES, stream, a);
#else
    for (int ph = 0; ph < 13; ++ph) {
        a.ph_lo = ph; a.ph_hi = ph + 1;
#if MK_DEBUG
        dbg_before(ph, a, stream);
#endif
        hipLaunchKernelGGL(fwd, dim3(grid), dim3(512), LDS_BYTES, stream, a);
#if MK_DEBUG
        dbg_after(ph, a, stream);
#endif
    }
#endif
}
```

```cpp
#include <hip/hip_runtime.h>
#include <cstdio>
#include <cstdint>

#ifndef MK_DEBUG
#define MK_DEBUG 0
#endif
#ifndef MK_ONE_LAUNCH
#define MK_ONE_LAUNCH 1
#endif

#define GAS __attribute__((address_space(1)))
#define LAS __attribute__((address_space(3)))
typedef unsigned short bf16;
typedef short bf16x8 __attribute__((ext_vector_type(8)));
typedef short s16x4 __attribute__((ext_vector_type(4)));
typedef float f32x4 __attribute__((ext_vector_type(4)));
typedef float f32x2 __attribute__((ext_vector_type(2)));
typedef float f32x16 __attribute__((ext_vector_type(16)));
typedef unsigned u32x4 __attribute__((ext_vector_type(4)));
typedef unsigned u32x2 __attribute__((ext_vector_type(2)));
typedef __bf16 bf16x2_t __attribute__((ext_vector_type(2)));

constexpr int NB = 8, SEQ = 8192, DM = 1024, T = NB * SEQ;
constexpr int NIN = 2048, IN_W = 1952;
constexpr int C_CKV = 256, C_KR = 384, C_QC = 416, C_KC = 928, C_VC = 1440;
constexpr int NE = 32;
constexpr int KQKV = 384, NQKV = 1792;
constexpr float EPS = 1e-6f;
constexpr float LOG2E = 1.4426950408889634f;
constexpr float C2M = 0.10206207261596577f * 1.4426950408889634f;
constexpr float C2C = 0.125f * 1.4426950408889634f;
constexpr int MODW = 6 * DM;

constexpr size_t MiB = 1u << 20;
constexpr size_t WS_CTL = 0, CTL_ZERO_BYTES = 1 * MiB;
constexpr size_t WS_MOD = 1 * MiB;
constexpr size_t WS_WRT = 1 * MiB + 256 * 1024;
constexpr size_t WS_GATE = 2 * MiB;
constexpr size_t WS_ROPE = 3 * MiB;
constexpr size_t WS_WQKV = 4 * MiB;
constexpr size_t WS_TINFO = 6 * MiB;
constexpr size_t WS_LIST = 8 * MiB;
constexpr size_t WS_WIN = 24 * MiB;
constexpr size_t WS_WO = 28 * MiB;
constexpr size_t WS_DBG = 30 * MiB;
constexpr size_t WS_WDN = 32 * MiB;
constexpr size_t WS_WGU = 64 * MiB;
constexpr size_t WS_H = 128 * MiB;
constexpr size_t WS_ACT = 192 * MiB;
constexpr size_t WS_Z = 256 * MiB;
constexpr size_t WS_OP = 256 * MiB;
constexpr size_t WS_QM = 512 * MiB;
constexpr size_t WS_KM = 608 * MiB;
constexpr size_t WS_VM = 704 * MiB;
constexpr size_t WS_O = 768 * MiB;
constexpr size_t WS_Y = 512 * MiB;
constexpr size_t WS_END = 1024 * MiB;
constexpr float W8S = 32.f, A8S = 4.f;
constexpr int LIST_CAP = 65536;

constexpr int CW_TMO = 0, CW_CODE = 1;
constexpr int CW_BAR = 4096;
constexpr int CW_CNT = 8192;
constexpr int CW_DIAG = 8320;

constexpr int LDS_BYTES = 147456;
constexpr int MISC_OFF = LDS_BYTES - 256;
constexpr int TAB_OFF = 139264;

__device__ __forceinline__ unsigned f2bf(float f) { unsigned u = __builtin_bit_cast(unsigned, f); return (u + 0x7fffu + ((u >> 16) & 1u)) >> 16; }
__device__ __forceinline__ float bf2f(unsigned b) { return __builtin_bit_cast(float, (b & 0xffffu) << 16); }
__device__ __forceinline__ unsigned pk2(float lo, float hi) { f32x2 v = {lo, hi}; bf16x2_t b = __builtin_convertvector(v, bf16x2_t); return __builtin_bit_cast(unsigned, b); }
__device__ __forceinline__ float wave_sum(float v) {
#pragma unroll
    for (int o = 1; o < 64; o <<= 1) v += __shfl_xor(v, o);
    return v;
}
__device__ __forceinline__ unsigned pk4_fp8(float a, float b, float c, float d) { unsigned w = 0; w = __builtin_amdgcn_cvt_pk_fp8_f32(a, b, w, false); w = __builtin_amdgcn_cvt_pk_fp8_f32(c, d, w, true); return w; }
#define LDS_WAIT() asm volatile("s_waitcnt lgkmcnt(0)" ::: "memory")
#define VM_WAIT() asm volatile("s_waitcnt vmcnt(0)" ::: "memory")

namespace pg8 {
typedef unsigned short bf16_t;
constexpr int BM = 256, BK = 64, HALF = 128, HTB = HALF * BK * 2, STAGE_BYTES = 8 * HTB;
__host__ __device__ __forceinline__ int lds_byte(int r, int c) { const int st = (r >> 4) * 2 + (c >> 5), rr = r & 15, cc = c & 31, ob = rr * 64 + cc * 2; return st * 1024 + (ob ^ (((ob >> 9) & 1) << 5)); }
__host__ __device__ __forceinline__ void stage_rc(int b, int& R, int& C) { const int st = b / 1024, sb = b % 1024, swz = sb ^ (((sb >> 9) & 1) << 5); R = (st >> 1) * 16 + swz / 64; C = (st & 1) * 32 + (swz % 64) / 2; }
__host__ __device__ __forceinline__ int perm32(int rho) { const int n = rho >> 4, i = rho & 15; return 8 * (i >> 2) + 4 * n + (i & 3); }

struct Unit { int pm, pn, brow, e, nvalid, orow; };
struct Gemm { const void* A; const void* Bt; int KB; };
typedef int v8i __attribute__((ext_vector_type(8)));
typedef int v4i __attribute__((ext_vector_type(4)));

__device__ __forceinline__ void glds_s(unsigned voff, const void* sbase, unsigned lds_dst) { unsigned keep;
    asm volatile("s_mov_b32 %0, m0\n\ts_mov_b32 m0, %3\n\ts_nop 0\n\tglobal_load_lds_dwordx4 %1, %2\n\ts_mov_b32 m0, %0" : "=&s"(keep) : "v"(voff), "s"(sbase), "s"(lds_dst) : "memory"); }
template <class Epi, class Sched, bool ALIGN_EPI, bool FP8>
__device__ __forceinline__ void gemm_phase(LAS unsigned char* lds, const Gemm g, const Sched& S, const Epi& E) {
    const int tid = threadIdx.x, wid = __builtin_amdgcn_readfirstlane(tid >> 6), lane = tid & 63, wr = wid >> 2, wc = wid & 3, fr = lane & 15, fq = lane >> 4;
    const int KB = g.KB, nt = KB / 128;
    int RA[2]; unsigned CA2[2], voffB[2];
#pragma unroll
    for (int i = 0; i < 2; ++i) { int R, C; stage_rc(tid * 16 + i * 8192, R, C); const int Rb = (R & ~31) + perm32(R & 31);
        RA[i] = R; CA2[i] = (unsigned)C * 2u; voffB[i] = (unsigned)(Rb * KB + C * 2); }
    const size_t kstep = (size_t)(BK * 2);
    const size_t hstep = (size_t)HALF * KB;
    const unsigned ldsw = (unsigned)wid * 1024u, ldsb = (unsigned)(uintptr_t)lds;
    const int aoff = lds_byte(wr * 64 + fr, fq * 8), boff = lds_byte(wc * 32 + fr, fq * 8);
#define PG8_SA(b, h) (((b) * 2 + (h)) * HTB)
#define PG8_SB(b, h) ((4 + (b) * 2 + (h)) * HTB)
#define PG8_STAGE(bufoff, gbase, voff) do { _Pragma("unroll") for (int _i = 0; _i < 2; ++_i) \
        glds_s((voff)[_i], (const void*)(gbase), (unsigned)__builtin_amdgcn_readfirstlane(ldsb + (unsigned)(bufoff) + ldsw + _i * 8192)); } while (0)
#define PG8_LDA(dst, b, h) do { _Pragma("unroll") for (int m = 0; m < 4; ++m) { \
        const v4i l0_ = *(const LAS v4i*)(lds + PG8_SA(b, h) + aoff + m * 2048), l1_ = *(const LAS v4i*)(lds + PG8_SA(b, h) + aoff + m * 2048 + 1024); \
        dst[m] = __builtin_shufflevector(l0_, l1_, 0, 1, 2, 3, 4, 5, 6, 7); } } while (0)
#define PG8_LDB(dst, b, h) do { _Pragma("unroll") for (int n = 0; n < 2; ++n) { \
        const v4i l0_ = *(const LAS v4i*)(lds + PG8_SB(b, h) + boff + n * 2048), l1_ = *(const LAS v4i*)(lds + PG8_SB(b, h) + boff + n * 2048 + 1024); \
        dst[n] = __builtin_shufflevector(l0_, l1_, 0, 1, 2, 3, 4, 5, 6, 7); } } while (0)
#define PG8_MMA(ai, bj, At, Bt) do { __builtin_amdgcn_s_setprio(1); _Pragma("unroll") for (int m = 0; m < 4; ++m) _Pragma("unroll") for (int n = 0; n < 2; ++n) { \
        if constexpr (FP8) acc[ai][bj][m][n] = __builtin_amdgcn_mfma_scale_f32_16x16x128_f8f6f4(Bt[n], At[m], acc[ai][bj][m][n], 0, 0, 0, 0x7F7F7F7F, 0, 0x7F7F7F7F); \
        else { acc[ai][bj][m][n] = __builtin_amdgcn_mfma_f32_16x16x32_bf16(__builtin_bit_cast(bf16x8, __builtin_shufflevector(Bt[n], Bt[n], 0, 1, 2, 3)), __builtin_bit_cast(bf16x8, __builtin_shufflevector(At[m], At[m], 0, 1, 2, 3)), acc[ai][bj][m][n], 0, 0, 0); \
               acc[ai][bj][m][n] = __builtin_amdgcn_mfma_f32_16x16x32_bf16(__builtin_bit_cast(bf16x8, __builtin_shufflevector(Bt[n], Bt[n], 4, 5, 6, 7)), __builtin_bit_cast(bf16x8, __builtin_shufflevector(At[m], At[m], 4, 5, 6, 7)), acc[ai][bj][m][n], 0, 0, 0); } } \
        __builtin_amdgcn_s_setprio(0); } while (0)
#define PG8_WAIT_V(n) asm volatile("s_waitcnt vmcnt(" #n ")" ::: "memory")
#define PG8_WAIT_L(n) asm volatile("s_waitcnt lgkmcnt(" #n ")" ::: "memory")
#define PG8_BAR __builtin_amdgcn_s_barrier()
#define PG8_SCHED __builtin_amdgcn_sched_barrier(0)
#define PG8_OFFS(dst, u) do { _Pragma("unroll") for (int _h = 0; _h < 2; ++_h) _Pragma("unroll") for (int _i = 0; _i < 2; ++_i) dst[_h][_i] = S.arow_off(u, _h * HALF + RA[_i]) + CA2[_i]; } while (0)
    Unit cur, nxt; int ui = 0;
    if (!S.next(0, cur)) return;
    bool has_next = S.next(1, nxt);
    unsigned cvo[2][2], nvo[2][2];
    PG8_OFFS(cvo, cur);
    if (has_next) PG8_OFFS(nvo, nxt); else { nvo[0][0] = cvo[0][0]; nvo[0][1] = cvo[0][1]; nvo[1][0] = cvo[1][0]; nvo[1][1] = cvo[1][1]; }
    f32x4 acc[2][2][4][2];
#pragma unroll
    for (int a = 0; a < 2; ++a)
#pragma unroll
        for (int b = 0; b < 2; ++b)
#pragma unroll
            for (int m = 0; m < 4; ++m)
#pragma unroll
                for (int n = 0; n < 2; ++n) acc[a][b][m][n] = (f32x4){0.f, 0.f, 0.f, 0.f};
    v8i At[4], B0[2], B1[2];
    const char* const Ab = (const char*)g.A;
    const char* cB = (const char*)g.Bt + (size_t)cur.brow * KB;
    VM_WAIT();
    PG8_STAGE(PG8_SB(0, 0), cB, voffB); PG8_STAGE(PG8_SB(0, 1), cB + hstep, voffB); PG8_STAGE(PG8_SA(0, 0), Ab, cvo[0]); PG8_STAGE(PG8_SA(0, 1), Ab, cvo[1]);
    if (wr == 1) PG8_BAR;
    PG8_WAIT_V(2); PG8_BAR;
    PG8_STAGE(PG8_SB(1, 0), cB + kstep, voffB); PG8_STAGE(PG8_SA(1, 0), Ab + kstep, cvo[0]); PG8_STAGE(PG8_SB(1, 1), cB + hstep + kstep, voffB);
    PG8_WAIT_V(6); PG8_BAR;
    for (;;) {
        const char* nB = has_next ? (const char*)g.Bt + (size_t)nxt.brow * KB : cB;
#pragma unroll 1
        for (int t = 0; t < nt; t += 2) {
            const bool last = (t == nt - 2);
            const char* a1 = Ab + (size_t)(t + 1) * kstep;
            const char* a2 = last ? Ab : Ab + (size_t)(t + 2) * kstep; const char* b2 = last ? nB : cB + (size_t)(t + 2) * kstep;
            const char* a3 = a2 + kstep; const char* b3 = b2 + kstep;
            unsigned vo2[2][2];
#pragma unroll
            for (int _h = 0; _h < 2; ++_h)
#pragma unroll
                for (int _i = 0; _i < 2; ++_i) vo2[_h][_i] = last ? nvo[_h][_i] : cvo[_h][_i];
            PG8_LDB(B0, 0, 0); PG8_LDB(B1, 0, 1); PG8_SCHED; PG8_LDA(At, 0, 0); PG8_STAGE(PG8_SA(1, 1), a1, cvo[1]);
            PG8_WAIT_V(8); PG8_WAIT_L(0); PG8_BAR; PG8_MMA(0, 0, At, B0); PG8_MMA(0, 1, At, B1); PG8_BAR; PG8_SCHED;
            PG8_LDA(At, 0, 1); PG8_STAGE(PG8_SB(0, 0), b2, voffB); PG8_STAGE(PG8_SB(0, 1), b2 + hstep, voffB); PG8_STAGE(PG8_SA(0, 0), a2, vo2[0]);
            PG8_WAIT_V(8); PG8_WAIT_L(0); PG8_BAR; PG8_MMA(1, 0, At, B0); PG8_MMA(1, 1, At, B1); PG8_BAR; PG8_SCHED;
            PG8_LDB(B0, 1, 0); PG8_LDB(B1, 1, 1); PG8_SCHED; PG8_LDA(At, 1, 0); PG8_STAGE(PG8_SA(0, 1), a2, vo2[1]);
            PG8_WAIT_V(8); PG8_WAIT_L(0); PG8_BAR; PG8_MMA(0, 0, At, B0); PG8_MMA(0, 1, At, B1); PG8_BAR; PG8_SCHED;
            PG8_LDA(At, 1, 1); PG8_STAGE(PG8_SB(1, 0), b3, voffB); PG8_STAGE(PG8_SB(1, 1), b3 + hstep, voffB); PG8_STAGE(PG8_SA(1, 0), a3, vo2[0]);
            PG8_WAIT_V(8); PG8_WAIT_L(0); PG8_BAR; PG8_MMA(1, 0, At, B0); PG8_MMA(1, 1, At, B1); PG8_BAR; PG8_SCHED;
        }
        if constexpr (ALIGN_EPI) { if (wr == 0) PG8_BAR; }
        { int fr_ = fr, fq_ = fq; asm volatile("" : "+v"(fr_), "+v"(fq_));
          E(acc, cur, wr, wc, fr_, fq_); }
        if (!has_next) break;
#pragma unroll
        for (int a = 0; a < 2; ++a)
#pragma unroll
            for (int b = 0; b < 2; ++b)
#pragma unroll
                for (int m = 0; m < 4; ++m)
#pragma unroll
                    for (int n = 0; n < 2; ++n) acc[a][b][m][n] = (f32x4){0.f, 0.f, 0.f, 0.f};
        cur = nxt; cB = nB; ++ui;
#pragma unroll
        for (int _h = 0; _h < 2; ++_h)
#pragma unroll
            for (int _i = 0; _i < 2; ++_i) cvo[_h][_i] = nvo[_h][_i];
        has_next = S.next(ui + 1, nxt);
        if (has_next) PG8_OFFS(nvo, nxt);
        if constexpr (ALIGN_EPI) { if (wr == 1) PG8_BAR; }
    }
    PG8_WAIT_V(0);
    if constexpr (!ALIGN_EPI) { if (wr == 0) PG8_BAR; }
    PG8_BAR;
#undef PG8_SA
#undef PG8_SB
#undef PG8_STAGE
#undef PG8_LDA
#undef PG8_LDB
#undef PG8_MMA
#undef PG8_WAIT_V
#undef PG8_WAIT_L
#undef PG8_BAR
#undef PG8_SCHED
#undef PG8_OFFS
}

struct DenseSched {
    int nN, nwg, G, c, K2;
    __device__ __forceinline__ bool next(int i, Unit& u) const {
        const int L = i * G + c; if (L >= nwg) return false;
        const int nig = 8 * nN, gid = L / nig, r = L % nig;
        u.pm = gid * 8 + (r & 7); u.pn = r >> 3; u.brow = u.pn * BM; u.e = 0; u.nvalid = BM; u.orow = u.pm * BM; return true;
    }
    __device__ __forceinline__ unsigned arow_off(const Unit& u, int r) const { return (unsigned)(u.pm * BM + r) * (unsigned)K2; }
};
struct MoeSched {
    const LAS int* tstart;
    const LAS int* cnt;
    const unsigned* list;
    int NT, G, c, nexp_rows;
    __device__ __forceinline__ bool next(int i, Unit& u) const {
        const int L = i * G + c; const int total = tstart[32] * NT; if (L >= total) return false;
        const int rt = L / NT, pn = L % NT;
        int e = 0;
#pragma unroll
        for (int st = 16; st; st >>= 1) if (tstart[e + st] <= rt) e += st;
        e = __builtin_amdgcn_readfirstlane(e);
        u.e = e; u.pm = rt - tstart[e]; u.pn = pn; u.nvalid = cnt[e] - u.pm * BM; u.orow = rt * BM; u.brow = e * nexp_rows + pn * BM; return true;
    }
    __device__ __forceinline__ unsigned arow_off(const Unit& u, int r) const {
        if (list) { int idx = u.pm * BM + r; const int c1 = cnt[u.e] - 1; idx = idx < c1 ? idx : c1; const unsigned ent = list[(size_t)u.e * LIST_CAP + idx]; return (ent >> 2) * 1024u; }
        return (unsigned)(u.orow + r) * 1024u;
    }
};

struct EpiPlain {
    bf16_t* O; int ldc;
    __device__ __forceinline__ void operator()(const f32x4 (&acc)[2][2][4][2], const Unit& u, int wr, int wc, int fr, int fq) const {
        const int row0 = u.orow + wr * 64 + fr, col0 = u.pn * BM + wc * 32 + 8 * fq;
#pragma unroll
        for (int ai = 0; ai < 2; ++ai)
#pragma unroll
            for (int m = 0; m < 4; ++m) { bf16_t* rowp = O + (size_t)(row0 + ai * HALF + m * 16) * ldc + col0;
#pragma unroll
                for (int bj = 0; bj < 2; ++bj) { const f32x4 v0 = acc[ai][bj][m][0], v1 = acc[ai][bj][m][1];
                    u32x4 w; w.x = pk2(v0[0], v0[1]); w.y = pk2(v0[2], v0[3]); w.z = pk2(v1[0], v1[1]); w.w = pk2(v1[2], v1[3]);
                    *(u32x4*)(rowp + bj * HALF) = w; } }
    }
};
struct EpiQKV {
    bf16_t* Qm; unsigned char* Km; unsigned char* Vm; const f32x2* rope;
    __device__ __forceinline__ void operator()(const f32x4 (&acc)[2][2][4][2], const Unit& u, int wr, int wc, int fr, int fq) const {
#pragma unroll
        for (int bj = 0; bj < 2; ++bj) {
            const int cb = u.pn * BM + bj * HALF + wc * 32;
            const int c0 = cb + 8 * fq;
#pragma unroll
            for (int ai = 0; ai < 2; ++ai)
#pragma unroll
                for (int m = 0; m < 4; ++m) {
                    int row = u.orow + ai * HALF + wr * 64 + m * 16 + fr;
                    asm volatile("" : "+v"(row) :: "memory");
                    const int b = row >> 13, s = row & (SEQ - 1);
                    f32x4 v0 = acc[ai][bj][m][0], v1 = acc[ai][bj][m][1];
                    if (cb < 768) {
                        const int h = cb / 96, d = c0 - h * 96;
                        v0 = v0 * C2M; v1 = v1 * C2M;
                        if (d >= 64) { const int gq = (d - 64) >> 3; const f32x2* rp = rope + s * 16 + 4 * gq;
                            const f32x2 t0 = rp[0], t1 = rp[1], t2 = rp[2], t3 = rp[3];
                            const f32x4 cs = {t0.x, t1.x, t2.x, t3.x}, sn = {t0.y, t1.y, t2.y, t3.y};
                            const f32x4 o0 = v0 * cs - v1 * sn, o1 = v1 * cs + v0 * sn; v0 = o0; v1 = o1; }
                        u32x4 w; w.x = pk2(v0[0], v0[1]); w.y = pk2(v0[2], v0[3]); w.z = pk2(v1[0], v1[1]); w.w = pk2(v1[2], v1[3]);
                        *(u32x4*)(Qm + ((size_t)(b * 8 + h) * SEQ + s) * 96 + d) = w;
                    } else {
                        const int cc = c0 - 768, h = cc >> 7, dd = cc & 127;
                        u32x4 w; w.x = pk2(v0[0], v0[1]); w.y = pk2(v0[2], v0[3]); w.z = pk2(v1[0], v1[1]); w.w = pk2(v1[2], v1[3]);
                        const size_t tile = (size_t)(b * 8 + h) * 128 + (s >> 6);
                        if (dd < 64) *(u32x4*)(Km + tile * 12288 + (dd >> 3) * 1024 + (s & 63) * 16) = w;
                        else { const int d = dd - 64; *(u32x4*)(Vm + tile * 8192 + (d >> 5) * 4096 + ((s & 63) >> 4) * 1024 + (s & 15) * 64 + (d & 31) * 2) = w; }
                    }
                }
        }
    }
};
struct EpiGU {
    unsigned char* act; const float* bgu;
    __device__ __forceinline__ void operator()(const f32x4 (&acc)[2][2][4][2], const Unit& u, int wr, int wc, int fr, int fq) const {
        const int cl = u.pn * 128 + wc * 32 + 8 * fq;
        const float* bg = bgu + (size_t)u.e * 2048 + cl; const float* bu = bg + 1024;
        const f32x4 bg0 = *(const f32x4*)bg, bg1 = *(const f32x4*)(bg + 4), bu0 = *(const f32x4*)bu, bu1 = *(const f32x4*)(bu + 4);
        constexpr float USC = 1.f / (W8S * A8S);
#pragma unroll
        for (int ai = 0; ai < 2; ++ai)
#pragma unroll
            for (int m = 0; m < 4; ++m) {
                const int row = u.orow + ai * HALF + wr * 64 + m * 16 + fr;
                float r8[8];
#pragma unroll
                for (int n = 0; n < 2; ++n)
#pragma unroll
                    for (int j = 0; j < 4; ++j) {
                        float gt = acc[ai][0][m][n][j] * USC + (n ? bg1[j] : bg0[j]); float up = acc[ai][1][m][n][j] * USC + (n ? bu1[j] : bu0[j]);
                        gt = fminf(gt, 7.f); up = fminf(fmaxf(up, -7.f), 7.f);
                        const float sg = __builtin_amdgcn_rcpf(1.f + __builtin_amdgcn_exp2f(gt * (-1.702f * LOG2E)));
                        r8[n * 4 + j] = (up + 1.f) * (gt * sg) * A8S;
                    }
                *(u32x2*)(act + (size_t)row * 1024 + cl) = (u32x2){pk4_fp8(r8[0], r8[1], r8[2], r8[3]), pk4_fp8(r8[4], r8[5], r8[6], r8[7])};
            }
    }
};
struct EpiDN {
    bf16_t* y; const float* bdn; const unsigned* list;
    __device__ __forceinline__ void operator()(const f32x4 (&acc)[2][2][4][2], const Unit& u, int wr, int wc, int fr, int fq) const {
        const int col0 = u.pn * BM + wc * 32 + 8 * fq;
        const float* bp = bdn + (size_t)u.e * 1024 + col0;
        f32x4 bv[2][2];
#pragma unroll
        for (int bj = 0; bj < 2; ++bj) { bv[bj][0] = *(const f32x4*)(bp + bj * HALF); bv[bj][1] = *(const f32x4*)(bp + bj * HALF + 4); }
#pragma unroll
        for (int ai = 0; ai < 2; ++ai)
#pragma unroll
            for (int m = 0; m < 4; ++m) {
                const int r = ai * HALF + wr * 64 + m * 16 + fr;
                if (r < u.nvalid) {
                    const unsigned ent = list[(size_t)u.e * LIST_CAP + u.pm * BM + r];
                    bf16_t* rowp = y + (size_t)ent * 1024 + col0;
#pragma unroll
                    for (int bj = 0; bj < 2; ++bj) { const f32x4 v0 = acc[ai][bj][m][0] * (1.f / (W8S * A8S)) + bv[bj][0], v1 = acc[ai][bj][m][1] * (1.f / (W8S * A8S)) + bv[bj][1];
                        u32x4 w; w.x = pk2(v0[0], v0[1]); w.y = pk2(v0[2], v0[3]); w.z = pk2(v1[0], v1[1]); w.w = pk2(v1[2], v1[3]);
                        *(u32x4*)(rowp + bj * HALF) = w; }
                }
            }
    }
};
}

namespace att {
constexpr int LK = 0, KSL = 12288, LV = 3 * KSL, VSL = 8192, LWS = LV + 3 * VSL, LOST = LWS + 8 * 256, LBT = LOST + 8 * 4096, LEND = LBT + 320 * 4;
constexpr float THR = 8.f;
__device__ __forceinline__ int crow(int r, int hi) { return (r & 3) + 8 * (r >> 2) + 4 * hi; }
__device__ __forceinline__ void glds16(const void* gsrc, unsigned lds_dst) { unsigned keep;
    asm volatile("s_mov_b32 %0, m0\n\ts_mov_b32 m0, %2\n\ts_nop 0\n\tglobal_load_lds_dwordx4 %1, off\n\ts_mov_b32 m0, %0" : "=&s"(keep) : "v"(gsrc), "s"(lds_dst) : "memory"); }
#define ATT_WAITBAR(N) asm volatile("s_waitcnt vmcnt(" #N ") lgkmcnt(0)\n\ts_barrier" ::: "memory")
__device__ __forceinline__ float rowmax(const f32x16& p0, const f32x16& p1) {
    float a = fmaxf(p0[0], p1[0]);
#pragma unroll
    for (int r = 1; r < 16; ++r) a = fmaxf(a, fmaxf(p0[r], p1[r]));
    auto rr = __builtin_amdgcn_permlane32_swap(__float_as_uint(a), __float_as_uint(a), false, false);
    return fmaxf(__uint_as_float(rr[0]), __uint_as_float(rr[1]));
}
template <int ND0> __device__ __forceinline__ void qkt(f32x16& p0, f32x16& p1, const LAS char* kb, const bf16x8* qr) {
    const f32x16 z = {0.f, 0.f, 0.f, 0.f, 0.f, 0.f, 0.f, 0.f, 0.f, 0.f, 0.f, 0.f, 0.f, 0.f, 0.f, 0.f};
#pragma unroll
    for (int d0 = 0; d0 < ND0; ++d0) {
        const bf16x8 b0 = *(const LAS bf16x8*)(kb + d0 * 2048);
        const bf16x8 b1 = *(const LAS bf16x8*)(kb + d0 * 2048 + 512);
        if (d0 == 0) { p0 = __builtin_amdgcn_mfma_f32_32x32x16_bf16(b0, qr[0], z, 0, 0, 0); p1 = __builtin_amdgcn_mfma_f32_32x32x16_bf16(b1, qr[0], z, 0, 0, 0); }
        else { p0 = __builtin_amdgcn_mfma_f32_32x32x16_bf16(b0, qr[d0], p0, 0, 0, 0); p1 = __builtin_amdgcn_mfma_f32_32x32x16_bf16(b1, qr[d0], p1, 0, 0, 0); }
    }
}
__device__ __forceinline__ void pv(f32x16& o0, f32x16& o1, int vb, bf16x8 pa0, bf16x8 pa1, bf16x8 pa2, bf16x8 pa3) {
#pragma unroll
    for (int d0 = 0; d0 < 2; ++d0) { s16x4 lo[4], hi[4];
#pragma unroll
        for (int ks = 0; ks < 4; ++ks) {
            asm volatile("ds_read_b64_tr_b16 %0,%1 offset:%c2" : "=&v"(lo[ks]) : "v"(vb), "i"(d0 * 4096 + ks * 1024) : "memory");
            asm volatile("ds_read_b64_tr_b16 %0,%1 offset:%c2" : "=&v"(hi[ks]) : "v"(vb), "i"(d0 * 4096 + ks * 1024 + 512) : "memory"); }
        asm volatile("s_waitcnt lgkmcnt(0)" ::: "memory"); __builtin_amdgcn_sched_barrier(0);
#define ATT_PK(k) (bf16x8){lo[k][0], lo[k][1], lo[k][2], lo[k][3], hi[k][0], hi[k][1], hi[k][2], hi[k][3]}
        f32x16& o = d0 ? o1 : o0;
        o = __builtin_amdgcn_mfma_f32_32x32x16_bf16(pa0, ATT_PK(0), o, 0, 0, 0);
        o = __builtin_amdgcn_mfma_f32_32x32x16_bf16(pa1, ATT_PK(1), o, 0, 0, 0);
        o = __builtin_amdgcn_mfma_f32_32x32x16_bf16(pa2, ATT_PK(2), o, 0, 0, 0);
        o = __builtin_amdgcn_mfma_f32_32x32x16_bf16(pa3, ATT_PK(3), o, 0, 0, 0);
#undef ATT_PK
    }
}
__device__ __forceinline__ void softmax_pv(f32x16& p0, f32x16& p1, bool first, float& mref, float& l, f32x16& o0, f32x16& o1, LAS float* wsf, int r32, int hi, int vb) {
    const float rm = rowmax(p0, p1);
    bool resc = false;
    if (first) mref = rm;
    else if (__any(rm > mref + THR)) { const float mn = fmaxf(mref, rm); const float f = __builtin_amdgcn_exp2f(mref - mn); l *= f; if (hi == 0) wsf[r32] = f; mref = mn; resc = true; }
    float sacc = 0.f;
#pragma unroll
    for (int r = 0; r < 16; ++r) { p0[r] = __builtin_amdgcn_exp2f(p0[r] - mref); p1[r] = __builtin_amdgcn_exp2f(p1[r] - mref); sacc += p0[r] + p1[r]; }
    l += sacc;
    u32x4 w0, w1, w2, w3;
    w0 = (u32x4){pk2(p0[0], p0[1]), pk2(p0[2], p0[3]), pk2(p0[4], p0[5]), pk2(p0[6], p0[7])};
    w1 = (u32x4){pk2(p0[8], p0[9]), pk2(p0[10], p0[11]), pk2(p0[12], p0[13]), pk2(p0[14], p0[15])};
    w2 = (u32x4){pk2(p1[0], p1[1]), pk2(p1[2], p1[3]), pk2(p1[4], p1[5]), pk2(p1[6], p1[7])};
    w3 = (u32x4){pk2(p1[8], p1[9]), pk2(p1[10], p1[11]), pk2(p1[12], p1[13]), pk2(p1[14], p1[15])};
    if (resc) { LDS_WAIT();
#pragma unroll
        for (int r = 0; r < 16; ++r) { const float f = wsf[crow(r, hi)]; o0[r] *= f; o1[r] *= f; } }
    pv(o0, o1, vb, __builtin_bit_cast(bf16x8, w0), __builtin_bit_cast(bf16x8, w1), __builtin_bit_cast(bf16x8, w2), __builtin_bit_cast(bf16x8, w3));
}
__device__ __forceinline__ void attn_store(f32x16& o0, f32x16& o1, float l, bf16* Ow, LAS char* shm, int wid, int lane, int r32, int hi) {
    LAS float* wsf = (LAS float*)(shm + LWS) + wid * 64;
    { auto rr = __builtin_amdgcn_permlane32_swap(__float_as_uint(l), __float_as_uint(l), false, false); l = __uint_as_float(rr[0]) + __uint_as_float(rr[1]); }
    if (hi == 0) wsf[32 + r32] = l;
    LDS_WAIT();
    LAS bf16* stg = (LAS bf16*)(shm + LOST) + wid * 2048;
#pragma unroll
    for (int r = 0; r < 16; ++r) { const int orow = crow(r, hi); const float rl = __builtin_amdgcn_rcpf(wsf[32 + orow]);
        stg[orow * 64 + r32] = (bf16)f2bf(o0[r] * rl); stg[orow * 64 + 32 + r32] = (bf16)f2bf(o1[r] * rl); }
    LDS_WAIT();
#pragma unroll
    for (int i = 0; i < 4; ++i) { const int row = i * 8 + (lane >> 3), ch = lane & 7; const u32x4 v = *(const LAS u32x4*)(stg + row * 64 + ch * 8); *(u32x4*)(Ow + (size_t)row * 1024 + ch * 8) = v; }
}

__device__ __forceinline__ void mla_unit(int bh, int qb, const bf16* Qm, const unsigned char* Km, const unsigned char* Vm, bf16* O, LAS char* shm) {
    const int tid = threadIdx.x, lane = tid & 63, r32 = lane & 31, hi = lane >> 5; const int wid = __builtin_amdgcn_readfirstlane(tid >> 6);
    const unsigned lds0 = (unsigned)(uintptr_t)shm;
    const bf16* Qw = Qm + ((size_t)bh * SEQ + qb * 256 + wid * 32) * 96;
    const unsigned char* ksrc = Km + (size_t)bh * 128 * 12288 + wid * 1024 + lane * 16;
    const unsigned char* vsrc = Vm + (size_t)bh * 128 * 8192 + wid * 1024 + lane * 16;
    const unsigned kdst = lds0 + LK + wid * 1024, vdst = lds0 + LV + wid * 1024;
    const int NT = 4 * qb + 4, mychunk = 4 * qb + (wid >> 1);
    bf16x8 qr[6];
#pragma unroll
    for (int d0 = 0; d0 < 6; ++d0) qr[d0] = *(const bf16x8*)(Qw + (size_t)r32 * 96 + d0 * 16 + hi * 8);
    VM_WAIT();
#define MLA_DMA(t, s) do { glds16(ksrc + (size_t)(t) * 12288, (unsigned)__builtin_amdgcn_readfirstlane(kdst + (s) * KSL)); \
        if (wid < 4) glds16(ksrc + (size_t)(t) * 12288 + 8192, (unsigned)__builtin_amdgcn_readfirstlane(kdst + (s) * KSL + 8192)); \
        glds16(vsrc + (size_t)(t) * 8192, (unsigned)__builtin_amdgcn_readfirstlane(vdst + (s) * VSL)); } while (0)
    MLA_DMA(0, 0); MLA_DMA(1, 1);
    float mref = 0.f, l = 0.f; f32x16 o0, o1;
#pragma unroll
    for (int r = 0; r < 16; ++r) { o0[r] = 0.f; o1[r] = 0.f; }
    LAS float* wsf = (LAS float*)(shm + LWS) + wid * 64;
    const LAS char* kp0 = (const LAS char*)shm + LK + hi * 1024 + r32 * 16;
    const int vb0 = (int)(lds0 + LV) + ((lane >> 4) & 1) * 32 + (lane & 3) * 8 + (4 * hi + ((lane & 15) >> 2)) * 64;
    int sc = 0, sn = 2;
    for (int t = 0; t < NT; ++t) {
        if (t + 1 < NT) { if (wid < 4) ATT_WAITBAR(3); else ATT_WAITBAR(2); } else ATT_WAITBAR(0);
        if (t + 2 < NT) MLA_DMA(t + 2, sn);
        if (t <= mychunk) {
            f32x16 p0, p1;
            qkt<6>(p0, p1, kp0 + sc * KSL, qr);
            softmax_pv(p0, p1, t == 0, mref, l, o0, o1, wsf, r32, hi, vb0 + sc * VSL);
        }
        sc = (sc == 2) ? 0 : sc + 1; sn = (sn == 2) ? 0 : sn + 1;
    }
#undef MLA_DMA
    const int b = bh >> 3, h = bh & 7;
    attn_store(o0, o1, l, O + ((size_t)b * SEQ + qb * 256 + wid * 32) * 1024 + h * 64, shm, wid, lane, r32, hi);
    asm volatile("s_waitcnt lgkmcnt(0)\n\ts_barrier" ::: "memory");
}

__device__ __forceinline__ void ca_unit(int bh, int g4, const bf16* Z, const float* rel_bias, bf16* O, LAS char* shm) {
    const int tid = threadIdx.x, lane = tid & 63, r32 = lane & 31, hi = lane >> 5; const int wid = __builtin_amdgcn_readfirstlane(tid >> 6);
    const unsigned lds0 = (unsigned)(uintptr_t)shm;
    const int b = bh >> 3, h = bh & 7;
    const int c0 = 4 * g4, cq = c0 + (wid >> 1), kc_lo = c0 >= 8 ? c0 - 8 : 0, NT = c0 + 4 - kc_lo;
    const size_t rowb = (size_t)b * SEQ;
    LAS float* bt = (LAS float*)(shm + LBT);
    if (tid < 320) bt[tid] = rel_bias[h * 320 + tid] * LOG2E;
    const bf16* Qw = Z + (rowb + c0 * 64 + wid * 32 + r32) * NIN + C_QC + h * 64;
    bf16x8 qr[4];
#pragma unroll
    for (int d0 = 0; d0 < 4; ++d0) qr[d0] = *(const bf16x8*)(Qw + d0 * 16 + hi * 8);
    VM_WAIT();
    const bf16* ksrc = Z + (rowb + kc_lo * 64 + lane) * NIN + C_KC + h * 64 + wid * 8;
    const bf16* vsrc = Z + (rowb + kc_lo * 64 + 16 * (wid & 3) + (lane >> 2)) * NIN + C_VC + h * 64 + (wid >> 2) * 32 + (lane & 3) * 8;
    const unsigned kdst = lds0 + LK + wid * 1024, vdst = lds0 + LV + wid * 1024;
#define CA_DMA(t, s) do { glds16(ksrc + (size_t)(t) * 64 * NIN, (unsigned)__builtin_amdgcn_readfirstlane(kdst + (s) * KSL)); \
        glds16(vsrc + (size_t)(t) * 64 * NIN, (unsigned)__builtin_amdgcn_readfirstlane(vdst + (s) * VSL)); } while (0)
    CA_DMA(0, 0); CA_DMA(1, 1);
    float mref = 0.f, l = 0.f; f32x16 o0, o1;
#pragma unroll
    for (int r = 0; r < 16; ++r) { o0[r] = 0.f; o1[r] = 0.f; }
    LAS float* wsf = (LAS float*)(shm + LWS) + wid * 64;
    const LAS char* kp0 = (const LAS char*)shm + LK + hi * 1024 + r32 * 16;
    const int vb0 = (int)(lds0 + LV) + ((lane >> 4) & 1) * 32 + (lane & 3) * 8 + (4 * hi + ((lane & 15) >> 2)) * 64;
    const int qi = (wid & 1) * 32 + r32;
    bool first = true;
    int sc = 0, sn = 2;
    for (int t = 0; t < NT; ++t) {
        if (t + 1 < NT) ATT_WAITBAR(2); else ATT_WAITBAR(0);
        if (t + 2 < NT) CA_DMA(t + 2, sn);
        const int dist = cq - (kc_lo + t);
        if (dist >= 0 && dist <= 8) {
            f32x16 p0, p1;
            qkt<4>(p0, p1, kp0 + sc * KSL, qr);
            if (dist >= 5) { const float bc = bt[319];
#pragma unroll
                for (int r = 0; r < 16; ++r) { p0[r] = p0[r] * C2C + bc; p1[r] = p1[r] * C2C + bc; } }
            else { const int rb = dist * 64 + qi + 63;
#pragma unroll
                for (int r = 0; r < 16; ++r) { const int k0 = crow(r, hi); int i0 = rb - k0, i1 = rb - k0 - 32; i0 = i0 < 319 ? i0 : 319; i1 = i1 < 319 ? i1 : 319;
                    p0[r] = p0[r] * C2C + bt[i0]; p1[r] = p1[r] * C2C + bt[i1]; } }
            softmax_pv(p0, p1, first, mref, l, o0, o1, wsf, r32, hi, vb0 + sc * VSL);
            first = false;
        }
        sc = (sc == 2) ? 0 : sc + 1; sn = (sn == 2) ? 0 : sn + 1;
    }
#undef CA_DMA
    attn_store(o0, o1, l, O + (rowb + c0 * 64 + wid * 32) * 1024 + 512 + h * 64, shm, wid, lane, r32, hi);
    asm volatile("s_waitcnt lgkmcnt(0)\n\ts_barrier" ::: "memory");
}
}

#define XB_TMO      128
#define XB_XCNT(j)  (256  + 64 * (j))
#define XB_XSUB(j)  (1280 + 64 * (j))
#define XB_XGEN(j)  (2304 + 64 * (j))
#define XB_TOP      3328
#define XB_TOPGEN   3392
#define XCD_BAR_WORDS 3456
#define XB_SPIN_CAP (1u << 18)
__device__ __forceinline__ unsigned xb_ld(unsigned* p)              { return __hip_atomic_load(p, __ATOMIC_RELAXED, __HIP_MEMORY_SCOPE_AGENT); }
__device__ __forceinline__ unsigned xb_add(unsigned* p, unsigned v) { return __hip_atomic_fetch_add(p, v, __ATOMIC_RELAXED, __HIP_MEMORY_SCOPE_AGENT); }
__device__ __forceinline__ unsigned xb_xcc_id() { return (unsigned)__builtin_amdgcn_s_getreg((3 << 11) | 20) & 0xFu; }
#define XB_SPIN(cond, bar) do { unsigned _sp = 0; while (cond) { __builtin_amdgcn_s_sleep(1); \
    if ((++_sp & 255u) == 0u) { if (xb_ld(&(bar)[XB_TMO])) break; if (_sp > XB_SPIN_CAP) { atomicAdd(&(bar)[XB_TMO], 1u); break; } } } } while (0)
struct XcdBarrier { unsigned* bar; unsigned x; volatile LAS unsigned* st; };
__device__ __forceinline__ XcdBarrier xcd_barrier_post(unsigned* bar, volatile LAS unsigned* st) {
    XcdBarrier b; b.bar = bar; b.x = xb_xcc_id(); b.st = st;
    if (threadIdx.x == 0) (void)xb_add(&bar[XB_XCNT(b.x)], 1u);
    return b;
}
__device__ __forceinline__ void xcd_barrier_complete(unsigned* bar, unsigned x, unsigned& nloc, unsigned& nx) {
    const unsigned G = gridDim.x * gridDim.y * gridDim.z;
    unsigned sum, cnt, mine, sp = 0u;
    for (;;) {
        sum = 0u; cnt = 0u; mine = 0u;
#pragma unroll
        for (unsigned j = 0; j < 16; ++j) { const unsigned c = xb_ld(&bar[XB_XCNT(j)]); sum += c; cnt += (c > 0u) ? 1u : 0u; mine = (j == x) ? c : mine; }
        if (sum == G) break;
        __builtin_amdgcn_s_sleep(1);
        if ((++sp & 255u) == 0u) { if (xb_ld(&bar[XB_TMO])) break; if (sp > XB_SPIN_CAP) { atomicAdd(&bar[XB_TMO], 1u); break; } }
    }
    nloc = mine > 0u ? mine : 1u; nx = cnt > 0u ? cnt : 1u;
}
__device__ __forceinline__ void xcd_barrier(const XcdBarrier& b) {
    asm volatile("s_waitcnt vmcnt(0)" ::: "memory");
    __syncthreads();
    if (threadIdx.x == 0) {
        unsigned* bar = b.bar;
        __builtin_amdgcn_s_waitcnt(0);
        unsigned nloc = b.st[0], nx = b.st[1];
        if (nloc == 0u) { xcd_barrier_complete(bar, b.x, nloc, nx); b.st[0] = nloc; b.st[1] = nx; }
        const unsigned old = xb_add(&bar[XB_XSUB(b.x)], 1u);
        const unsigned gen = old / nloc;
        if (old + 1u == (gen + 1u) * nloc) {
            __builtin_amdgcn_fence(__ATOMIC_RELEASE, "agent");
            asm volatile("s_waitcnt vmcnt(0)" ::: "memory");
            const unsigned og = xb_add(&bar[XB_TOP], 1u);
            const unsigned tg = og / nx;
            if (og + 1u == (tg + 1u) * nx) xb_add(&bar[XB_TOPGEN], 1u);
            else XB_SPIN(xb_ld(&bar[XB_TOPGEN]) == tg, bar);
            __builtin_amdgcn_fence(__ATOMIC_ACQUIRE, "agent");
            xb_add(&bar[XB_XGEN(b.x)], 1u);
            asm volatile("s_waitcnt vmcnt(0)" ::: "memory");
        } else {
            XB_SPIN(xb_ld(&bar[XB_XGEN(b.x)]) == gen, bar);
            __builtin_amdgcn_fence(__ATOMIC_ACQUIRE, "agent");
            asm volatile("s_waitcnt vmcnt(0)" ::: "memory");
        }
    }
    __syncthreads();
}

struct Args { const float* in[21]; float* out; unsigned char* ws; int ph_lo, ph_hi; };
enum { I_X = 0, I_C, I_WADA, I_BADA, I_GPRE1, I_GPOST1, I_GPRE2, I_GPOST2, I_WIN, I_GQ, I_WQB, I_GKV, I_WKVB, I_RELB, I_WO, I_WR, I_BR, I_WGU, I_BGU, I_WDN, I_BDN };

__device__ __forceinline__ int qperm(int n) { const int h = n / 96, d = n - 96 * h; if (d < 64) return n; const int j = d - 64, i = j & 15, x2 = j >> 4; return h * 96 + 64 + 8 * (i >> 2) + 4 * x2 + (i & 3); }
__device__ __forceinline__ void tr_item(const float* W, int ldw, bf16* WT, int ldt, int k0, int kdst0, int nsrc0, int mode, int ndst0, LAS float* scr, int lane) {
#pragma unroll 8
    for (int i = 0; i < 32; ++i) { const int kk = 2 * i + (lane >> 5); scr[kk * 33 + (lane & 31)] = W[(size_t)(k0 + kk) * ldw + nsrc0 + (lane & 31)]; }
    LDS_WAIT(); asm volatile("" ::: "memory");
    const int c = lane & 7;
#pragma unroll
    for (int j = 0; j < 4; ++j) { const int n = (lane >> 3) + 8 * j; const LAS float* s = scr + (8 * c) * 33 + n;
        u32x4 o; o.x = pk2(s[0 * 33], s[1 * 33]); o.y = pk2(s[2 * 33], s[3 * 33]); o.z = pk2(s[4 * 33], s[5 * 33]); o.w = pk2(s[6 * 33], s[7 * 33]);
        const int dr = mode ? qperm(nsrc0 + n) : ndst0 + n;
        *(u32x4*)(WT + (size_t)dr * ldt + kdst0 + k0 + 8 * c) = o; }
    LDS_WAIT(); asm volatile("" ::: "memory");
}

__device__ __forceinline__ void tr_item8(const float* W, int ldw, unsigned char* WT, int ldt, int k0, int nsrc0, int ndst0, float scale, LAS float* scr, int lane) {
#pragma unroll 8
    for (int i = 0; i < 32; ++i) { const int kk = 2 * i + (lane >> 5); scr[kk * 33 + (lane & 31)] = W[(size_t)(k0 + kk) * ldw + nsrc0 + (lane & 31)] * scale; }
    LDS_WAIT(); asm volatile("" ::: "memory");
    const int n = lane >> 1, hf = lane & 1; const LAS float* s = scr + (32 * hf) * 33 + n;
    unsigned w[8];
#pragma unroll
    for (int q = 0; q < 8; ++q) w[q] = pk4_fp8(s[(4 * q) * 33], s[(4 * q + 1) * 33], s[(4 * q + 2) * 33], s[(4 * q + 3) * 33]);
    unsigned char* dst = WT + (size_t)(ndst0 + n) * ldt + k0 + 32 * hf;
    *(u32x4*)dst = (u32x4){w[0], w[1], w[2], w[3]}; *(u32x4*)(dst + 16) = (u32x4){w[4], w[5], w[6], w[7]};
    LDS_WAIT(); asm volatile("" ::: "memory");
}

__global__ void __launch_bounds__(512, 2) fwd(Args args) {
    extern __shared__ __attribute__((aligned(16))) unsigned char lds_raw[];
    LAS unsigned char* lds = (LAS unsigned char*)lds_raw;
    const int tid = threadIdx.x, lane = tid & 63, wave = __builtin_amdgcn_readfirstlane(tid >> 6);
    const int G = gridDim.x; const int bx = blockIdx.x; const int vcu = (G % 8 == 0) ? (bx % 8) * (G / 8) + bx / 8 : bx;
    unsigned char* ws = args.ws;
    unsigned* ctl = (unsigned*)(ws + WS_CTL);
    volatile LAS unsigned* MISC = (volatile LAS unsigned*)(lds + MISC_OFF);
    if (tid < 64) MISC[tid] = 0u;
    __syncthreads();
#if MK_ONE_LAUNCH
    XcdBarrier bar = xcd_barrier_post(ctl + CW_BAR, MISC + 8);
#define GRID_BAR() xcd_barrier(bar)
#else
#define GRID_BAR() do {} while (0)
#endif
    const int lo = args.ph_lo, hi_ph = args.ph_hi;
#ifndef PHM
#define PHM 0x1fff
#endif
#define IN(k) (((PHM >> (k)) & 1) && lo <= (k) && (k) < hi_ph)
#define BOTH(k) (IN(k) && IN((k) + 1))
    const float* x = args.in[I_X]; float* out = args.out;
    float* mod = (float*)(ws + WS_MOD); float* wrT = (float*)(ws + WS_WRT); float* gates = (float*)(ws + WS_GATE); f32x2* rope = (f32x2*)(ws + WS_ROPE);
    bf16* WQKV = (bf16*)(ws + WS_WQKV); unsigned* tinfo = (unsigned*)(ws + WS_TINFO); unsigned* lists = (unsigned*)(ws + WS_LIST);
    bf16* WIN = (bf16*)(ws + WS_WIN); bf16* WOt = (bf16*)(ws + WS_WO); unsigned char* WDN = ws + WS_WDN; unsigned char* WGU = ws + WS_WGU;
    bf16* Hb = (bf16*)(ws + WS_H); unsigned char* H8 = ws + WS_H; bf16* Z = (bf16*)(ws + WS_Z); bf16* Qm = (bf16*)(ws + WS_QM); unsigned char* Km = ws + WS_KM; unsigned char* Vm = ws + WS_VM;
    bf16* Ob = (bf16*)(ws + WS_O); bf16* OP = (bf16*)(ws + WS_OP); unsigned char* ACT = ws + WS_ACT; bf16* Y = (bf16*)(ws + WS_Y);
    const int gw = vcu * 8 + wave, NGW = G * 8, gt = vcu * 512 + tid, NGT = G * 512;

    if (IN(0)) {
        LAS float* scr = (LAS float*)(lds + wave * 16384);
        constexpr int I_GU = 32 * 16 * 64, I_DN = 32 * 16 * 32, I_IN = 16 * 61, I_O = 16 * 32, I_QB = 4 * 24, I_KVB = 2 * 32;
        constexpr int NITEMS = I_GU + I_DN + I_IN + I_O + I_QB + I_KVB;
        for (int it = gw; it < NITEMS; it += NGW) {
            int r = it;
            if (r < I_GU) { const int e = r >> 10, q = r & 1023, kb = q >> 6, nb = q & 63, nsrc0 = nb * 32, bj = nsrc0 >> 10, rem = nsrc0 & 1023, pn = rem >> 7, j0 = rem & 127;
                tr_item8(args.in[I_WGU] + (size_t)e * 1024 * 2048, 2048, WGU, 1024, kb * 64, nsrc0, e * 2048 + pn * 256 + bj * 128 + j0, W8S, scr, lane); continue; } r -= I_GU;
            if (r < I_DN) { const int e = r >> 9, q = r & 511, kb = q >> 5, nb = q & 31;
                tr_item8(args.in[I_WDN] + (size_t)e * 1024 * 1024, 1024, WDN, 1024, kb * 64, nb * 32, e * 1024 + nb * 32, W8S, scr, lane); continue; } r -= I_DN;
            if (r < I_IN) { const int kb = r / 61, nb = r % 61; tr_item(args.in[I_WIN], IN_W, WIN, 1024, kb * 64, 0, nb * 32, 0, nb * 32, scr, lane); continue; } r -= I_IN;
            if (r < I_O) { const int kb = r >> 5, nb = r & 31; tr_item(args.in[I_WO], 1024, WOt, 1024, kb * 64, 0, nb * 32, 0, nb * 32, scr, lane); continue; } r -= I_O;
            if (r < I_QB) { const int kb = r / 24, nb = r % 24; tr_item(args.in[I_WQB], 768, WQKV, KQKV, kb * 64, 0, nb * 32, 1, 0, scr, lane); continue; } r -= I_QB;
            { const int kb = r >> 5, nb = r & 31; tr_item(args.in[I_WKVB], 1024, WQKV, KQKV, kb * 64, 256, nb * 32, 0, 768 + nb * 32, scr, lane); }
        }
        const u32x4 z4 = {0u, 0u, 0u, 0u};
        for (int i = gt; i < 12288; i += NGT) *(u32x4*)((unsigned char*)WIN + (size_t)IN_W * 2048 + (size_t)i * 16) = z4;
        for (int i = gt; i < 768 * 16; i += NGT) { const int rr = i >> 4, cc = i & 15; *(u32x4*)((unsigned char*)WQKV + (size_t)rr * 768 + 512 + cc * 16) = z4; }
        for (int i = gt; i < 1024 * 32; i += NGT) { const int rr = 768 + (i >> 5), cc = i & 31; *(u32x4*)((unsigned char*)WQKV + (size_t)rr * 768 + cc * 16) = z4; }
        for (int i = gt; i < SEQ * 16; i += NGT) { const int pos = i >> 4, fi = i & 15;
            const float invf = __builtin_amdgcn_exp2f(-(float)fi * (13.287712379549449f / 16.f)); const float ang = (float)pos * invf;
            const double rev = (double)ang * 0.15915494309189535; const float fr = (float)(rev - __builtin_rint(rev));
            rope[i] = (f32x2){__builtin_amdgcn_cosf(fr), __builtin_amdgcn_sinf(fr)}; }
        for (int i = gt; i < 32 * 1024; i += NGT) { const int e = i >> 10, d = i & 1023; wrT[i] = args.in[I_WR][d * 32 + e]; }
        { const float* c = args.in[I_C] + wave * 1024; float sc[16];
#pragma unroll
            for (int i = 0; i < 16; ++i) { const float v = c[lane + 64 * i]; sc[i] = v / (1.f + __expf(-v)); }
            for (int cb = vcu; cb < 256; cb += G)
                for (int j = 0; j < 24; ++j) { const int col = cb * 24 + j; float s = 0.f;
#pragma unroll
                    for (int i = 0; i < 16; ++i) s += sc[i] * args.in[I_WADA][(size_t)(lane + 64 * i) * MODW + col];
                    s = wave_sum(s); if (lane == 0) mod[wave * MODW + col] = s + args.in[I_BADA][col]; } }
        if (BOTH(0)) GRID_BAR();
    }

    if (IN(1)) {
        for (int tile = vcu; tile < T / 256; tile += G) {
            const int row0 = tile * 256, b = row0 >> 13; const float* mb = mod + b * MODW;
            f32x4 a[4], s[4];
#pragma unroll
            for (int j = 0; j < 4; ++j) { const int d = 4 * lane + 256 * j; const f32x4 g = *(const f32x4*)(args.in[I_GPRE1] + d), sc1 = *(const f32x4*)(mb + 1024 + d); a[j] = g * (1.f + sc1); s[j] = *(const f32x4*)(mb + d); }
            for (int i = 0; i < 32; ++i) { const int row = row0 + wave * 32 + i; const f32x4* xr = (const f32x4*)(x + (size_t)row * DM) + lane;
                f32x4 v[4]; float ss = 0.f;
#pragma unroll
                for (int j = 0; j < 4; ++j) { v[j] = xr[64 * j]; ss += (v[j].x * v[j].x + v[j].y * v[j].y) + (v[j].z * v[j].z + v[j].w * v[j].w); }
                const float rstd = 1.f / sqrtf(wave_sum(ss) * (1.f / DM) + EPS);
                u32x2* o8 = (u32x2*)(Hb + (size_t)row * DM) + lane;
#pragma unroll
                for (int j = 0; j < 4; ++j) { const f32x4 hv = v[j] * rstd * a[j] + s[j]; o8[64 * j] = (u32x2){pk2(hv.x, hv.y), pk2(hv.z, hv.w)}; } }
        }
        if (BOTH(1)) GRID_BAR();
    }

    if (IN(2)) {
        pg8::Gemm g{Hb, WIN, 2048}; pg8::DenseSched S{NIN / 256, (T / 256) * (NIN / 256), G, vcu, 2048}; pg8::EpiPlain E{Z, NIN};
        pg8::gemm_phase<pg8::EpiPlain, pg8::DenseSched, true, false>(lds, g, S, E);
        if (BOTH(2)) GRID_BAR();
    }

    if (IN(3)) {
        bf16* AQ = Hb;
        const u32x2 gq2 = *(const u32x2*)(args.in[I_GQ] + 4 * lane), gq3 = *(const u32x2*)(args.in[I_GQ] + 4 * lane + 2);
        const float gq[4] = {__uint_as_float(gq2.x), __uint_as_float(gq2.y), __uint_as_float(gq3.x), __uint_as_float(gq3.y)};
        const float gk0 = args.in[I_GKV][2 * lane], gk1 = args.in[I_GKV][2 * lane + 1];
        for (int row = gw; row < T; row += NGW) {
            const bf16* zr = Z + (size_t)row * NIN;
            const u32x2 q2 = *(const u32x2*)(zr + 4 * lane); const unsigned k2 = *(const unsigned*)(zr + C_CKV + 2 * lane);
            const float q0 = bf2f(q2.x), q1 = bf2f(q2.x >> 16), q2f = bf2f(q2.y), q3 = bf2f(q2.y >> 16), c0 = bf2f(k2), c1 = bf2f(k2 >> 16);
            float x1 = 0.f, x2 = 0.f; if (lane < 16) { x1 = bf2f(zr[C_KR + lane]); x2 = bf2f(zr[C_KR + 16 + lane]); }
            const float rq = 1.f / sqrtf(wave_sum(q0 * q0 + q1 * q1 + q2f * q2f + q3 * q3) * (1.f / 256.f) + EPS);
            const float rk = 1.f / sqrtf(wave_sum(c0 * c0 + c1 * c1) * (1.f / 128.f) + EPS);
            *(u32x2*)(AQ + (size_t)row * KQKV + 4 * lane) = (u32x2){pk2(q0 * rq * gq[0], q1 * rq * gq[1]), pk2(q2f * rq * gq[2], q3 * rq * gq[3])};
            *(unsigned*)(AQ + (size_t)row * KQKV + 256 + 2 * lane) = pk2(c0 * rk * gk0, c1 * rk * gk1);
            const int pos = row & (SEQ - 1), b = row >> 13;
            const f32x2 cs = rope[pos * 16 + (lane & 15)];
            const float o1 = x1 * cs.x - x2 * cs.y, o2 = x2 * cs.x + x1 * cs.y;
            const int gq4 = lane & 3, hh = (lane >> 2) & 7;
            float v8[8];
#pragma unroll
            for (int t = 0; t < 4; ++t) { v8[t] = __shfl(o1, 4 * gq4 + t); v8[4 + t] = __shfl(o2, 4 * gq4 + t); }
            if (lane < 32) { const u32x4 w = {pk2(v8[0], v8[1]), pk2(v8[2], v8[3]), pk2(v8[4], v8[5]), pk2(v8[6], v8[7])};
                *(u32x4*)(Km + ((size_t)(b * 8 + hh) * 128 + (pos >> 6)) * 12288 + (8 + gq4) * 1024 + (pos & 63) * 16) = w; }
        }
        if (BOTH(3)) GRID_BAR();
    }

    if (IN(4)) {
        pg8::Gemm g{Hb, WQKV, KQKV * 2}; pg8::DenseSched S{NQKV / 256, (T / 256) * (NQKV / 256), G, vcu, KQKV * 2}; pg8::EpiQKV E{Qm, Km, Vm, rope};
        pg8::gemm_phase<pg8::EpiQKV, pg8::DenseSched, true, false>(lds, g, S, E);
        if (BOTH(4)) GRID_BAR();
    }

    if (IN(5)) {
        for (int v = vcu; v < 256; v += G) {
            const int bh = v >> 2, s4 = v & 3;
#pragma unroll 1
            for (int i = 0; i < 8; ++i) { const int qb = 8 * (i >> 1) + ((i & 1) ? 7 - s4 : s4); att::mla_unit(bh, qb, Qm, Km, Vm, Ob, (LAS char*)lds); }
#pragma unroll 1
            for (int i = 0; i < 8; ++i) { const int id = v * 8 + i; att::ca_unit(id >> 5, id & 31, Z, args.in[I_RELB], Ob, (LAS char*)lds); }
        }
        if (BOTH(5)) GRID_BAR();
    }

    if (IN(6)) {
        pg8::Gemm g{Ob, WOt, 2048}; pg8::DenseSched S{4, (T / 256) * 4, G, vcu, 2048}; pg8::EpiPlain E{OP, 1024};
        pg8::gemm_phase<pg8::EpiPlain, pg8::DenseSched, true, false>(lds, g, S, E);
        if (BOTH(6)) GRID_BAR();
    }

    if (IN(7)) {
        constexpr int HS = 1028;
        LAS float* Hs = (LAS float*)lds;
        LAS float* part = (LAS float*)lds;
        LAS float* Lg = (LAS float*)(lds + 132096);
        LAS int* hist = (LAS int*)(lds + 132096 + 4352);
        LAS int* gbase = hist + 64;
        unsigned* gcnt = ctl + CW_CNT;
        for (int tile = vcu; tile < T / 256; tile += G) {
            const int row0 = tile * 256, b = row0 >> 13; const float* mb = mod + b * MODW;
            f32x4 A1[4], A2[4], S2[4];
#pragma unroll
            for (int j = 0; j < 4; ++j) { const int d = 4 * lane + 256 * j;
                A1[j] = *(const f32x4*)(mb + 2048 + d) * *(const f32x4*)(args.in[I_GPOST1] + d);
                A2[j] = *(const f32x4*)(args.in[I_GPRE2] + d) * (1.f + *(const f32x4*)(mb + 4096 + d));
                S2[j] = *(const f32x4*)(mb + 3072 + d); }
            for (int grp = 0; grp < 8; ++grp) {
                const int tok0 = row0 + grp * 32;
                if (tid < 32) hist[tid] = 0;
                for (int i = 0; i < 4; ++i) { const int tl = wave * 4 + i, row = tok0 + tl;
                    const f32x4* xr = (const f32x4*)(x + (size_t)row * DM) + lane; const u32x2* pr = (const u32x2*)(OP + (size_t)row * DM) + lane;
                    f32x4 xv[4], ov[4]; float ss = 0.f;
#pragma unroll
                    for (int j = 0; j < 4; ++j) { xv[j] = xr[64 * j]; const u32x2 p = pr[64 * j]; ov[j] = (f32x4){bf2f(p.x), bf2f(p.x >> 16), bf2f(p.y), bf2f(p.y >> 16)};
                        ss += (ov[j].x * ov[j].x + ov[j].y * ov[j].y) + (ov[j].z * ov[j].z + ov[j].w * ov[j].w); }
                    const float r1 = 1.f / sqrtf(wave_sum(ss) * (1.f / DM) + EPS); float ss2 = 0.f;
                    f32x4* outr = (f32x4*)(out + (size_t)row * DM) + lane;
#pragma unroll
                    for (int j = 0; j < 4; ++j) { xv[j] = xv[j] + A1[j] * (ov[j] * r1); outr[64 * j] = xv[j]; ss2 += (xv[j].x * xv[j].x + xv[j].y * xv[j].y) + (xv[j].z * xv[j].z + xv[j].w * xv[j].w); }
                    const float r2 = 1.f / sqrtf(wave_sum(ss2) * (1.f / DM) + EPS);
                    unsigned* h8 = (unsigned*)(H8 + (size_t)row * DM) + lane;
#pragma unroll
                    for (int j = 0; j < 4; ++j) { const f32x4 hv = xv[j] * r2 * A2[j] + S2[j]; h8[64 * j] = pk4_fp8(hv.x * A8S, hv.y * A8S, hv.z * A8S, hv.w * A8S);
                        *(LAS f32x4*)(Hs + tl * HS + 4 * lane + 256 * j) = hv; } }
                __syncthreads();
                f32x16 pl;
#pragma unroll
                for (int r = 0; r < 16; ++r) pl[r] = 0.f;
                { const int tk = lane & 31, hi = lane >> 5; const LAS float* ap = Hs + tk * HS + wave * 128 + 4 * hi; const float* bp = wrT + tk * 1024 + wave * 128 + 4 * hi;
#pragma unroll 4
                    for (int m = 0; m < 16; ++m) { const f32x4 av = *(const LAS f32x4*)(ap + 8 * m); const f32x4 bv = *(const f32x4*)(bp + 8 * m);
                        pl = __builtin_amdgcn_mfma_f32_32x32x2f32(av.x, bv.x, pl, 0, 0, 0); pl = __builtin_amdgcn_mfma_f32_32x32x2f32(av.y, bv.y, pl, 0, 0, 0);
                        pl = __builtin_amdgcn_mfma_f32_32x32x2f32(av.z, bv.z, pl, 0, 0, 0); pl = __builtin_amdgcn_mfma_f32_32x32x2f32(av.w, bv.w, pl, 0, 0, 0); } }
                __syncthreads();
                { const int e = lane & 31, hi = lane >> 5;
#pragma unroll
                    for (int r = 0; r < 16; ++r) part[(wave * 32 + att::crow(r, hi)) * 33 + e] = pl[r]; }
                __syncthreads();
                { const int tk = tid & 31, e0 = (tid >> 5) * 2;
#pragma unroll
                    for (int q = 0; q < 2; ++q) { const int e = e0 + q; float s = args.in[I_BR][e];
#pragma unroll
                        for (int w = 0; w < 8; ++w) s += part[(w * 32 + tk) * 33 + e];
                        Lg[tk * 33 + e] = s; } }
                __syncthreads();
                if (wave == 0) {
                    const int tk = lane & 31, tok = tok0 + tk; int ei[4]; float ev[4]; int li[4];
                    { int c0 = -1, c1 = -1, c2 = -1;
#pragma unroll
                        for (int k = 0; k < 4; ++k) { float best = -INFINITY; int bi = 0;
                            for (int e = 0; e < 32; ++e) { const float v = Lg[tk * 33 + e]; if (e != c0 && e != c1 && e != c2 && v > best) { best = v; bi = e; } }
                            ei[k] = bi; ev[k] = best; if (k == 0) c0 = bi; else if (k == 1) c1 = bi; else if (k == 2) c2 = bi; } }
                    float gsum = 0.f, gv[4];
#pragma unroll
                    for (int k = 0; k < 4; ++k) { gv[k] = __expf(ev[k] - ev[0]); gsum += gv[k]; }
                    const float ginv = 1.f / gsum;
                    if (lane < 32) {
#pragma unroll
                        for (int k = 0; k < 4; ++k) li[k] = __hip_atomic_fetch_add(hist + ei[k], 1, __ATOMIC_RELAXED, __HIP_MEMORY_SCOPE_WORKGROUP);
                        *(f32x4*)(gates + (size_t)tok * 4) = (f32x4){gv[0] * ginv, gv[1] * ginv, gv[2] * ginv, gv[3] * ginv};
                    }
                    LDS_WAIT(); asm volatile("" ::: "memory");
                    { const int c = hist[lane & 31]; int gb = 0; if (c > 0 && lane < 32) gb = (int)__hip_atomic_fetch_add(gcnt + lane, (unsigned)c, __ATOMIC_RELAXED, __HIP_MEMORY_SCOPE_AGENT); if (lane < 32) gbase[lane] = gb; }
                    LDS_WAIT(); asm volatile("" ::: "memory");
                    if (lane < 32) {
#pragma unroll
                        for (int k = 0; k < 4; ++k) { const int e = ei[k], idx = gbase[e] + li[k];
                            lists[(size_t)e * LIST_CAP + idx] = (unsigned)tok * 4u + (unsigned)k;
                            tinfo[(size_t)tok * 4 + k] = ((unsigned)e << 16) | (unsigned)idx; }
                    }
                }
                __syncthreads();
            }
        }
        if (BOTH(7)) GRID_BAR();
    }

#define MOE_TABLES() do { LAS int* tst = (LAS int*)(lds + TAB_OFF); LAS int* cn = tst + 40; \
        if (tid < 32) cn[tid] = (int)__hip_atomic_load(ctl + CW_CNT + tid, __ATOMIC_RELAXED, __HIP_MEMORY_SCOPE_AGENT); \
        __syncthreads(); \
        if (tid == 0) { int acc_ = 0; for (int e = 0; e < 32; ++e) { tst[e] = acc_; acc_ += (cn[e] + 255) >> 8; } tst[32] = acc_; } \
        __syncthreads(); } while (0)
    if (IN(8)) { MOE_TABLES();
        pg8::Gemm g{H8, WGU, 1024}; pg8::MoeSched S{(const LAS int*)(lds + TAB_OFF), (const LAS int*)(lds + TAB_OFF) + 40, lists, 8, G, vcu, 2048};
        pg8::EpiGU E{ACT, args.in[I_BGU]}; pg8::gemm_phase<pg8::EpiGU, pg8::MoeSched, true, true>(lds, g, S, E);
        if (BOTH(8)) GRID_BAR(); }
    if (IN(9)) { MOE_TABLES();
        pg8::Gemm g{ACT, WDN, 1024}; pg8::MoeSched S{(const LAS int*)(lds + TAB_OFF), (const LAS int*)(lds + TAB_OFF) + 40, nullptr, 4, G, vcu, 1024};
        pg8::EpiDN E{Y, args.in[I_BDN], lists}; pg8::gemm_phase<pg8::EpiDN, pg8::MoeSched, true, true>(lds, g, S, E);
        if (BOTH(9)) GRID_BAR(); }

    if (IN(10)) {
        for (int tile = vcu; tile < T / 256; tile += G) {
            const int row0 = tile * 256, b = row0 >> 13; const float* mb = mod + b * MODW;
            f32x4 A3[4];
#pragma unroll
            for (int j = 0; j < 4; ++j) { const int d = 4 * lane + 256 * j; A3[j] = *(const f32x4*)(mb + 5120 + d) * *(const f32x4*)(args.in[I_GPOST2] + d); }
            for (int i = 0; i < 32; ++i) { const int row = row0 + wave * 32 + i;
                const f32x4 gv = *(const f32x4*)(gates + (size_t)row * 4);
                const u32x2* ya = (const u32x2*)(Y + (size_t)row * 4096) + lane; const u32x2* yb = ya + 512;
                f32x4 f[4]; float ss = 0.f;
#pragma unroll
                for (int j = 0; j < 4; ++j) { const u32x2 p0 = ya[64 * j], p1 = ya[256 + 64 * j], p2 = yb[64 * j], p3 = yb[256 + 64 * j];
                    f[j] = (f32x4){bf2f(p0.x), bf2f(p0.x >> 16), bf2f(p0.y), bf2f(p0.y >> 16)} * gv.x + (f32x4){bf2f(p1.x), bf2f(p1.x >> 16), bf2f(p1.y), bf2f(p1.y >> 16)} * gv.y
                         + (f32x4){bf2f(p2.x), bf2f(p2.x >> 16), bf2f(p2.y), bf2f(p2.y >> 16)} * gv.z + (f32x4){bf2f(p3.x), bf2f(p3.x >> 16), bf2f(p3.y), bf2f(p3.y >> 16)} * gv.w;
                    ss += (f[j].x * f[j].x + f[j].y * f[j].y) + (f[j].z * f[j].z + f[j].w * f[j].w); }
                const float rs = 1.f / sqrtf(wave_sum(ss) * (1.f / DM) + EPS);
                f32x4* outr = (f32x4*)(out + (size_t)row * DM) + lane;
#pragma unroll
                for (int j = 0; j < 4; ++j) outr[64 * j] = outr[64 * j] + A3[j] * (f[j] * rs); }
        }
    }
#undef IN
#undef BOTH
}


#if MK_DEBUG
__device__ __forceinline__ unsigned hsh(unsigned x) { x ^= x >> 16; x *= 0x7feb352dU; x ^= x >> 15; x *= 0x846ca68bU; x ^= x >> 16; return x; }
__device__ __forceinline__ void diag_max(unsigned* ctl, int slot, float err) { if (!(err == err)) err = 1e30f; if (err < 0.f) err = -err; atomicMax(ctl + CW_DIAG + slot, __float_as_uint(err)); }
__device__ __forceinline__ float relerr(float got, float want, float flo) { return fabsf(got - want) / (fabsf(want) + flo); }
__device__ __forceinline__ float kimg(const unsigned char* Km, int bh, int key, int d) { return bf2f(*(const bf16*)(Km + ((size_t)bh * 128 + (key >> 6)) * 12288 + (d >> 3) * 1024 + (key & 63) * 16 + (d & 7) * 2)); }
__device__ __forceinline__ float vimg(const unsigned char* Vm, int bh, int key, int d) { return bf2f(*(const bf16*)(Vm + ((size_t)bh * 128 + (key >> 6)) * 8192 + (d >> 5) * 4096 + ((key & 63) >> 4) * 1024 + (key & 15) * 64 + (d & 31) * 2)); }
__device__ __forceinline__ float f8dec(unsigned b) { const unsigned e = (b >> 3) & 15u, m = b & 7u; float v = e ? (1.f + m * 0.125f) * exp2f((float)e - 7.f) : m * 0.001953125f; return (b & 0x80u) ? -v : v; }
__device__ __forceinline__ float dot8(const unsigned char* a, const unsigned char* b, int n) { float s = 0.f; for (int k = 0; k < n; ++k) s += f8dec(a[k]) * f8dec(b[k]); return s; }
__device__ __forceinline__ unsigned f8enc(float v) { return __builtin_amdgcn_cvt_pk_fp8_f32(v, 0.f, 0u, false) & 0xffu; }
__device__ __forceinline__ float dotbf(const bf16* a, const bf16* b, int n) { float s = 0.f; for (int k = 0; k < n; ++k) s += bf2f(a[k]) * bf2f(b[k]); return s; }

__global__ void __launch_bounds__(256) dbg_chk(Args a, int which, int p) {
    unsigned char* ws = a.ws; unsigned* ctl = (unsigned*)(ws + WS_CTL);
    const int gt = blockIdx.x * 256 + threadIdx.x, NGT = gridDim.x * 256, lane = threadIdx.x & 63, gwv = gt >> 6;
    float* mod = (float*)(ws + WS_MOD); float* wrT = (float*)(ws + WS_WRT); float* gates = (float*)(ws + WS_GATE); f32x2* rope = (f32x2*)(ws + WS_ROPE);
    bf16* WQKV = (bf16*)(ws + WS_WQKV); unsigned* tinfo = (unsigned*)(ws + WS_TINFO); unsigned* lists = (unsigned*)(ws + WS_LIST);
    bf16* WIN = (bf16*)(ws + WS_WIN); bf16* WOt = (bf16*)(ws + WS_WO); unsigned char* WDN = ws + WS_WDN; unsigned char* WGU = ws + WS_WGU;
    bf16* Hb = (bf16*)(ws + WS_H); unsigned char* H8 = ws + WS_H; bf16* Z = (bf16*)(ws + WS_Z); bf16* Qm = (bf16*)(ws + WS_QM); unsigned char* Km = ws + WS_KM; unsigned char* Vm = ws + WS_VM;
    bf16* Ob = (bf16*)(ws + WS_O); bf16* OP = (bf16*)(ws + WS_OP); unsigned char* ACT = ws + WS_ACT; bf16* Y = (bf16*)(ws + WS_Y);
    float* dbgv = (float*)(ws + WS_DBG); unsigned* gcnt = ctl + CW_CNT;
    const float* x = a.in[I_X];
    if (which == 0) {
        for (int i = gt; i < 65536; i += NGT) { const unsigned h = hsh(i), h2 = hsh(i + 77777u);
            { const int n = h & 2047, k = (h >> 11) & 1023; const unsigned want = n < IN_W ? f2bf(a.in[I_WIN][(size_t)k * IN_W + n]) : 0u; if (want != WIN[(size_t)n * 1024 + k]) diag_max(ctl, 0, 10.f); }
            { const int n = h & 1023, k = (h >> 10) & 1023; if (f2bf(a.in[I_WO][(size_t)k * 1024 + n]) != WOt[(size_t)n * 1024 + k]) diag_max(ctl, 0, 11.f); }
            { const int e = h2 & 31, rr = (h2 >> 5) & 2047, k = (h2 >> 16) & 1023, pn = rr >> 8, bj = (rr >> 7) & 1, j = rr & 127, col = bj * 1024 + pn * 128 + j;
              if (f8enc(a.in[I_WGU][((size_t)e * 1024 + k) * 2048 + col] * W8S) != WGU[((size_t)e * 2048 + rr) * 1024 + k]) diag_max(ctl, 0, 12.f); }
            { const int e = h2 & 31, n = (h2 >> 5) & 1023, k = (h2 >> 16) & 1023; if (f8enc(a.in[I_WDN][((size_t)e * 1024 + k) * 1024 + n] * W8S) != WDN[((size_t)e * 1024 + n) * 1024 + k]) diag_max(ctl, 0, 13.f); }
            { const int ns = h % 768, k = (h >> 10) % 384; const unsigned want = k < 256 ? f2bf(a.in[I_WQB][(size_t)k * 768 + ns]) : 0u; if (want != WQKV[(size_t)qperm(ns) * KQKV + k]) diag_max(ctl, 0, 14.f); }
            { const int n = h2 & 1023, k = (h2 >> 10) % 384; const unsigned want = k >= 256 ? f2bf(a.in[I_WKVB][(size_t)(k - 256) * 1024 + n]) : 0u; if (want != WQKV[(size_t)(768 + n) * KQKV + k]) diag_max(ctl, 0, 15.f); }
        }
    } else if (which == 1) {
        for (int i = gt; i < 2048; i += NGT) { const unsigned h = hsh(i); const int b = h & 7, j = (h >> 3) % MODW; float s = 0.f;
            for (int k = 0; k < 1024; ++k) { const float v = a.in[I_C][b * 1024 + k]; s += (v / (1.f + expf(-v))) * a.in[I_WADA][(size_t)k * MODW + j]; }
            diag_max(ctl, 1, relerr(mod[b * MODW + j], s + a.in[I_BADA][j], 0.1f) * 30.f); }
        for (int i = gt; i < 4096; i += NGT) { const unsigned h = hsh(i + 999u); const int pos = h & 8191, fi = (h >> 13) & 15;
            const float invf = __builtin_amdgcn_exp2f(-(float)fi * (13.287712379549449f / 16.f)); const float ang = (float)pos * invf;
            const double tp = 6.283185307179586; double r = (double)ang; r -= tp * __builtin_rint(r / tp); const double r2 = r * r; double sn = r, cs = 1.0, ts = r, tc = 1.0;
            for (int n = 1; n <= 14; ++n) { tc *= -r2 / (double)((2 * n - 1) * (2 * n)); cs += tc; ts *= -r2 / (double)((2 * n) * (2 * n + 1)); sn += ts; }
            const f32x2 g = rope[pos * 16 + fi]; diag_max(ctl, 1, (fabsf(g.x - (float)cs) + fabsf(g.y - (float)sn)) * 30.f); }
        for (int i = gt; i < 32768; i += NGT) { const int e = i >> 10, d = i & 1023; if (wrT[i] != a.in[I_WR][d * 32 + e]) diag_max(ctl, 1, 9.f); }
    } else if (which == 2) {
        for (int i = gt; i < 2048; i += NGT) { const unsigned h = hsh(i); const int row = h & 65535, col = (h >> 16) & 1023, b = row >> 13; float ss = 0.f;
            for (int k = 0; k < 1024; ++k) { const float v = x[(size_t)row * 1024 + k]; ss += v * v; }
            const float rstd = 1.f / sqrtf(ss / 1024.f + EPS); const float want = x[(size_t)row * 1024 + col] * rstd * a.in[I_GPRE1][col] * (1.f + mod[b * MODW + 1024 + col]) + mod[b * MODW + col];
            diag_max(ctl, 2, relerr(bf2f(Hb[(size_t)row * 1024 + col]), want, 0.5f)); }
    } else if (which == 3) {
        for (int i = gt; i < 4096; i += NGT) { const unsigned h = hsh(i); const int row = h & 65535, n = (h >> 16) % IN_W;
            diag_max(ctl, 3, relerr(bf2f(Z[(size_t)row * NIN + n]), dotbf(Hb + (size_t)row * 1024, WIN + (size_t)n * 1024, 1024), 0.5f)); }
    } else if (which == 4) {
        bf16* AQ = Hb;
        for (int i = gt; i < 2048; i += NGT) { const unsigned h = hsh(i); const int row = h & 65535, col = (h >> 16) % 384; const bf16* zr = Z + (size_t)row * NIN; float ss = 0.f, want;
            if (col < 256) { for (int k = 0; k < 256; ++k) { const float v = bf2f(zr[k]); ss += v * v; } want = bf2f(zr[col]) / sqrtf(ss / 256.f + EPS) * a.in[I_GQ][col]; }
            else { for (int k = 256; k < 384; ++k) { const float v = bf2f(zr[k]); ss += v * v; } want = bf2f(zr[col]) / sqrtf(ss / 128.f + EPS) * a.in[I_GKV][col - 256]; }
            diag_max(ctl, 4, relerr(bf2f(AQ[(size_t)row * KQKV + col]), want, 0.3f));
            const int hh = (h >> 16) & 7, jp = (h >> 19) & 31, g = jp >> 3, t = jp & 7, fi = 4 * g + (t & 3), x2s = t >> 2, pos = row & 8191, b = row >> 13;
            const float x1 = bf2f(zr[C_KR + fi]), x2 = bf2f(zr[C_KR + 16 + fi]); const f32x2 cs = rope[pos * 16 + fi];
            const float wk = x2s ? x2 * cs.x + x1 * cs.y : x1 * cs.x - x2 * cs.y;
            diag_max(ctl, 4, relerr(kimg(Km, b * 8 + hh, pos, 64 + jp), wk, 0.3f)); }
    } else if (which == 5) {
        bf16* AQ = Hb;
        for (int i = gt; i < 4096; i += NGT) { const unsigned h = hsh(i); const int row = h & 65535, c = (h >> 16) % NQKV, b = row >> 13, s = row & 8191; const bf16* ar = AQ + (size_t)row * KQKV;
            if (c < 768) { const int hh = c / 96, d = c % 96; float want, got = bf2f(Qm[((size_t)(b * 8 + hh) * SEQ + s) * 96 + d]);
                if (d < 64) want = dotbf(ar, WQKV + (size_t)c * KQKV, KQKV) * C2M;
                else { const int jp = d - 64, g = jp >> 3, t = jp & 7, fi = 4 * g + (t & 3), x2s = t >> 2, cpart = hh * 96 + 64 + 8 * g + (t & 3) + (x2s ? 0 : 4);
                    const float dc = dotbf(ar, WQKV + (size_t)c * KQKV, KQKV) * C2M, dp = dotbf(ar, WQKV + (size_t)cpart * KQKV, KQKV) * C2M; const float x1 = x2s ? dp : dc, x2 = x2s ? dc : dp; const f32x2 cs = rope[s * 16 + fi];
                    want = x2s ? x2 * cs.x + x1 * cs.y : x1 * cs.x - x2 * cs.y; }
                diag_max(ctl, 5, relerr(got, want, 0.1f)); }
            else { const int cc = c - 768, hh = cc >> 7, dd = cc & 127; const float want = dotbf(ar, WQKV + (size_t)c * KQKV, KQKV);
                const float got = dd < 64 ? kimg(Km, b * 8 + hh, s, dd) : vimg(Vm, b * 8 + hh, s, dd - 64); diag_max(ctl, 5, relerr(got, want, 0.3f)); } }
    } else if (which == 6) {
        for (int smp = gwv; smp < 256; smp += NGT / 64) { const unsigned h = hsh(smp * 3 + 1); const int b = h & 7, hh = (h >> 3) & 7; int s = (h >> 6) & 8191; if (smp < 16) s = smp * 17; const int bh = b * 8 + hh, nk = ((s >> 6) + 1) * 64;
            const bf16* q = Qm + ((size_t)bh * SEQ + s) * 96; float m = -INFINITY;
            for (int k = lane; k < nk; k += 64) { float sc = 0.f; for (int d = 0; d < 96; ++d) sc += bf2f(q[d]) * kimg(Km, bh, k, d); m = fmaxf(m, sc); }
            for (int o = 1; o < 64; o <<= 1) m = fmaxf(m, __shfl_xor(m, o));
            float l = 0.f; float acc[64];
#pragma unroll
            for (int d = 0; d < 64; ++d) acc[d] = 0.f;
            for (int k = lane; k < nk; k += 64) { float sc = 0.f; for (int d = 0; d < 96; ++d) sc += bf2f(q[d]) * kimg(Km, bh, k, d); const float e = exp2f(sc - m); l += e;
#pragma unroll
                for (int d = 0; d < 64; ++d) acc[d] += e * vimg(Vm, bh, k, d); }
            l = wave_sum(l); float mine = 0.f, sq = 0.f;
#pragma unroll
            for (int d = 0; d < 64; ++d) { const float v = wave_sum(acc[d]) / l; sq += v * v; if (lane == d) mine = v; }
            const float rms = sqrtf(sq / 64.f); const float got = bf2f(Ob[((size_t)b * SEQ + s) * 1024 + hh * 64 + lane]);
            diag_max(ctl, 6, fabsf(got - mine) / (fabsf(mine) + 0.3f * rms + 1e-6f)); }
    } else if (which == 7) {
        for (int smp = gwv; smp < 256; smp += NGT / 64) { const unsigned h = hsh(smp * 5 + 2); const int b = h & 7, hh = (h >> 3) & 7; int s = (h >> 6) & 8191; if (smp < 16) s = smp * 41; const int cq = s >> 6, k0 = (cq >= 8 ? cq - 8 : 0) * 64, k1 = (cq + 1) * 64;
            const bf16* q = Z + ((size_t)b * SEQ + s) * NIN + C_QC + hh * 64; float m = -INFINITY;
            for (int k = k0 + lane; k < k1; k += 64) { const bf16* kr = Z + ((size_t)b * SEQ + k) * NIN + C_KC + hh * 64; float sc = 0.f; for (int d = 0; d < 64; ++d) sc += bf2f(q[d]) * bf2f(kr[d]);
                int rel = s - k; rel = rel < -63 ? -63 : (rel > 256 ? 256 : rel); sc = sc * 0.125f + a.in[I_RELB][hh * 320 + rel + 63]; m = fmaxf(m, sc); }
            for (int o = 1; o < 64; o <<= 1) m = fmaxf(m, __shfl_xor(m, o));
            float l = 0.f; float acc[64];
#pragma unroll
            for (int d = 0; d < 64; ++d) acc[d] = 0.f;
            for (int k = k0 + lane; k < k1; k += 64) { const bf16* kr = Z + ((size_t)b * SEQ + k) * NIN + C_KC + hh * 64; const bf16* vr = Z + ((size_t)b * SEQ + k) * NIN + C_VC + hh * 64; float sc = 0.f; for (int d = 0; d < 64; ++d) sc += bf2f(q[d]) * bf2f(kr[d]);
                int rel = s - k; rel = rel < -63 ? -63 : (rel > 256 ? 256 : rel); sc = sc * 0.125f + a.in[I_RELB][hh * 320 + rel + 63]; const float e = expf(sc - m); l += e;
#pragma unroll
                for (int d = 0; d < 64; ++d) acc[d] += e * bf2f(vr[d]); }
            l = wave_sum(l); float mine = 0.f, sq = 0.f;
#pragma unroll
            for (int d = 0; d < 64; ++d) { const float v = wave_sum(acc[d]) / l; sq += v * v; if (lane == d) mine = v; }
            const float rms = sqrtf(sq / 64.f); const float got = bf2f(Ob[((size_t)b * SEQ + s) * 1024 + 512 + hh * 64 + lane]);
            diag_max(ctl, 7, fabsf(got - mine) / (fabsf(mine) + 0.3f * rms + 1e-6f)); }
    } else if (which == 8) {
        for (int i = gt; i < 4096; i += NGT) { const unsigned h = hsh(i); const int row = h & 65535, n = (h >> 16) & 1023;
            diag_max(ctl, 8, relerr(bf2f(OP[(size_t)row * 1024 + n]), dotbf(Ob + (size_t)row * 1024, WOt + (size_t)n * 1024, 1024), 0.2f)); }
    } else if (which == 9 || which == 10) {
        for (int i = gt; i < 1024; i += NGT) { const unsigned h = hsh(i + 31u * which); const int row = h & 65535, col = (h >> 16) & 1023, b = row >> 13; const float* mb = mod + b * MODW;
            float ss = 0.f; for (int k = 0; k < 1024; ++k) { const float v = bf2f(OP[(size_t)row * 1024 + k]); ss += v * v; }
            const float r1 = 1.f / sqrtf(ss / 1024.f + EPS); float ss2 = 0.f;
            for (int k = 0; k < 1024; ++k) { const float v = x[(size_t)row * 1024 + k] + mb[2048 + k] * (bf2f(OP[(size_t)row * 1024 + k]) * r1 * a.in[I_GPOST1][k]); ss2 += v * v; }
            const float r2 = 1.f / sqrtf(ss2 / 1024.f + EPS);
            if (which == 9) { const float x1 = x[(size_t)row * 1024 + col] + mb[2048 + col] * (bf2f(OP[(size_t)row * 1024 + col]) * r1 * a.in[I_GPOST1][col]);
                const float h2 = x1 * r2 * a.in[I_GPRE2][col] * (1.f + mb[4096 + col]) + mb[3072 + col];
                diag_max(ctl, 9, relerr(a.out[(size_t)row * 1024 + col], x1, 0.5f) * 30.f); diag_max(ctl, 9, relerr(f8dec(H8[(size_t)row * 1024 + col]) / A8S, h2, 0.3f) * 0.4f); }
            else { float lg[32];
#pragma unroll
                for (int e = 0; e < 32; ++e) lg[e] = a.in[I_BR][e];
                for (int k = 0; k < 1024; ++k) { const float x1 = x[(size_t)row * 1024 + k] + mb[2048 + k] * (bf2f(OP[(size_t)row * 1024 + k]) * r1 * a.in[I_GPOST1][k]);
                    const float h2 = x1 * r2 * a.in[I_GPRE2][k] * (1.f + mb[4096 + k]) + mb[3072 + k];
#pragma unroll
                    for (int e = 0; e < 32; ++e) lg[e] += h2 * a.in[I_WR][k * 32 + e]; }
                int ci[5]; float cv[5];
#pragma unroll
                for (int k = 0; k < 5; ++k) { float best = -INFINITY; int bi = 0;
#pragma unroll
                    for (int e = 0; e < 32; ++e) { bool used = false;
#pragma unroll
                        for (int q = 0; q < 5; ++q) if (q < k && ci[q] == e) used = true;
                        if (!used && lg[e] > best) { best = lg[e]; bi = e; } }
                    ci[k] = bi; cv[k] = best; }
                bool tie = false;
#pragma unroll
                for (int k = 0; k < 4; ++k) if (cv[k] - cv[k + 1] < 2e-4f) tie = true;
                if (!tie) { float gs = 0.f, gv[4];
#pragma unroll
                    for (int k = 0; k < 4; ++k) { gv[k] = expf(cv[k] - cv[0]); gs += gv[k]; }
#pragma unroll
                    for (int k = 0; k < 4; ++k) { const unsigned ti = tinfo[(size_t)row * 4 + k]; const int e = ti >> 16, idx = ti & 0xffff;
                        if (e != ci[k]) diag_max(ctl, 10, 1.f);
                        else { diag_max(ctl, 10, fabsf(gates[(size_t)row * 4 + k] - gv[k] / gs) * 10.f);
                            if (idx >= (int)gcnt[e]) diag_max(ctl, 10, 2.f);
                            else if (lists[(size_t)e * LIST_CAP + idx] != (unsigned)row * 4u + k) diag_max(ctl, 10, 3.f); } } } } }
        if (which == 10 && gt == 0) { unsigned s0 = 0; for (int e = 0; e < 32; ++e) s0 += gcnt[e]; if (s0 != 262144u) diag_max(ctl, 10, 4.f); }
    } else if (which == 11 || which == 12) {
        for (int i = gt; i < 4096; i += NGT) { const unsigned h = hsh(i + 7u * which); const int e = h & 31, cnt = (int)gcnt[e]; if (cnt <= 0) continue;
            const int idx = (int)(((h >> 5) & 0xffff) % (unsigned)cnt), col = (h >> 21) & 1023; int ts = 0; for (int q = 0; q < e; ++q) ts += ((int)gcnt[q] + 255) >> 8;
            const int row = ts * 256 + idx; const unsigned ent = lists[(size_t)e * LIST_CAP + idx]; const int tok = ent >> 2;
            if (which == 11) { const int pn = col >> 7, j = col & 127;
                float gte = dot8(H8 + (size_t)tok * 1024, WGU + ((size_t)e * 2048 + pn * 256 + j) * 1024, 1024) / (W8S * A8S) + a.in[I_BGU][e * 2048 + col];
                float up = dot8(H8 + (size_t)tok * 1024, WGU + ((size_t)e * 2048 + pn * 256 + 128 + j) * 1024, 1024) / (W8S * A8S) + a.in[I_BGU][e * 2048 + 1024 + col];
                gte = fminf(gte, 7.f); up = fminf(fmaxf(up, -7.f), 7.f); const float want = (up + 1.f) * (gte / (1.f + expf(-1.702f * gte)));
                diag_max(ctl, 11, relerr(f8dec(ACT[(size_t)row * 1024 + col]) / A8S, want, 0.2f) * 0.4f); }
            else { const float want = dot8(ACT + (size_t)row * 1024, WDN + ((size_t)e * 1024 + col) * 1024, 1024) / (W8S * A8S) + a.in[I_BDN][e * 1024 + col];
                diag_max(ctl, 12, relerr(bf2f(Y[(size_t)ent * 1024 + col]), want, 0.2f)); } }
    } else if (which == 15 || which == 16) {
        for (int i = gt; i < 1024; i += NGT) { const unsigned h = hsh(i + 4242u); const int row = h & 65535, col = (h >> 16) & 1023, b = row >> 13;
            if (which == 15) { const f32x4 gv = *(const f32x4*)(gates + (size_t)row * 4); float ss = 0.f, fc = 0.f;
                for (int k = 0; k < 1024; ++k) { const bf16* yr = Y + (size_t)row * 4096 + k; const float f = gv.x * bf2f(yr[0]) + gv.y * bf2f(yr[1024]) + gv.z * bf2f(yr[2048]) + gv.w * bf2f(yr[3072]); ss += f * f; if (k == col) fc = f; }
                dbgv[i] = a.out[(size_t)row * 1024 + col] + mod[b * MODW + 5120 + col] * (fc / sqrtf(ss / 1024.f + EPS) * a.in[I_GPOST2][col]); }
            else diag_max(ctl, 15, relerr(a.out[(size_t)row * 1024 + col], dbgv[i], 0.5f) * 30.f); }
    }
}
__global__ void __launch_bounds__(256) dbg_report(Args a) {
    unsigned* ctl = (unsigned*)(a.ws + WS_CTL); int fs = -1; float fe = 0.f;
    for (int s = 15; s >= 0; --s) { const float e = __uint_as_float(ctl[CW_DIAG + s]); if (e > 0.03f) { fs = s; fe = e; } }
    if (fs < 0) return;
    int lvl = 1; float e = fe / 0.03f; while (e >= 2.f && lvl < 8) { e *= 0.5f; ++lvl; }
    float V = (float)(1 + lvl) * 1000.f; for (int s = 0; s < fs; ++s) V *= 10.f;
    const size_t n = (size_t)T * DM;
    for (size_t i = (size_t)blockIdx.x * 256 + threadIdx.x; i < n; i += (size_t)gridDim.x * 256) a.out[i] = (i == 0) ? V : 0.f;
}
static void dbg_before(int ph, const Args& a, hipStream_t st) { if (ph == 10) hipLaunchKernelGGL(dbg_chk, dim3(64), dim3(256), 0, st, a, 15, 0); }
static void dbg_after(int ph, const Args& a, hipStream_t st) {
#define CHK(w, p) hipLaunchKernelGGL(dbg_chk, dim3(64), dim3(256), 0, st, a, w, p)
    switch (ph) {
        case 0: CHK(0, 0); CHK(1, 0); break; case 1: CHK(2, 0); break; case 2: CHK(3, 0); break; case 3: CHK(4, 0); break; case 4: CHK(5, 0); break;
        case 5: CHK(6, 0); CHK(7, 0); break; case 6: CHK(8, 0); break; case 7: CHK(9, 0); CHK(10, 0); break;
        case 8: CHK(11, 0); break; case 9: CHK(12, 0); break;
        case 10: CHK(16, 0); hipLaunchKernelGGL(dbg_report, dim3(2048), dim3(256), 0, st, a); break;
    }
#undef CHK
}
#endif


extern "C" void kernel_launch(void* const* d_in, const int* in_sizes, int n_in, void* d_out, int out_size, void* d_ws, size_t ws_size, hipStream_t stream) {
    static int grid = 0;
    if (grid == 0) {
        if (n_in != 21 || in_sizes[0] != T * DM || out_size != T * DM || ws_size < WS_END) { fprintf(stderr, "kernel_launch: unexpected shapes (n_in %d, in0 %d, out %d, ws %zu); nothing launched\n", n_in, n_in > 0 ? in_sizes[0] : -1, out_size, ws_size); grid = -1; return; }
        int dev = 0, cus = 0, per_cu = 0;
        if (hipGetDevice(&dev) != hipSuccess || hipDeviceGetAttribute(&cus, hipDeviceAttributeMultiprocessorCount, dev) != hipSuccess) { grid = -1; return; }
        if (hipFuncSetAttribute((const void*)fwd, hipFuncAttributeMaxDynamicSharedMemorySize, LDS_BYTES) != hipSuccess) { fprintf(stderr, "kernel_launch: hipFuncSetAttribute failed\n"); grid = -1; return; }
        if (hipOccupancyMaxActiveBlocksPerMultiprocessor(&per_cu, (const void*)fwd, 512, LDS_BYTES) != hipSuccess || per_cu < 1) fprintf(stderr, "kernel_launch: occupancy query reports %d\n", per_cu);
        (void)hipGetLastError();
        grid = cus;
    }
    if (grid < 0) return;
    if (hipMemsetAsync((char*)d_ws + WS_CTL, 0, CTL_ZERO_BYTES, stream) != hipSuccess) return;
    Args a{};
    for (int i = 0; i < 21; ++i) a.in[i] = (const float*)d_in[i];
    a.out = (float*)d_out; a.ws = (unsigned char*)d_ws;
#if MK_ONE_LAUNCH
    a.ph_lo = 0; a.ph_hi = 11;
    hipLaunchKernelGGL(fwd, dim3(grid), dim3(512), LDS_BYTES, stream, a);
#else
    for (int ph = 0; ph < 11; ++ph) {
        a.ph_lo = ph; a.ph_hi = ph + 1;
#if MK_DEBUG
        dbg_before(ph, a, stream);
#endif
        hipLaunchKernelGGL(fwd, dim3(grid), dim3(512), LDS_BYTES, stream, a);
#if MK_DEBUG
        dbg_after(ph, a, stream);
#endif
    }
#endif
}
```

```cpp
#include <hip/hip_runtime.h>
#include <cstdio>
#include <cstdint>

#ifndef MK_DEBUG
#define MK_DEBUG 0
#endif
#ifndef MK_ONE_LAUNCH
#define MK_ONE_LAUNCH 1
#endif

#ifndef PROBE_A
#define PROBE_A -1
#define PROBE_B -1
#ifndef BENCH_ABL
#define BENCH_ABL -1
#endif
#ifndef BENCH_GEMM
#define BENCH_GEMM 0
#endif
#define PROBE_TID 0
#define PROBE_X 0
#endif
#define GAS __attribute__((address_space(1)))
#define LAS __attribute__((address_space(3)))
typedef unsigned short bf16;
typedef short bf16x8 __attribute__((ext_vector_type(8)));
typedef short s16x4 __attribute__((ext_vector_type(4)));
typedef float f32x4 __attribute__((ext_vector_type(4)));
typedef float f32x2 __attribute__((ext_vector_type(2)));
typedef float f32x16 __attribute__((ext_vector_type(16)));
typedef unsigned u32x4 __attribute__((ext_vector_type(4)));
typedef unsigned u32x2 __attribute__((ext_vector_type(2)));
typedef __bf16 bf16x2_t __attribute__((ext_vector_type(2)));

constexpr int NB = 8, SEQ = 8192, DM = 1024, T = NB * SEQ;
constexpr int NIN = 2048, IN_W = 1952, ZP = 2176;
constexpr int C_CKV = 256, C_KR = 384, C_QC = 416, C_KC = 928, C_VC = 1440;
constexpr int NE = 32;
constexpr int KQKV = 384, NQKV = 1792;
constexpr float EPS = 1e-6f;
constexpr float LOG2E = 1.4426950408889634f;
constexpr float C2M = 0.10206207261596577f * 1.4426950408889634f;
constexpr float C2C = 0.125f * 1.4426950408889634f;
constexpr int MODW = 6 * DM;
constexpr int OPI = 1088;

constexpr size_t MiB = 1u << 20;
constexpr size_t WS_CTL = 0, CTL_ZERO_BYTES = 1 * MiB;
constexpr size_t WS_MOD = 1 * MiB;
constexpr size_t WS_WRT = 1 * MiB + 256 * 1024;
constexpr size_t WS_GATE = 2 * MiB;
constexpr size_t WS_ROPE = 3 * MiB;
constexpr size_t WS_WQKV = 4 * MiB;
constexpr size_t WS_TINFO = 6 * MiB;
constexpr size_t WS_RS = 7 * MiB;
constexpr size_t WS_LIST = 8 * MiB;
constexpr size_t WS_WIN = 24 * MiB;
constexpr size_t WS_WO = 28 * MiB;
constexpr size_t WS_DBG = 31 * MiB;
constexpr size_t WS_WDN = 32 * MiB;
constexpr size_t WS_WGU = 64 * MiB;
constexpr size_t WS_H = 128 * MiB;
constexpr size_t WS_H8 = 784 * MiB;
constexpr size_t WS_ACT = 256 * MiB;
constexpr size_t WS_Z = 256 * MiB;
constexpr size_t WS_OP = 128 * MiB;
constexpr size_t WS_QM = 528 * MiB;
constexpr size_t WS_KM = 624 * MiB;
constexpr size_t WS_VM = 720 * MiB;
constexpr size_t WS_O = 784 * MiB;
constexpr size_t WS_Y = 520 * MiB;
constexpr size_t WS_END = 1024 * MiB;
constexpr float W8S = 32.f, A8S = 4.f, Y8S = 16.f;
constexpr int LIST_CAP = 65536;

constexpr int CW_TMO = 0, CW_CODE = 1;
constexpr int CW_BAR = 4096;
constexpr int CW_CNT = 8192;
constexpr int CW_DIAG = 8320;

constexpr int LDS_BYTES = 147456;
constexpr int MISC_OFF = LDS_BYTES - 256;
constexpr int TAB_OFF = 139264;

__device__ __forceinline__ unsigned f2bf(float f) { unsigned u = __builtin_bit_cast(unsigned, f); return (u + 0x7fffu + ((u >> 16) & 1u)) >> 16; }
__device__ __forceinline__ float bf2f(unsigned b) { return __builtin_bit_cast(float, (b & 0xffffu) << 16); }
__device__ __forceinline__ unsigned pk2(float lo, float hi) { f32x2 v = {lo, hi}; bf16x2_t b = __builtin_convertvector(v, bf16x2_t); return __builtin_bit_cast(unsigned, b); }
__device__ __forceinline__ float wave_sum(float v) {
#pragma unroll
    for (int o = 1; o < 64; o <<= 1) v += __shfl_xor(v, o);
    return v;
}
__device__ __forceinline__ unsigned pk4_fp8(float a, float b, float c, float d) { unsigned w = 0; w = __builtin_amdgcn_cvt_pk_fp8_f32(a, b, w, false); w = __builtin_amdgcn_cvt_pk_fp8_f32(c, d, w, true); return w; }
#define LDS_WAIT() asm volatile("s_waitcnt lgkmcnt(0)" ::: "memory")
#define VM_WAIT() asm volatile("s_waitcnt vmcnt(0)" ::: "memory")

namespace pg8 {
typedef unsigned short bf16_t;
constexpr int BM = 256, BK = 64, HALF = 128, HTB = HALF * BK * 2, STAGE_BYTES = 8 * HTB;
__host__ __device__ __forceinline__ int lds_byte(int r, int c) { const int st = (r >> 4) * 2 + (c >> 5), rr = r & 15, cc = c & 31, ob = rr * 64 + cc * 2; return st * 1024 + (ob ^ (((ob >> 9) & 1) << 5)); }
__host__ __device__ __forceinline__ void stage_rc(int b, int& R, int& C) { const int st = b / 1024, sb = b % 1024, swz = sb ^ (((sb >> 9) & 1) << 5); R = (st >> 1) * 16 + swz / 64; C = (st & 1) * 32 + (swz % 64) / 2; }
__host__ __device__ __forceinline__ int perm32(int rho) { const int n = rho >> 4, i = rho & 15; return 8 * (i >> 2) + 4 * n + (i & 3); }

struct Unit { int pm, pn, brow, e, nvalid, orow; };
struct Gemm { const void* A; const void* Bt; int KB; int BP; };
typedef int v8i __attribute__((ext_vector_type(8)));
typedef int v4i __attribute__((ext_vector_type(4)));

__device__ __forceinline__ void glds_s(unsigned voff, const void* sbase, unsigned lds_dst) { unsigned keep;
    asm volatile("s_mov_b32 %0, m0\n\ts_mov_b32 m0, %3\n\ts_nop 0\n\tglobal_load_lds_dwordx4 %1, %2\n\ts_mov_b32 m0, %0" : "=&s"(keep) : "v"(voff), "s"(sbase), "s"(lds_dst) : "memory"); }
template <class Epi, class Sched, bool ALIGN_EPI, bool FP8>
__device__ __forceinline__ void gemm_phase(LAS unsigned char* lds, const Gemm g, const Sched& S, const Epi& E) {
    const int tid = threadIdx.x, wid = __builtin_amdgcn_readfirstlane(tid >> 6), lane = tid & 63, wr = wid >> 2, wc = wid & 3, fr = lane & 15, fq = lane >> 4;
    const int KB = g.KB, BP = g.BP, nt = KB / 128;
    unsigned voffB[2];
#pragma unroll
    for (int i = 0; i < 2; ++i) { int R, C; stage_rc(tid * 16 + i * 8192, R, C); const int Rb = (R & ~31) + perm32(R & 31); voffB[i] = (unsigned)(Rb * BP + C * 2); }
    const size_t kstep = (size_t)(BK * 2);
    const size_t hstep = (size_t)HALF * BP;
    const unsigned ldsw = (unsigned)wid * 1024u, ldsb = (unsigned)(uintptr_t)lds;
    const int aoff = lds_byte(wr * 64 + fr, fq * 8), boff = lds_byte(wc * 32 + fr, fq * 8);
#define PG8_SA(b, h) (((b) * 2 + (h)) * HTB)
#define PG8_SB(b, h) ((4 + (b) * 2 + (h)) * HTB)
#define PG8_STAGE(bufoff, gbase, voff) do { _Pragma("unroll") for (int _i = 0; _i < 2; ++_i) \
        glds_s((voff)[_i], (const void*)(gbase), (unsigned)__builtin_amdgcn_readfirstlane(ldsb + (unsigned)(bufoff) + ldsw + _i * 8192)); } while (0)
#define PG8_LDA(dst, b, h) do { _Pragma("unroll") for (int m = 0; m < 4; ++m) { \
        const v4i l0_ = *(const LAS v4i*)(lds + PG8_SA(b, h) + aoff + m * 2048), l1_ = *(const LAS v4i*)(lds + PG8_SA(b, h) + aoff + m * 2048 + 1024); \
        dst[m] = __builtin_shufflevector(l0_, l1_, 0, 1, 2, 3, 4, 5, 6, 7); } } while (0)
#define PG8_LDB(dst, b, h) do { _Pragma("unroll") for (int n = 0; n < 2; ++n) { \
        const v4i l0_ = *(const LAS v4i*)(lds + PG8_SB(b, h) + boff + n * 2048), l1_ = *(const LAS v4i*)(lds + PG8_SB(b, h) + boff + n * 2048 + 1024); \
        dst[n] = __builtin_shufflevector(l0_, l1_, 0, 1, 2, 3, 4, 5, 6, 7); } } while (0)
#define PG8_MMA(ai, bj, At, Bt) do { __builtin_amdgcn_s_setprio(1); _Pragma("unroll") for (int m = 0; m < 4; ++m) _Pragma("unroll") for (int n = 0; n < 2; ++n) { \
        if constexpr (FP8) acc[ai][bj][m][n] = __builtin_amdgcn_mfma_scale_f32_16x16x128_f8f6f4(Bt[n], At[m], acc[ai][bj][m][n], 0, 0, 0, 0, 0, 0); \
        else { acc[ai][bj][m][n] = __builtin_amdgcn_mfma_f32_16x16x32_bf16(__builtin_bit_cast(bf16x8, __builtin_shufflevector(Bt[n], Bt[n], 0, 1, 2, 3)), __builtin_bit_cast(bf16x8, __builtin_shufflevector(At[m], At[m], 0, 1, 2, 3)), acc[ai][bj][m][n], 0, 0, 0); \
               acc[ai][bj][m][n] = __builtin_amdgcn_mfma_f32_16x16x32_bf16(__builtin_bit_cast(bf16x8, __builtin_shufflevector(Bt[n], Bt[n], 4, 5, 6, 7)), __builtin_bit_cast(bf16x8, __builtin_shufflevector(At[m], At[m], 4, 5, 6, 7)), acc[ai][bj][m][n], 0, 0, 0); } } \
        __builtin_amdgcn_s_setprio(0); } while (0)
#define PG8_WAIT_V(n) asm volatile("s_waitcnt vmcnt(" #n ")" ::: "memory")
#define PG8_WAIT_L(n) asm volatile("s_waitcnt lgkmcnt(" #n ")" ::: "memory")
#define PG8_BAR __builtin_amdgcn_s_barrier()
#define PG8_SCHED __builtin_amdgcn_sched_barrier(0)
#define PG8_OFFS(dst, u) do { int tid_ = tid; asm volatile("" : "+v"(tid_)); _Pragma("unroll") for (int _i = 0; _i < 2; ++_i) { int R_, C_; stage_rc(tid_ * 16 + _i * 8192, R_, C_); \
        _Pragma("unroll") for (int _h = 0; _h < 2; ++_h) dst[_h][_i] = S.arow_off(u, _h * HALF + R_) + (unsigned)C_ * 2u; } } while (0)
    Unit cur, nxt; int ui = 0;
    if (!S.next(0, cur)) return;
    bool has_next = S.next(1, nxt);
    unsigned cvo[2][2], nvo[2][2];
    PG8_OFFS(cvo, cur);
    if (has_next) PG8_OFFS(nvo, nxt); else { nvo[0][0] = cvo[0][0]; nvo[0][1] = cvo[0][1]; nvo[1][0] = cvo[1][0]; nvo[1][1] = cvo[1][1]; }
    f32x4 acc[2][2][4][2];
#pragma unroll
    for (int a = 0; a < 2; ++a)
#pragma unroll
        for (int b = 0; b < 2; ++b)
#pragma unroll
            for (int m = 0; m < 4; ++m)
#pragma unroll
                for (int n = 0; n < 2; ++n) acc[a][b][m][n] = (f32x4){0.f, 0.f, 0.f, 0.f};
    v8i At[4], B0[2], B1[2];
    const char* const Ab = (const char*)g.A;
    const char* cB = (const char*)g.Bt + (size_t)cur.brow * BP;
    VM_WAIT();
    PG8_STAGE(PG8_SB(0, 0), cB, voffB); PG8_STAGE(PG8_SB(0, 1), cB + hstep, voffB); PG8_STAGE(PG8_SA(0, 0), Ab, cvo[0]); PG8_STAGE(PG8_SA(0, 1), Ab, cvo[1]);
    if (wr == 1) PG8_BAR;
    PG8_WAIT_V(2); PG8_BAR;
    PG8_STAGE(PG8_SB(1, 0), cB + kstep, voffB); PG8_STAGE(PG8_SA(1, 0), Ab + kstep, cvo[0]); PG8_STAGE(PG8_SB(1, 1), cB + hstep + kstep, voffB);
    PG8_WAIT_V(6); PG8_BAR;
    Unit nn; bool has_nn = false; unsigned raw[2][2] = {{0u, 0u}, {0u, 0u}};
    const bool pref = Sched::PREF && S.gathers();
    for (;;) {
        const char* nB = has_next ? (const char*)g.Bt + (size_t)nxt.brow * BP : cB;
        if (Sched::PREF) { if (pref) { has_nn = has_next && S.next(ui + 2, nn);
            if (has_nn) { int tid_ = tid; asm volatile("" : "+v"(tid_));
#pragma unroll
                for (int _i = 0; _i < 2; ++_i) { int R_, C_; stage_rc(tid_ * 16 + _i * 8192, R_, C_);
#pragma unroll
                    for (int _h = 0; _h < 2; ++_h) { const unsigned* ap_ = S.raw_addr(nn, _h * HALF + R_); asm volatile("global_load_dword %0, %1, off" : "=v"(raw[_h][_i]) : "v"(ap_) : "memory"); } } } } }
#pragma unroll 1
        for (int t = 0; t < nt; t += 2) {
            const bool last = (t == nt - 2);
            const char* a1 = Ab + (size_t)(t + 1) * kstep;
            const char* a2 = last ? Ab : Ab + (size_t)(t + 2) * kstep; const char* b2 = last ? nB : cB + (size_t)(t + 2) * kstep;
            const char* a3 = a2 + kstep; const char* b3 = b2 + kstep;
            unsigned vo2[2][2];
#pragma unroll
            for (int _h = 0; _h < 2; ++_h)
#pragma unroll
                for (int _i = 0; _i < 2; ++_i) vo2[_h][_i] = last ? nvo[_h][_i] : cvo[_h][_i];
            PG8_LDB(B0, 0, 0); PG8_LDB(B1, 0, 1); PG8_SCHED; PG8_LDA(At, 0, 0); PG8_STAGE(PG8_SA(1, 1), a1, cvo[1]);
            PG8_WAIT_V(8); PG8_WAIT_L(0); PG8_BAR; PG8_MMA(0, 0, At, B0); PG8_MMA(0, 1, At, B1); PG8_BAR; PG8_SCHED;
            PG8_LDA(At, 0, 1); PG8_STAGE(PG8_SB(0, 0), b2, voffB); PG8_STAGE(PG8_SB(0, 1), b2 + hstep, voffB); PG8_STAGE(PG8_SA(0, 0), a2, vo2[0]);
            PG8_WAIT_V(8); PG8_WAIT_L(0); PG8_BAR; PG8_MMA(1, 0, At, B0); PG8_MMA(1, 1, At, B1); PG8_BAR; PG8_SCHED;
            PG8_LDB(B0, 1, 0); PG8_LDB(B1, 1, 1); PG8_SCHED; PG8_LDA(At, 1, 0); PG8_STAGE(PG8_SA(0, 1), a2, vo2[1]);
            PG8_WAIT_V(8); PG8_WAIT_L(0); PG8_BAR; PG8_MMA(0, 0, At, B0); PG8_MMA(0, 1, At, B1); PG8_BAR; PG8_SCHED;
            PG8_LDA(At, 1, 1); PG8_STAGE(PG8_SB(1, 0), b3, voffB); PG8_STAGE(PG8_SB(1, 1), b3 + hstep, voffB); PG8_STAGE(PG8_SA(1, 0), a3, vo2[0]);
            PG8_WAIT_V(8); PG8_WAIT_L(0); PG8_BAR; PG8_MMA(1, 0, At, B0); PG8_MMA(1, 1, At, B1); PG8_BAR; PG8_SCHED;
        }
        if constexpr (ALIGN_EPI) { if (wr == 0) PG8_BAR; }
        { int fr_ = fr, fq_ = fq; asm volatile("" : "+v"(fr_), "+v"(fq_));
#if PROBE_A >= 0
          unsigned long long te0_ = __builtin_amdgcn_s_memrealtime();
#endif
          E(acc, cur, wr, wc, fr_, fq_);
#if PROBE_A >= 0
          asm volatile("s_waitcnt vmcnt(0)" ::: "memory");
          if (blockIdx.x == 0 && tid == 0) { LAS unsigned long long* st_ = (LAS unsigned long long*)(lds + 147456 - 256 + 64); st_[14] += __builtin_amdgcn_s_memrealtime() - te0_; }
#endif
        }
        if (!has_next) break;
#pragma unroll
        for (int a = 0; a < 2; ++a)
#pragma unroll
            for (int b = 0; b < 2; ++b)
#pragma unroll
                for (int m = 0; m < 4; ++m)
#pragma unroll
                    for (int n = 0; n < 2; ++n) acc[a][b][m][n] = (f32x4){0.f, 0.f, 0.f, 0.f};
        cur = nxt; cB = nB; ++ui;
#pragma unroll
        for (int _h = 0; _h < 2; ++_h)
#pragma unroll
            for (int _i = 0; _i < 2; ++_i) cvo[_h][_i] = nvo[_h][_i];
        if (Sched::PREF && pref) { has_next = has_nn; if (has_nn) { nxt = nn;
                asm volatile("" : "+v"(raw[0][0]), "+v"(raw[0][1]), "+v"(raw[1][0]), "+v"(raw[1][1]));
                int tid_ = tid; asm volatile("" : "+v"(tid_));
#pragma unroll
                for (int _i = 0; _i < 2; ++_i) { int R_, C_; stage_rc(tid_ * 16 + _i * 8192, R_, C_);
#pragma unroll
                    for (int _h = 0; _h < 2; ++_h) nvo[_h][_i] = S.conv(raw[_h][_i]) + (unsigned)C_ * 2u; } } }
        else { has_next = S.next(ui + 1, nxt);
            if (has_next) PG8_OFFS(nvo, nxt); }
        if constexpr (ALIGN_EPI) { if (wr == 1) PG8_BAR; }
    }
    PG8_WAIT_V(0);
    if constexpr (!ALIGN_EPI) { if (wr == 0) PG8_BAR; }
    PG8_BAR;
#undef PG8_SA
#undef PG8_SB
#undef PG8_STAGE
#undef PG8_LDA
#undef PG8_LDB
#undef PG8_MMA
#undef PG8_WAIT_V
#undef PG8_WAIT_L
#undef PG8_BAR
#undef PG8_SCHED
#undef PG8_OFFS
}

struct DenseSched {
    static constexpr bool PREF = false;
    __device__ __forceinline__ bool gathers() const { return false; }
    __device__ __forceinline__ const unsigned* raw_addr(const Unit&, int) const { return nullptr; }
    __device__ __forceinline__ unsigned conv(unsigned) const { return 0u; }
    int nN, nwg, G, c, K2;
    __device__ __forceinline__ bool next(int i, Unit& u) const {
        const int L = i * G + c; if (L >= nwg) return false;
        const int nig = 8 * nN, gid = L / nig, r = L % nig;
        u.pm = gid * 8 + (r & 7); u.pn = r >> 3; u.brow = u.pn * BM; u.e = 0; u.nvalid = BM; u.orow = u.pm * BM; return true;
    }
    __device__ __forceinline__ unsigned arow_off(const Unit& u, int r) const { return (unsigned)(u.pm * BM + r) * (unsigned)K2; }
};
struct MoeSched {
    static constexpr bool PREF = true;
    const LAS int* tstart;
    const LAS int* cnt;
    const unsigned* list;
    int NT, G, c, nexp_rows;
    __device__ __forceinline__ bool next(int i, Unit& u) const {
        const int L = i * G + c; const int total = __builtin_amdgcn_readfirstlane(tstart[32]) * NT; if (L >= total) return false;
        const int rt = L / NT, pn = L % NT;
        int e = 0;
#pragma unroll
        for (int st = 16; st; st >>= 1) if (tstart[e + st] <= rt) e += st;
        e = __builtin_amdgcn_readfirstlane(e);
        const int ts_e = __builtin_amdgcn_readfirstlane(tstart[e]), cn_e = __builtin_amdgcn_readfirstlane(cnt[e]);
        u.e = e; u.pm = rt - ts_e; u.pn = pn; u.nvalid = cn_e - u.pm * BM; u.orow = rt * BM; u.brow = e * nexp_rows + pn * BM; return true;
    }
    __device__ __forceinline__ bool gathers() const { return list != nullptr; }
    __device__ __forceinline__ const unsigned* raw_addr(const Unit& u, int r) const { int idx = u.pm * BM + r; const int c1 = u.nvalid + u.pm * BM - 1; idx = idx < c1 ? idx : c1; return list + (size_t)u.e * LIST_CAP + idx; }
    __device__ __forceinline__ unsigned conv(unsigned ent) const { return (ent >> 2) * 1024u; }
    __device__ __forceinline__ unsigned arow_off(const Unit& u, int r) const {
        if (list) { int idx = u.pm * BM + r; const int c1 = u.nvalid + u.pm * BM - 1; idx = idx < c1 ? idx : c1; const unsigned ent = list[(size_t)u.e * LIST_CAP + idx]; return (ent >> 2) * 1024u; }
        return (unsigned)(u.orow + r) * 1024u;
    }
};

struct EpiPlain {
    bf16_t* O; int ldc;
    __device__ __forceinline__ void operator()(const f32x4 (&acc)[2][2][4][2], const Unit& u, int wr, int wc, int fr, int fq) const {
        const int row0 = u.orow + wr * 64 + fr, col0 = u.pn * BM + wc * 32 + 8 * fq;
#pragma unroll
        for (int ai = 0; ai < 2; ++ai)
#pragma unroll
            for (int m = 0; m < 4; ++m) { bf16_t* rowp = O + (size_t)(row0 + ai * HALF + m * 16) * ldc + col0;
#pragma unroll
                for (int bj = 0; bj < 2; ++bj) { const f32x4 v0 = acc[ai][bj][m][0], v1 = acc[ai][bj][m][1];
                    u32x4 w; w.x = pk2(v0[0], v0[1]); w.y = pk2(v0[2], v0[3]); w.z = pk2(v1[0], v1[1]); w.w = pk2(v1[2], v1[3]);
                    *(u32x4*)(rowp + bj * HALF) = w; } }
    }
};
struct EpiZ {
    bf16_t* O; int ldc; float* rs; unsigned char* Km; const f32x2* rope; LAS float* xch;
    __device__ __forceinline__ void operator()(const f32x4 (&acc)[2][2][4][2], const Unit& u, int wr, int wc, int fr, int fq) const {
        const int row0 = u.orow + wr * 64 + fr, col0 = u.pn * BM + wc * 32 + 8 * fq;
#pragma unroll
        for (int ai = 0; ai < 2; ++ai)
#pragma unroll
            for (int m = 0; m < 4; ++m) { bf16_t* rowp = O + (size_t)(row0 + ai * HALF + m * 16) * ldc + col0;
#pragma unroll
                for (int bj = 0; bj < 2; ++bj) { const f32x4 v0 = acc[ai][bj][m][0], v1 = acc[ai][bj][m][1];
                    u32x4 w; w.x = pk2(v0[0], v0[1]); w.y = pk2(v0[2], v0[3]); w.z = pk2(v1[0], v1[1]); w.w = pk2(v1[2], v1[3]);
                    *(u32x4*)(rowp + bj * HALF) = w; } }
        if (u.pn <= 1) {
            const int nb = u.pn == 0 ? 2 : 1;
#pragma unroll
            for (int ai = 0; ai < 2; ++ai)
#pragma unroll
                for (int m = 0; m < 4; ++m) { float ss = 0.f;
#pragma unroll
                    for (int bj = 0; bj < 2; ++bj) if (bj < nb) {
#pragma unroll
                        for (int n = 0; n < 2; ++n) { const f32x4 v = acc[ai][bj][m][n]; ss += (v[0] * v[0] + v[1] * v[1]) + (v[2] * v[2] + v[3] * v[3]); } }
                    ss += __shfl_xor(ss, 16); ss += __shfl_xor(ss, 32);
                    if (fq == 0) xch[wc * 256 + ai * HALF + wr * 64 + m * 16 + fr] = ss; }
            if (u.pn == 1 && wc == 0) {
#pragma unroll
                for (int ai = 0; ai < 2; ++ai)
#pragma unroll
                    for (int m = 0; m < 4; ++m) { const int row = u.orow + ai * HALF + wr * 64 + m * 16 + fr, b = row >> 13, pos = row & (SEQ - 1);
                        const f32x4 x1 = acc[ai][1][m][0], x2 = acc[ai][1][m][1]; const f32x2* rp = rope + pos * 16 + 4 * fq;
                        const f32x2 t0 = rp[0], t1 = rp[1], t2 = rp[2], t3 = rp[3]; const f32x4 cs = {t0.x, t1.x, t2.x, t3.x}, sn = {t0.y, t1.y, t2.y, t3.y};
                        const f32x4 o0 = x1 * cs - x2 * sn, o1 = x2 * cs + x1 * sn;
                        const u32x4 w = {pk2(o0[0], o0[1]), pk2(o0[2], o0[3]), pk2(o1[0], o1[1]), pk2(o1[2], o1[3])};
                        unsigned char* kp = Km + ((size_t)(b * 8) * 128 + (pos >> 6)) * 12288 + (8 + fq) * 1024 + (pos & 63) * 16;
#pragma unroll
                        for (int hh = 0; hh < 8; ++hh) *(u32x4*)(kp + (size_t)hh * 128 * 12288) = w; } }
            asm volatile("s_waitcnt lgkmcnt(0)\n\ts_barrier" ::: "memory");
            const int tid_ = (wr * 4 + wc) * 64 + fq * 16 + fr;
            if (tid_ < 256) { const float sq = (xch[tid_] + xch[256 + tid_]) + (xch[512 + tid_] + xch[768 + tid_]);
                rs[(size_t)u.pn * T + u.orow + tid_] = 1.f / sqrtf(sq * (u.pn == 0 ? 1.f / 256.f : 1.f / 128.f) + EPS); }
        }
    }
};
struct EpiQKV {
    bf16_t* Qm; unsigned char* Km; unsigned char* Vm; const f32x2* rope; int coff; const float* rs;
    __device__ __forceinline__ void operator()(const f32x4 (&acc)[2][2][4][2], const Unit& u, int wr, int wc, int fr, int fq) const {
#pragma unroll
        for (int bj = 0; bj < 2; ++bj) {
            const int cb = coff + u.pn * BM + bj * HALF + wc * 32;
            const int c0 = cb + 8 * fq;
#pragma unroll
            for (int ai = 0; ai < 2; ++ai)
#pragma unroll
                for (int m = 0; m < 4; ++m) {
                    int row = u.orow + ai * HALF + wr * 64 + m * 16 + fr;
                    asm volatile("" : "+v"(row) :: "memory");
                    const int b = row >> 13, s = row & (SEQ - 1);
                    const float rr = rs[row];
                    f32x4 v0 = acc[ai][bj][m][0] * rr, v1 = acc[ai][bj][m][1] * rr;
                    if (cb < 768) {
                        const int h = cb / 96, d = c0 - h * 96;
                        v0 = v0 * C2M; v1 = v1 * C2M;
                        if (d >= 64) { const int gq = (d - 64) >> 3; const f32x2* rp = rope + s * 16 + 4 * gq;
                            const f32x2 t0 = rp[0], t1 = rp[1], t2 = rp[2], t3 = rp[3];
                            const f32x4 cs = {t0.x, t1.x, t2.x, t3.x}, sn = {t0.y, t1.y, t2.y, t3.y};
                            const f32x4 o0 = v0 * cs - v1 * sn, o1 = v1 * cs + v0 * sn; v0 = o0; v1 = o1; }
                        u32x4 w; w.x = pk2(v0[0], v0[1]); w.y = pk2(v0[2], v0[3]); w.z = pk2(v1[0], v1[1]); w.w = pk2(v1[2], v1[3]);
                        *(u32x4*)(Qm + ((size_t)(b * 8 + h) * SEQ + s) * 96 + d) = w;
                    } else {
                        const int cc = c0 - 768, h = cc >> 7, dd = cc & 127;
                        u32x4 w; w.x = pk2(v0[0], v0[1]); w.y = pk2(v0[2], v0[3]); w.z = pk2(v1[0], v1[1]); w.w = pk2(v1[2], v1[3]);
                        const size_t tile = (size_t)(b * 8 + h) * 128 + (s >> 6);
                        if (dd < 64) *(u32x4*)(Km + tile * 12288 + (dd >> 3) * 1024 + (s & 63) * 16) = w;
                        else { const int d = dd - 64; *(u32x4*)(Vm + tile * 8192 + (d >> 5) * 4096 + ((s & 63) >> 4) * 1024 + (s & 15) * 64 + (d & 31) * 2) = w; }
                    }
                }
        }
    }
};
struct EpiGU {
    unsigned char* act; const float* bgu;
    __device__ __forceinline__ void operator()(const f32x4 (&acc)[2][2][4][2], const Unit& u, int wr, int wc, int fr, int fq) const {
        const int cl = u.pn * 128 + wc * 32 + 8 * fq;
        const float* bg = bgu + (size_t)u.e * 2048 + cl; const float* bu = bg + 1024;
        const f32x4 bg0 = *(const f32x4*)bg, bg1 = *(const f32x4*)(bg + 4), bu0 = *(const f32x4*)bu + 1.f, bu1 = *(const f32x4*)(bu + 4) + 1.f;
        constexpr float USC = 1.f / (W8S * A8S);
#pragma unroll
        for (int ai = 0; ai < 2; ++ai)
#pragma unroll
            for (int m = 0; m < 4; ++m) {
                const int row = u.orow + ai * HALF + wr * 64 + m * 16 + fr;
                f32x4 r4[2];
#pragma unroll
                for (int n = 0; n < 2; ++n) {
                    f32x4 gt = acc[ai][0][m][n] * USC + (n ? bg1 : bg0), up = acc[ai][1][m][n] * USC + (n ? bu1 : bu0);
#pragma unroll
                    for (int j = 0; j < 4; ++j) { gt[j] = fminf(gt[j], 7.f); up[j] = fminf(fmaxf(up[j], -6.f), 8.f); }
                    const f32x4 ea = gt * (-1.702f * LOG2E); f32x4 e;
#pragma unroll
                    for (int j = 0; j < 4; ++j) e[j] = __builtin_amdgcn_exp2f(ea[j]);
                    const f32x4 den = e * (1.f / A8S) + (1.f / A8S); f32x4 sg;
#pragma unroll
                    for (int j = 0; j < 4; ++j) sg[j] = __builtin_amdgcn_rcpf(den[j]);
                    r4[n] = (up * gt) * sg;
                }
                *(u32x2*)(act + (size_t)row * 1024 + cl) = (u32x2){pk4_fp8(r4[0][0], r4[0][1], r4[0][2], r4[0][3]), pk4_fp8(r4[1][0], r4[1][1], r4[1][2], r4[1][3])};
            }
    }
};
struct EpiDN {
    unsigned char* y; const float* bdn;
    __device__ __forceinline__ void operator()(const f32x4 (&acc)[2][2][4][2], const Unit& u, int wr, int wc, int fr, int fq) const {
        const int col0 = u.pn * BM + wc * 32 + 8 * fq;
        const float* bp = bdn + (size_t)u.e * 1024 + col0;
        f32x4 bv[2][2];
#pragma unroll
        for (int bj = 0; bj < 2; ++bj) { bv[bj][0] = *(const f32x4*)(bp + bj * HALF) * Y8S; bv[bj][1] = *(const f32x4*)(bp + bj * HALF + 4) * Y8S; }
#pragma unroll
        for (int ai = 0; ai < 2; ++ai)
#pragma unroll
            for (int m = 0; m < 4; ++m) {
                unsigned char* rowp = y + (size_t)(u.orow + ai * HALF + wr * 64 + m * 16 + fr) * 1024 + col0;
#pragma unroll
                for (int bj = 0; bj < 2; ++bj) { f32x4 v0 = acc[ai][bj][m][0] * (Y8S / (W8S * A8S)) + bv[bj][0], v1 = acc[ai][bj][m][1] * (Y8S / (W8S * A8S)) + bv[bj][1];
#pragma unroll
                    for (int j = 0; j < 4; ++j) { v0[j] = fminf(fmaxf(v0[j], -448.f), 448.f); v1[j] = fminf(fmaxf(v1[j], -448.f), 448.f); }
                    *(u32x2*)(rowp + bj * HALF) = (u32x2){pk4_fp8(v0[0], v0[1], v0[2], v0[3]), pk4_fp8(v1[0], v1[1], v1[2], v1[3])}; }
            }
    }
};
}

namespace att {
constexpr int NKS = 3, NVS = 4;
constexpr int LK = 0, KSL = 12288, LV = NKS * KSL, VSL = 8192, LWS = LV + NVS * VSL, LBT = LWS + 8 * 256, LEND = LBT + 4 * 648 * 4, LOST = 0;
static_assert(LEND <= 131072 && 8 * 4096 <= NKS * KSL, "attention LDS map");
constexpr float THR = 8.f;
typedef short v4i16_t __attribute__((ext_vector_type(4)));
__device__ __forceinline__ int crow(int r, int hi) { return (r & 3) + 8 * (r >> 2) + 4 * hi; }
__device__ __forceinline__ void glds16(const void* gsrc, unsigned lds_dst) { unsigned keep;
    asm volatile("s_mov_b32 %0, m0\n\ts_mov_b32 m0, %2\n\ts_nop 0\n\tglobal_load_lds_dwordx4 %1, off\n\ts_mov_b32 m0, %0" : "=&s"(keep) : "v"(gsrc), "s"(lds_dst) : "memory"); }
#define ATT_WAITBAR(N) asm volatile("s_waitcnt vmcnt(" #N ") lgkmcnt(0)\n\ts_barrier" ::: "memory")
__device__ __forceinline__ s16x4 vtr(const LAS char* p) { return __builtin_bit_cast(s16x4, __builtin_amdgcn_ds_read_tr16_b64_v4i16((LAS v4i16_t*)p)); }
__device__ __forceinline__ float max3(float a, float b, float c) { return __builtin_fmaxf(__builtin_fmaxf(a, b), c); }
__device__ __forceinline__ float rowmax(const f32x16& p0, const f32x16& p1) {
    float a = max3(p0[0], p0[1], p1[0]), b = max3(p0[2], p0[3], p1[1]); a = max3(a, p1[2], p1[3]);
#pragma unroll
    for (int r = 4; r < 16; r += 4) { a = max3(a, p0[r], p0[r + 1]); b = max3(b, p0[r + 2], p0[r + 3]); a = max3(a, p1[r], p1[r + 1]); b = max3(b, p1[r + 2], p1[r + 3]); }
    a = __builtin_fmaxf(a, b);
    auto rr = __builtin_amdgcn_permlane32_swap(__float_as_uint(a), __float_as_uint(a), false, false);
    return __builtin_fmaxf(__uint_as_float(rr[0]), __uint_as_float(rr[1]));
}
template <int ND0> __device__ __forceinline__ void qkt(f32x16& p0, f32x16& p1, unsigned kb, const bf16x8* qr, const f32x16& z, const f32x16& z1) {
    bf16x8 kf[2 * ND0];
#pragma unroll
    for (int i = 0; i < 2 * ND0; ++i) asm volatile("ds_read_b128 %0, %1 offset:%c2" : "=v"(kf[i]) : "v"(kb), "i"((i >> 1) * 2048 + (i & 1) * 512));
#pragma unroll
    for (int d0 = 0; d0 < ND0; ++d0) {
        asm volatile("s_waitcnt lgkmcnt(%c2)" : "+v"(kf[2 * d0]), "+v"(kf[2 * d0 + 1]) : "i"((2 * ND0 - 2 * d0 - 4) > 0 ? (2 * ND0 - 2 * d0 - 4) : 0));
        if (d0 == 0) { p0 = __builtin_amdgcn_mfma_f32_32x32x16_bf16(kf[0], qr[0], z, 0, 0, 0); p1 = __builtin_amdgcn_mfma_f32_32x32x16_bf16(kf[1], qr[0], z1, 0, 0, 0); }
        else { p0 = __builtin_amdgcn_mfma_f32_32x32x16_bf16(kf[2 * d0], qr[d0], p0, 0, 0, 0); p1 = __builtin_amdgcn_mfma_f32_32x32x16_bf16(kf[2 * d0 + 1], qr[d0], p1, 0, 0, 0); }
    }
}
__device__ __forceinline__ void exp_half(f32x16& p, float mref, float& sacc, u32x4& wa, u32x4& wb) {
#pragma unroll
    for (int r = 0; r < 16; ++r) { p[r] = __builtin_amdgcn_exp2f(p[r] - mref); sacc += p[r]; }
    wa = (u32x4){pk2(p[0], p[1]), pk2(p[2], p[3]), pk2(p[4], p[5]), pk2(p[6], p[7])};
    wb = (u32x4){pk2(p[8], p[9]), pk2(p[10], p[11]), pk2(p[12], p[13]), pk2(p[14], p[15])};
}
__device__ __forceinline__ void pv8(f32x16& o0, f32x16& o1, unsigned vb, u32x4 w0, u32x4 w1, u32x4 w2, u32x4 w3) {
    s16x4 lo[8], hh[8];
#pragma unroll
    for (int j = 0; j < 8; ++j) { const int i = (j >> 1) + 4 * (j & 1);
        asm volatile("ds_read_b64_tr_b16 %0, %1 offset:%c2" : "=v"(lo[i]) : "v"(vb), "i"((i >> 2) * 4096 + (i & 3) * 1024));
        asm volatile("ds_read_b64_tr_b16 %0, %1 offset:%c2" : "=v"(hh[i]) : "v"(vb), "i"((i >> 2) * 4096 + (i & 3) * 1024 + 512)); }
#define ATT_VF(i) (bf16x8){lo[i][0], lo[i][1], lo[i][2], lo[i][3], hh[i][0], hh[i][1], hh[i][2], hh[i][3]}
#define ATT_PVW(j, i) asm volatile("s_waitcnt lgkmcnt(%c2)" : "+v"(lo[i]), "+v"(hh[i]) : "i"((12 - 2 * (j)) > 0 ? (12 - 2 * (j)) : 0))
    ATT_PVW(0, 0); o0 = __builtin_amdgcn_mfma_f32_32x32x16_bf16(__builtin_bit_cast(bf16x8, w0), ATT_VF(0), o0, 0, 0, 0);
    ATT_PVW(1, 4); o1 = __builtin_amdgcn_mfma_f32_32x32x16_bf16(__builtin_bit_cast(bf16x8, w0), ATT_VF(4), o1, 0, 0, 0);
    ATT_PVW(2, 1); o0 = __builtin_amdgcn_mfma_f32_32x32x16_bf16(__builtin_bit_cast(bf16x8, w1), ATT_VF(1), o0, 0, 0, 0);
    ATT_PVW(3, 5); o1 = __builtin_amdgcn_mfma_f32_32x32x16_bf16(__builtin_bit_cast(bf16x8, w1), ATT_VF(5), o1, 0, 0, 0);
    ATT_PVW(4, 2); o0 = __builtin_amdgcn_mfma_f32_32x32x16_bf16(__builtin_bit_cast(bf16x8, w2), ATT_VF(2), o0, 0, 0, 0);
    ATT_PVW(5, 6); o1 = __builtin_amdgcn_mfma_f32_32x32x16_bf16(__builtin_bit_cast(bf16x8, w2), ATT_VF(6), o1, 0, 0, 0);
    ATT_PVW(6, 3); o0 = __builtin_amdgcn_mfma_f32_32x32x16_bf16(__builtin_bit_cast(bf16x8, w3), ATT_VF(3), o0, 0, 0, 0);
    ATT_PVW(7, 7); o1 = __builtin_amdgcn_mfma_f32_32x32x16_bf16(__builtin_bit_cast(bf16x8, w3), ATT_VF(7), o1, 0, 0, 0);
#undef ATT_VF
#undef ATT_PVW
}
__device__ __forceinline__ bool max_update(const f32x16& p0, const f32x16& p1, bool first, float& mref, float& l, LAS float* wsf, int r32, int hi) {
    const float rm = rowmax(p0, p1);
    if (first) { mref = rm; return false; }
    if (__any(rm > mref + THR)) { const float mn = __builtin_fmaxf(mref, rm); const float f = __builtin_amdgcn_exp2f(mref - mn); l *= f; if (hi == 0) wsf[r32] = f; mref = mn; return true; }
    return false;
}
__device__ __forceinline__ void rescale_o(f32x16& o0, f32x16& o1, const LAS float* wsf, int hi) {
#pragma unroll
    for (int r = 0; r < 16; ++r) { const float f = wsf[crow(r, hi)]; o0[r] *= f; o1[r] *= f; }
}
__device__ __forceinline__ void attn_store(f32x16& o0, f32x16& o1, float l, bf16* Ow, LAS char* shm, int wid, int lane, int r32, int hi) {
    LAS float* wsf = (LAS float*)(shm + LWS) + wid * 64;
    { auto rr = __builtin_amdgcn_permlane32_swap(__float_as_uint(l), __float_as_uint(l), false, false); l = __uint_as_float(rr[0]) + __uint_as_float(rr[1]); }
    if (hi == 0) wsf[32 + r32] = l;
    LDS_WAIT();
    LAS bf16* stg = (LAS bf16*)(shm + LOST) + wid * 2048;
#pragma unroll
    for (int r = 0; r < 16; ++r) { const int orow = crow(r, hi); const float rl = __builtin_amdgcn_rcpf(wsf[32 + orow]);
        stg[orow * 64 + r32] = (bf16)f2bf(o0[r] * rl); stg[orow * 64 + 32 + r32] = (bf16)f2bf(o1[r] * rl); }
    LDS_WAIT();
#pragma unroll
    for (int i = 0; i < 4; ++i) { const int row = i * 8 + (lane >> 3), ch = lane & 7; const u32x4 v = *(const LAS u32x4*)(stg + row * 64 + ch * 8); *(u32x4*)(Ow + (size_t)row * OPI + ch * 8) = v; }
}

template <bool CA> __device__ __forceinline__ void attn_unit(int bh, int ub, const bf16* Qm, const unsigned char* Km, const unsigned char* Vm, const bf16* Z, const float* rel_bias, bf16* O, LAS char* shm) {
    constexpr int ND0 = CA ? 4 : 6;
    int tid = threadIdx.x; asm volatile("" : "+v"(tid));
    const int lane = tid & 63, r32 = lane & 31, hi = lane >> 5, wid = __builtin_amdgcn_readfirstlane(tid >> 6);
    const bool late = wid >= 4;
    const unsigned lds0 = (unsigned)(uintptr_t)shm;
    const int b = bh >> 3, h = bh & 7; const size_t rowb = (size_t)b * SEQ;
    int NT, t0, t1, cqk = 0, qi = 0; const unsigned char* ksrc; const unsigned char* vsrc; size_t kst, vst; const LAS float* bt = nullptr;
    bf16x8 qr[ND0]; bf16* Ow;
    if constexpr (CA) {
        const int c0 = 4 * ub, kc_lo = c0 >= 8 ? c0 - 8 : 0; NT = c0 + 4 - kc_lo; cqk = c0 + (wid >> 1) - kc_lo; t1 = cqk; t0 = cqk >= 8 ? cqk - 8 : 0; qi = (wid & 1) * 32 + r32;
        LAS float* btw = (LAS float*)(shm + LBT); bt = btw;
        for (int i = tid; i < 4 * 648; i += 512) { const int c = i / 648, j = i - c * 648; int idx = 640 - (j + c); idx = idx > 319 ? 319 : (idx < 0 ? 0 : idx); btw[i] = rel_bias[h * 320 + idx] * LOG2E; }
        const bf16* Qw = Z + (rowb + c0 * 64 + wid * 32 + r32) * ZP + C_QC + h * 64;
#pragma unroll
        for (int d0 = 0; d0 < ND0; ++d0) { const u32x4 qv = *(const u32x4*)(Qw + d0 * 16 + hi * 8);
            const u32x4 qs = {pk2(bf2f(qv.x) * C2C, bf2f(qv.x >> 16) * C2C), pk2(bf2f(qv.y) * C2C, bf2f(qv.y >> 16) * C2C), pk2(bf2f(qv.z) * C2C, bf2f(qv.z >> 16) * C2C), pk2(bf2f(qv.w) * C2C, bf2f(qv.w >> 16) * C2C)};
            qr[d0] = __builtin_bit_cast(bf16x8, qs); }
        ksrc = (const unsigned char*)(Z + (rowb + kc_lo * 64 + lane) * ZP + C_KC + h * 64 + wid * 8); kst = (size_t)64 * ZP * 2;
        vsrc = (const unsigned char*)(Z + (rowb + kc_lo * 64 + 16 * (wid & 3) + (lane >> 2)) * ZP + C_VC + h * 64 + (wid >> 2) * 32 + (lane & 3) * 8); vst = (size_t)64 * ZP * 2;
        Ow = O + (rowb + c0 * 64 + wid * 32) * OPI + 512 + h * 64;
    } else {
        NT = 4 * ub + 4; t0 = 0; t1 = 4 * ub + (wid >> 1);
        const bf16* Qw = Qm + ((size_t)bh * SEQ + ub * 256 + wid * 32) * 96;
#pragma unroll
        for (int d0 = 0; d0 < ND0; ++d0) qr[d0] = *(const bf16x8*)(Qw + (size_t)r32 * 96 + d0 * 16 + hi * 8);
        ksrc = Km + (size_t)bh * 128 * 12288 + wid * 1024 + lane * 16; kst = 12288;
        vsrc = Vm + (size_t)bh * 128 * 8192 + wid * 1024 + lane * 16; vst = 8192;
        Ow = O + (rowb + ub * 256 + wid * 32) * OPI + h * 64;
    }
    VM_WAIT();
    const bool k2 = !CA && wid < 4;
    const unsigned kdst = lds0 + LK + wid * 1024, vdst = lds0 + LV + wid * 1024;
    const unsigned kp0 = lds0 + LK + hi * 1024 + r32 * 16;
    const unsigned vp0 = lds0 + LV + ((lane >> 4) & 1) * 32 + (lane & 3) * 8 + (4 * hi + ((lane & 15) >> 2)) * 64;
    LAS float* wsf = (LAS float*)(shm + LWS) + wid * 64;
#define ATT_DMA(tt) do { const unsigned kd_ = (unsigned)__builtin_amdgcn_readfirstlane(kdst + ((tt) % NKS) * KSL); glds16(ksrc + (size_t)(tt) * kst, kd_); if (k2) glds16(ksrc + (size_t)(tt) * kst + 8192, kd_ + 8192); \
        glds16(vsrc + (size_t)(tt) * vst, (unsigned)__builtin_amdgcn_readfirstlane(vdst + ((tt) & 3) * VSL)); } while (0)
    ATT_DMA(0); ATT_DMA(1);
    float mref = 0.f, l = 0.f; f32x16 o0, o1;
#pragma unroll
    for (int r = 0; r < 16; ++r) { o0[r] = 0.f; o1[r] = 0.f; }
    u32x4 w0 = {0u, 0u, 0u, 0u}, w1 = w0, w2 = w0, w3 = w0;
    bool pend = false;
#if PROBE_A >= 0
    unsigned long long tA_ = 0, tB_ = 0, tC_ = 0, tD_ = 0, tq_ = 0;
#define ATT_TS(acc) do { const unsigned long long n_ = __builtin_amdgcn_s_memrealtime(); acc += n_ - tq_; tq_ = n_; } while (0)
#else
#define ATT_TS(acc) do {} while (0)
#endif
#pragma unroll 1
    for (int t = 0; t < NT; ++t) {
#if PROBE_A >= 0
        tq_ = __builtin_amdgcn_s_memrealtime();
#endif
        if (t + 1 < NT) { if (k2) ATT_WAITBAR(3); else ATT_WAITBAR(2); } else ATT_WAITBAR(0);
        if (t + 2 < NT) ATT_DMA(t + 2);
        ATT_TS(tA_);
        unsigned kb_ = kp0 + (unsigned)((t % NKS) * KSL), vb_ = vp0 + (unsigned)((t & 3) * VSL), vq_ = vp0 + (unsigned)(((t + 3) & 3) * VSL);
        asm volatile("" : "+v"(kb_), "+v"(vb_), "+v"(vq_));
        if (late && pend) { pv8(o0, o1, vq_, w0, w1, w2, w3); pend = false; }
        if (t >= t0 && t <= t1) {
            f32x16 p0, p1;
            if constexpr (CA) { f32x16 c0, c1;
                const int Mb = 640 - ((cqk - t) * 64 + qi + 63); const LAS float* bp = bt + (Mb & 3) * 648 + (Mb & ~3) + 4 * hi;
#pragma unroll
                for (int g = 0; g < 4; ++g) { const f32x4 a = *(const LAS f32x4*)(bp + 8 * g), b2 = *(const LAS f32x4*)(bp + 8 * g + 32);
                    c0[4 * g] = a.x; c0[4 * g + 1] = a.y; c0[4 * g + 2] = a.z; c0[4 * g + 3] = a.w; c1[4 * g] = b2.x; c1[4 * g + 1] = b2.y; c1[4 * g + 2] = b2.z; c1[4 * g + 3] = b2.w; }
                qkt<ND0>(p0, p1, kb_, qr, c0, c1); }
            else { const f32x16 z = {0.f, 0.f, 0.f, 0.f, 0.f, 0.f, 0.f, 0.f, 0.f, 0.f, 0.f, 0.f, 0.f, 0.f, 0.f, 0.f}; qkt<ND0>(p0, p1, kb_, qr, z, z); }
            const bool resc = max_update(p0, p1, t == t0, mref, l, wsf, r32, hi);
            float sa = 0.f, sb = 0.f;
            exp_half(p0, mref, sa, w0, w1); exp_half(p1, mref, sb, w2, w3);
            l += sa + sb;
            if (resc) rescale_o(o0, o1, wsf, hi);
#if PROBE_A >= 0
            asm volatile("s_nop 0" : "+v"(w0), "+v"(w1), "+v"(w2), "+v"(w3));
#endif
            ATT_TS(tC_);
            if (late) pend = true;
            else pv8(o0, o1, vb_, w0, w1, w2, w3);
#if PROBE_A >= 0
            asm volatile("s_nop 0" : "+v"(o0), "+v"(o1));
#endif
            ATT_TS(tD_);
        }
    }
#if PROBE_A >= 0
    if (!CA && blockIdx.x == 0 && tid == PROBE_TID) { LAS unsigned long long* st_ = (LAS unsigned long long*)(shm + 147456 - 256 + 64); st_[16] += tA_; st_[17] += tB_; st_[18] += tC_; st_[19] += tD_; }
#endif
    if (late && pend) { const unsigned vq_ = vp0 + (unsigned)(((NT - 1) & 3) * VSL); pv8(o0, o1, vq_, w0, w1, w2, w3); }
#undef ATT_DMA
    asm volatile("s_waitcnt lgkmcnt(0)\n\ts_barrier" ::: "memory");
    attn_store(o0, o1, l, Ow, shm, wid, lane, r32, hi);
    asm volatile("s_waitcnt lgkmcnt(0)\n\ts_barrier" ::: "memory");
}
}

#define XB_TMO      128
#define XB_XCNT(j)  (256  + 64 * (j))
#define XB_XSUB(j)  (1280 + 64 * (j))
#define XB_XGEN(j)  (2304 + 64 * (j))
#define XB_TOP      3328
#define XB_TOPGEN   3392
#define XCD_BAR_WORDS 3456
#define XB_SPIN_CAP (1u << 18)
__device__ __forceinline__ unsigned xb_ld(unsigned* p)              { return __hip_atomic_load(p, __ATOMIC_RELAXED, __HIP_MEMORY_SCOPE_AGENT); }
__device__ __forceinline__ unsigned xb_add(unsigned* p, unsigned v) { return __hip_atomic_fetch_add(p, v, __ATOMIC_RELAXED, __HIP_MEMORY_SCOPE_AGENT); }
__device__ __forceinline__ unsigned xb_xcc_id() { return (unsigned)__builtin_amdgcn_s_getreg((3 << 11) | 20) & 0xFu; }
#define XB_SPIN(cond, bar) do { unsigned _sp = 0; while (cond) { __builtin_amdgcn_s_sleep(1); \
    if ((++_sp & 255u) == 0u) { if (xb_ld(&(bar)[XB_TMO])) break; if (_sp > XB_SPIN_CAP) { atomicAdd(&(bar)[XB_TMO], 1u); break; } } } } while (0)
struct XcdBarrier { unsigned* bar; unsigned x; volatile LAS unsigned* st; };
__device__ __forceinline__ XcdBarrier xcd_barrier_post(unsigned* bar, volatile LAS unsigned* st) {
    XcdBarrier b; b.bar = bar; b.x = xb_xcc_id(); b.st = st;
    if (threadIdx.x == 0) (void)xb_add(&bar[XB_XCNT(b.x)], 1u);
    return b;
}
__device__ __forceinline__ void xcd_barrier_complete(unsigned* bar, unsigned x, unsigned& nloc, unsigned& nx) {
    const unsigned G = gridDim.x * gridDim.y * gridDim.z;
    unsigned sum, cnt, mine, sp = 0u;
    for (;;) {
        sum = 0u; cnt = 0u; mine = 0u;
#pragma unroll
        for (unsigned j = 0; j < 16; ++j) { const unsigned c = xb_ld(&bar[XB_XCNT(j)]); sum += c; cnt += (c > 0u) ? 1u : 0u; mine = (j == x) ? c : mine; }
        if (sum == G) break;
        __builtin_amdgcn_s_sleep(1);
        if ((++sp & 255u) == 0u) { if (xb_ld(&bar[XB_TMO])) break; if (sp > XB_SPIN_CAP) { atomicAdd(&bar[XB_TMO], 1u); break; } }
    }
    nloc = mine > 0u ? mine : 1u; nx = cnt > 0u ? cnt : 1u;
}
__device__ __forceinline__ void xcd_barrier(const XcdBarrier& b) {
    asm volatile("s_waitcnt vmcnt(0)" ::: "memory");
    __syncthreads();
    if (threadIdx.x == 0) {
        unsigned* bar = b.bar;
        __builtin_amdgcn_s_waitcnt(0);
        unsigned nloc = b.st[0], nx = b.st[1];
        if (nloc == 0u) { xcd_barrier_complete(bar, b.x, nloc, nx); b.st[0] = nloc; b.st[1] = nx; }
        const unsigned old = xb_add(&bar[XB_XSUB(b.x)], 1u);
        const unsigned gen = old / nloc;
        if (old + 1u == (gen + 1u) * nloc) {
            __builtin_amdgcn_fence(__ATOMIC_RELEASE, "agent");
            asm volatile("s_waitcnt vmcnt(0)" ::: "memory");
            const unsigned og = xb_add(&bar[XB_TOP], 1u);
            const unsigned tg = og / nx;
            if (og + 1u == (tg + 1u) * nx) xb_add(&bar[XB_TOPGEN], 1u);
            else XB_SPIN(xb_ld(&bar[XB_TOPGEN]) == tg, bar);
            __builtin_amdgcn_fence(__ATOMIC_ACQUIRE, "agent");
            xb_add(&bar[XB_XGEN(b.x)], 1u);
            asm volatile("s_waitcnt vmcnt(0)" ::: "memory");
        } else {
            XB_SPIN(xb_ld(&bar[XB_XGEN(b.x)]) == gen, bar);
            __builtin_amdgcn_fence(__ATOMIC_ACQUIRE, "agent");
            asm volatile("s_waitcnt vmcnt(0)" ::: "memory");
        }
    }
    __syncthreads();
}

struct Args { const float* in[21]; float* out; unsigned char* ws; int ph_lo, ph_hi; };
enum { I_X = 0, I_C, I_WADA, I_BADA, I_GPRE1, I_GPOST1, I_GPRE2, I_GPOST2, I_WIN, I_GQ, I_WQB, I_GKV, I_WKVB, I_RELB, I_WO, I_WR, I_BR, I_WGU, I_BGU, I_WDN, I_BDN };

__device__ __forceinline__ int qperm(int n) { const int h = n / 96, d = n - 96 * h; if (d < 64) return n; const int j = d - 64, i = j & 15, x2 = j >> 4; return h * 96 + 64 + 8 * (i >> 2) + 4 * x2 + (i & 3); }
__device__ __forceinline__ int krperm(int n) { if (n < C_KR || n >= C_KR + 32) return n; const int j = n - C_KR, x2 = j >> 4, i = j & 15; return C_KR + 8 * (i >> 2) + 4 * x2 + (i & 3); }
__device__ __forceinline__ void tr_item(const float* W, int ldw, bf16* WT, int ldt, int k0, int kdst0, int nsrc0, int mode, int ndst0, LAS float* scr, int lane, const float* rsc = nullptr) {
#pragma unroll 8
    for (int i = 0; i < 32; ++i) { const int kk = 2 * i + (lane >> 5); scr[kk * 33 + (lane & 31)] = W[(size_t)(k0 + kk) * ldw + nsrc0 + (lane & 31)] * (rsc ? rsc[k0 + kk] : 1.f); }
    LDS_WAIT(); asm volatile("" ::: "memory");
    const int c = lane & 7;
#pragma unroll
    for (int j = 0; j < 4; ++j) { const int n = (lane >> 3) + 8 * j; const LAS float* s = scr + (8 * c) * 33 + n;
        u32x4 o; o.x = pk2(s[0 * 33], s[1 * 33]); o.y = pk2(s[2 * 33], s[3 * 33]); o.z = pk2(s[4 * 33], s[5 * 33]); o.w = pk2(s[6 * 33], s[7 * 33]);
        const int dr = mode == 1 ? qperm(nsrc0 + n) : mode == 2 ? krperm(nsrc0 + n) : ndst0 + n;
        *(u32x4*)(WT + (size_t)dr * ldt + kdst0 + k0 + 8 * c) = o; }
    LDS_WAIT(); asm volatile("" ::: "memory");
}

__device__ __forceinline__ void tr_item8(const float* W, int ldw, unsigned char* WT, int ldt, int k0, int nsrc0, int ndst0, float scale, LAS float* scr, int lane) {
#pragma unroll 8
    for (int i = 0; i < 32; ++i) { const int kk = 2 * i + (lane >> 5); scr[kk * 33 + (lane & 31)] = W[(size_t)(k0 + kk) * ldw + nsrc0 + (lane & 31)] * scale; }
    LDS_WAIT(); asm volatile("" ::: "memory");
    const int n = lane >> 1, hf = lane & 1; const LAS float* s = scr + (32 * hf) * 33 + n;
    unsigned w[8];
#pragma unroll
    for (int q = 0; q < 8; ++q) w[q] = pk4_fp8(s[(4 * q) * 33], s[(4 * q + 1) * 33], s[(4 * q + 2) * 33], s[(4 * q + 3) * 33]);
    unsigned char* dst = WT + (size_t)(ndst0 + n) * ldt + k0 + 32 * hf;
    *(u32x4*)dst = (u32x4){w[0], w[1], w[2], w[3]}; *(u32x4*)(dst + 16) = (u32x4){w[4], w[5], w[6], w[7]};
    LDS_WAIT(); asm volatile("" ::: "memory");
}

__global__ void __launch_bounds__(512, 2) fwd(Args args) {
    extern __shared__ __attribute__((aligned(16))) unsigned char lds_raw[];
    LAS unsigned char* lds = (LAS unsigned char*)lds_raw;
    const int tid = threadIdx.x, lane = tid & 63, wave = __builtin_amdgcn_readfirstlane(tid >> 6);
    const int G = gridDim.x; const int bx = blockIdx.x; const int vcu = (G % 8 == 0) ? (bx % 8) * (G / 8) + bx / 8 : bx;
    unsigned char* ws = args.ws;
    unsigned* ctl = (unsigned*)(ws + WS_CTL);
    volatile LAS unsigned* MISC = (volatile LAS unsigned*)(lds + MISC_OFF);
    if (tid < 64) MISC[tid] = 0u;
    __syncthreads();
#if MK_ONE_LAUNCH
    XcdBarrier bar = xcd_barrier_post(ctl + CW_BAR, MISC + 8);
#define GRID_BAR() xcd_barrier(bar)
#else
#define GRID_BAR() do {} while (0)
#endif
    const int lo = args.ph_lo, hi_ph = args.ph_hi;
#if PROBE_A >= 0
#define STAMP(k) do { if (blockIdx.x == 0 && tid == 0) { LAS unsigned long long* st_ = (LAS unsigned long long*)(lds + MISC_OFF + 64); st_[k] = __builtin_amdgcn_s_memrealtime(); if ((k) == PROBE_A && PROBE_B == 15) st_[20] = __builtin_amdgcn_s_memtime(); if ((k) == PROBE_A + 1 && PROBE_B == 15) st_[21] = __builtin_amdgcn_s_memtime(); if ((k) == PROBE_A && PROBE_B == 14) st_[14] = 0ull; if ((k) == PROBE_A + 1 && PROBE_B == 14) st_[13] = st_[14]; } } while (0)
#else
#define STAMP(k) do {} while (0)
#endif
    STAMP(0);
#ifndef PHM
#define PHM 0x1fff
#endif
#define IN(k) (((PHM >> (k)) & 1) && lo <= (k) && (k) < hi_ph)
#define BOTH(k) (IN(k) && IN((k) + 1))
    const float* x = args.in[I_X]; float* out = args.out;
    float* mod = (float*)(ws + WS_MOD); float* wrT = (float*)(ws + WS_WRT); float* gates = (float*)(ws + WS_GATE); f32x2* rope = (f32x2*)(ws + WS_ROPE);
    bf16* WQ = (bf16*)(ws + WS_WQKV); bf16* WKV = (bf16*)(ws + WS_WQKV + 512 * 1024); unsigned* tinfo = (unsigned*)(ws + WS_TINFO); unsigned* lists = (unsigned*)(ws + WS_LIST);
    float* rsv = (float*)(ws + WS_RS);
    bf16* WIN = (bf16*)(ws + WS_WIN); bf16* WOt = (bf16*)(ws + WS_WO); unsigned char* WDN = ws + WS_WDN; unsigned char* WGU = ws + WS_WGU;
    bf16* Hb = (bf16*)(ws + WS_H); unsigned char* H8 = ws + WS_H8; bf16* Z = (bf16*)(ws + WS_Z); bf16* Qm = (bf16*)(ws + WS_QM); unsigned char* Km = ws + WS_KM; unsigned char* Vm = ws + WS_VM;
    bf16* Ob = (bf16*)(ws + WS_O); bf16* OP = (bf16*)(ws + WS_OP); unsigned char* ACT = ws + WS_ACT; unsigned char* Y = ws + WS_Y;
    const int gw = vcu * 8 + wave, NGW = G * 8, gt = vcu * 512 + tid, NGT = G * 512;

    if (IN(0)) {
        { constexpr int T_GU = 32 * 8 * 32, T_DN = 32 * 4 * 32, NTILE = T_GU + T_DN;
          const int per = (NTILE + G - 1) / G, tl0 = vcu * per, tl1 = (tl0 + per < NTILE) ? tl0 + per : NTILE;
          const unsigned ldsb = (unsigned)(uintptr_t)lds;
          auto tile_src = [&](int tl, const float*& W, int& ldw, int& e, int& kb, int& nb, bool& gu) {
              gu = tl < T_GU; const int r = gu ? tl : tl - T_GU; kb = r & 31; const int q = r >> 5;
              if (gu) { nb = q & 7; e = q >> 3; W = args.in[I_WGU] + (size_t)e * 1024 * 2048; ldw = 2048; } else { nb = q & 3; e = q >> 2; W = args.in[I_WDN] + (size_t)e * 1024 * 1024; ldw = 1024; } };
#define P0_DMA(tl, buf) do { const float* W_; int ldw_, e_, kb_, nb_; bool gu_; tile_src(tl, W_, ldw_, e_, kb_, nb_, gu_); \
              _Pragma("unroll") for (int j = 0; j < 4; ++j) { const int k_ = kb_ * 32 + wave * 4 + j; \
                  att::glds16((const unsigned char*)(W_ + (size_t)k_ * ldw_ + nb_ * 256) + lane * 16, (unsigned)__builtin_amdgcn_readfirstlane(ldsb + (buf) * 32768 + (wave * 4 + j) * 1024)); } } while (0)
#pragma unroll 1
          for (int q = 0; q < 3; ++q) if (tl0 + q < tl1) P0_DMA(tl0 + q, q);
#pragma unroll 1
          for (int tl = tl0; tl < tl1; ++tl) { const int buf = (tl - tl0) & 3;
              const int rem = tl1 - 1 - tl;
              if (rem >= 2) asm volatile("s_waitcnt vmcnt(8)\n\ts_barrier" ::: "memory"); else if (rem == 1) asm volatile("s_waitcnt vmcnt(4)\n\ts_barrier" ::: "memory"); else asm volatile("s_waitcnt vmcnt(0)\n\ts_barrier" ::: "memory");
              if (tl + 3 < tl1) P0_DMA(tl + 3, (buf + 3) & 3);
              const float* W; int ldw, e, kb, nb; bool gu; tile_src(tl, W, ldw, e, kb, nb, gu);
              const int i = tid & 255, kh = tid >> 8; const LAS float* sc = (const LAS float*)(lds + buf * 32768) + (16 * kh) * 256 + i;
              unsigned w[4];
#pragma unroll
              for (int q = 0; q < 4; ++q) w[q] = pk4_fp8(sc[(4 * q) * 256] * W8S, sc[(4 * q + 1) * 256] * W8S, sc[(4 * q + 2) * 256] * W8S, sc[(4 * q + 3) * 256] * W8S);
              size_t drow; unsigned char* WT;
              if (gu) { drow = (size_t)e * 2048 + (2 * (nb & 3) + (i >> 7)) * 256 + (nb >> 2) * 128 + (i & 127); WT = WGU; } else { drow = (size_t)e * 1024 + nb * 256 + i; WT = WDN; }
              *(u32x4*)(WT + drow * 1024 + kb * 32 + 16 * kh) = (u32x4){w[0], w[1], w[2], w[3]}; }
#undef P0_DMA
          asm volatile("s_waitcnt vmcnt(0) lgkmcnt(0)\n\ts_barrier" ::: "memory"); }
        LAS float* scr = (LAS float*)(lds + wave * 16384);
        constexpr int I_IN = 16 * 61, I_O = 16 * 32, I_QB = 4 * 24, I_KVB = 2 * 32;
        constexpr int NITEMS = I_IN + I_O + I_QB + I_KVB;
        for (int it = gw; it < NITEMS; it += NGW) {
            int r = it;
            if (r < I_IN) { const int kb = r / 61, nb = r % 61; tr_item(args.in[I_WIN], IN_W, WIN, 1024, kb * 64, 0, nb * 32, 2, 0, scr, lane); continue; } r -= I_IN;
            if (r < I_O) { const int kb = r >> 5, nb = r & 31; tr_item(args.in[I_WO], 1024, WOt, OPI, kb * 64, 0, nb * 32, 0, nb * 32, scr, lane); continue; } r -= I_O;
            if (r < I_QB) { const int kb = r / 24, nb = r % 24; tr_item(args.in[I_WQB], 768, WQ, 256, kb * 64, 0, nb * 32, 1, 0, scr, lane, args.in[I_GQ]); continue; } r -= I_QB;
            { const int kb = r >> 5, nb = r & 31; tr_item(args.in[I_WKVB], 1024, WKV, 256, kb * 64, 128, nb * 32, 0, nb * 32, scr, lane, args.in[I_GKV]); }
        }
        const u32x4 z4 = {0u, 0u, 0u, 0u};
        for (int i = gt; i < 12288; i += NGT) *(u32x4*)((unsigned char*)WIN + (size_t)IN_W * 2048 + (size_t)i * 16) = z4;
        for (int i = gt; i < 1024 * 16; i += NGT) { const int rr = i >> 4, cc = i & 15; *(u32x4*)((unsigned char*)WKV + (size_t)rr * 512 + cc * 16) = z4; }
        for (int i = gt; i < SEQ * 16; i += NGT) { const int pos = i >> 4, fi = i & 15;
            const float invf = __builtin_amdgcn_exp2f(-(float)fi * (13.287712379549449f / 16.f)); const float ang = (float)pos * invf;
            const double rev = (double)ang * 0.15915494309189535; const float fr = (float)(rev - __builtin_rint(rev));
            rope[i] = (f32x2){__builtin_amdgcn_cosf(fr), __builtin_amdgcn_sinf(fr)}; }
        for (int i = gt; i < 32 * 1024; i += NGT) { const int e = i >> 10, d = i & 1023; wrT[i] = args.in[I_WR][d * 32 + e]; }
        { LAS float* scs = (LAS float*)lds;
          __syncthreads();
          for (int i = tid; i < 8192; i += 512) { const float v = args.in[I_C][i]; scs[i] = v / (1.f + __expf(-v)); }
          __syncthreads();
          for (int cb = vcu; cb < 256; cb += G) { const int col0 = cb * 24 + wave * 3; float wv[16][3];
#pragma unroll
              for (int i = 0; i < 16; ++i)
#pragma unroll
                  for (int c = 0; c < 3; ++c) wv[i][c] = args.in[I_WADA][(size_t)(lane + 64 * i) * MODW + col0 + c];
#pragma unroll 1
              for (int bb = 0; bb < 8; ++bb) { float s0 = 0.f, s1 = 0.f, s2 = 0.f;
#pragma unroll
                  for (int i = 0; i < 16; ++i) { const float sv = scs[bb * 1024 + lane + 64 * i]; s0 += sv * wv[i][0]; s1 += sv * wv[i][1]; s2 += sv * wv[i][2]; }
                  s0 = wave_sum(s0); s1 = wave_sum(s1); s2 = wave_sum(s2);
                  if (lane == 0) { mod[bb * MODW + col0] = s0 + args.in[I_BADA][col0]; mod[bb * MODW + col0 + 1] = s1 + args.in[I_BADA][col0 + 1]; mod[bb * MODW + col0 + 2] = s2 + args.in[I_BADA][col0 + 2]; } } }
          __syncthreads(); }
        if (BOTH(0)) GRID_BAR(); STAMP(1);
    }

    if (IN(1)) {
        for (int tile = vcu; tile < T / 256; tile += G) {
            const int row0 = tile * 256, b = row0 >> 13; const float* mb = mod + b * MODW;
            f32x4 a[4], s[4];
#pragma unroll
            for (int j = 0; j < 4; ++j) { const int d = 4 * lane + 256 * j; const f32x4 g = *(const f32x4*)(args.in[I_GPRE1] + d), sc1 = *(const f32x4*)(mb + 1024 + d); a[j] = g * (1.f + sc1); s[j] = *(const f32x4*)(mb + d); }
            for (int i = 0; i < 32; ++i) { const int row = row0 + wave * 32 + i; const f32x4* xr = (const f32x4*)(x + (size_t)row * DM) + lane;
                f32x4 v[4]; float ss = 0.f;
#pragma unroll
                for (int j = 0; j < 4; ++j) { v[j] = xr[64 * j]; ss += (v[j].x * v[j].x + v[j].y * v[j].y) + (v[j].z * v[j].z + v[j].w * v[j].w); }
                const float rstd = 1.f / sqrtf(wave_sum(ss) * (1.f / DM) + EPS);
                u32x2* o8 = (u32x2*)(Hb + (size_t)row * DM) + lane;
#pragma unroll
                for (int j = 0; j < 4; ++j) { const f32x4 hv = v[j] * rstd * a[j] + s[j]; o8[64 * j] = (u32x2){pk2(hv.x, hv.y), pk2(hv.z, hv.w)}; } }
        }
        if (BOTH(1)) GRID_BAR(); STAMP(2);
    }

    if (IN(2)) {
        pg8::Gemm g{Hb, WIN, 2048, 2048}; pg8::DenseSched S{NIN / 256, (T / 256) * (NIN / 256), G, vcu, 2048}; pg8::EpiZ E{Z, ZP, rsv, Km, rope, (LAS float*)(lds + 131072)};
        pg8::gemm_phase<pg8::EpiZ, pg8::DenseSched, true, false>(lds, g, S, E);
        if (BOTH(2)) GRID_BAR(); STAMP(3);
    }

    if (IN(3)) { STAMP(4); }

    if (IN(4)) {
        { pg8::Gemm g{Z, WQ, 512, 512}; pg8::DenseSched S{3, (T / 256) * 3, G, vcu, ZP * 2}; pg8::EpiQKV E{Qm, Km, Vm, rope, 0, rsv};
          pg8::gemm_phase<pg8::EpiQKV, pg8::DenseSched, true, false>(lds, g, S, E); }
        { pg8::Gemm g{Z + 128, WKV, 512, 512}; pg8::DenseSched S{4, (T / 256) * 4, G, vcu, ZP * 2}; pg8::EpiQKV E{Qm, Km, Vm, rope, 768, rsv + T};
          pg8::gemm_phase<pg8::EpiQKV, pg8::DenseSched, true, false>(lds, g, S, E); }
        if (BOTH(4)) GRID_BAR(); STAMP(5);
    }

    if (IN(5)) {
        for (int v = vcu; v < 256; v += G) {
            const int bh = v >> 2, s4 = v & 3;
#pragma unroll 1
            for (int i = 0; i < 8; ++i) { const int qb = 8 * (i >> 1) + ((i & 1) ? 7 - s4 : s4); att::attn_unit<false>(bh, qb, Qm, Km, Vm, Z, nullptr, Ob, (LAS char*)lds); }
            STAMP(12);
#pragma unroll 1
            for (int i = 0; i < 8; ++i) { const int id = v * 8 + i; att::attn_unit<true>(id >> 5, id & 31, Qm, Km, Vm, Z, args.in[I_RELB], Ob, (LAS char*)lds); }
        }
        if (BOTH(5)) GRID_BAR(); STAMP(6);
    }

    if (IN(6)) {
        pg8::Gemm g{Ob, WOt, 2048, OPI * 2}; pg8::DenseSched S{4, (T / 256) * 4, G, vcu, OPI * 2}; pg8::EpiPlain E{OP, 1024};
        pg8::gemm_phase<pg8::EpiPlain, pg8::DenseSched, true, false>(lds, g, S, E);
        if (BOTH(6)) GRID_BAR(); STAMP(7);
    }

    if (IN(7)) {
        constexpr int HS = 1028;
        LAS float* Hs = (LAS float*)lds;
        LAS float* part = (LAS float*)lds;
        LAS float* Lg = (LAS float*)(lds + 132096);
        LAS int* hist = (LAS int*)(lds + 132096 + 4352);
        LAS int* gbase = hist + 64;
        unsigned* gcnt = ctl + CW_CNT;
        for (int tile = vcu; tile < T / 256; tile += G) {
            const int row0 = tile * 256, b = row0 >> 13; const float* mb = mod + b * MODW;
            f32x4 A1[4], A2[4], S2[4];
#pragma unroll
            for (int j = 0; j < 4; ++j) { const int d = 4 * lane + 256 * j;
                A1[j] = *(const f32x4*)(mb + 2048 + d) * *(const f32x4*)(args.in[I_GPOST1] + d);
                A2[j] = *(const f32x4*)(args.in[I_GPRE2] + d) * (1.f + *(const f32x4*)(mb + 4096 + d));
                S2[j] = *(const f32x4*)(mb + 3072 + d); }
            for (int grp = 0; grp < 8; ++grp) {
                const int tok0 = row0 + grp * 32;
                if (tid < 32) hist[tid] = 0;
                { f32x4 xa[4][4]; u32x2 pa[4][4];
#pragma unroll
                  for (int i = 0; i < 4; ++i) { const int row = tok0 + wave * 4 + i; const f32x4* xr = (const f32x4*)(x + (size_t)row * DM) + lane; const u32x2* pr = (const u32x2*)(OP + (size_t)row * DM) + lane;
#pragma unroll
                      for (int j = 0; j < 4; ++j) { xa[i][j] = xr[64 * j]; pa[i][j] = pr[64 * j]; } }
#pragma unroll
                  for (int i = 0; i < 4; ++i) { const int tl = wave * 4 + i, row = tok0 + tl;
                    f32x4 xv[4], ov[4]; float ss = 0.f;
#pragma unroll
                    for (int j = 0; j < 4; ++j) { xv[j] = xa[i][j]; const u32x2 p = pa[i][j]; ov[j] = (f32x4){bf2f(p.x), bf2f(p.x >> 16), bf2f(p.y), bf2f(p.y >> 16)};
                        ss += (ov[j].x * ov[j].x + ov[j].y * ov[j].y) + (ov[j].z * ov[j].z + ov[j].w * ov[j].w); }
                    const float r1 = 1.f / sqrtf(wave_sum(ss) * (1.f / DM) + EPS); float ss2 = 0.f;
#pragma unroll
                    for (int j = 0; j < 4; ++j) { xv[j] = xv[j] + A1[j] * (ov[j] * r1); ss2 += (xv[j].x * xv[j].x + xv[j].y * xv[j].y) + (xv[j].z * xv[j].z + xv[j].w * xv[j].w); }
                    const float r2 = 1.f / sqrtf(wave_sum(ss2) * (1.f / DM) + EPS);
                    unsigned* h8 = (unsigned*)(H8 + (size_t)row * DM) + lane;
#pragma unroll
                    for (int j = 0; j < 4; ++j) { const f32x4 hv = xv[j] * r2 * A2[j] + S2[j]; h8[64 * j] = pk4_fp8(fminf(fmaxf(hv.x * A8S, -448.f), 448.f), fminf(fmaxf(hv.y * A8S, -448.f), 448.f), fminf(fmaxf(hv.z * A8S, -448.f), 448.f), fminf(fmaxf(hv.w * A8S, -448.f), 448.f));
                        *(LAS f32x4*)(Hs + tl * HS + 4 * lane + 256 * j) = hv; } } }
                __syncthreads();
                f32x16 pl;
#pragma unroll
                for (int r = 0; r < 16; ++r) pl[r] = 0.f;
                { const int tk = lane & 31, hi = lane >> 5; const LAS float* ap = Hs + tk * HS + wave * 128 + 4 * hi; const float* bp = wrT + tk * 1024 + wave * 128 + 4 * hi;
#pragma unroll 4
                    for (int m = 0; m < 16; ++m) { const f32x4 av = *(const LAS f32x4*)(ap + 8 * m); const f32x4 bv = *(const f32x4*)(bp + 8 * m);
                        pl = __builtin_amdgcn_mfma_f32_32x32x2f32(av.x, bv.x, pl, 0, 0, 0); pl = __builtin_amdgcn_mfma_f32_32x32x2f32(av.y, bv.y, pl, 0, 0, 0);
                        pl = __builtin_amdgcn_mfma_f32_32x32x2f32(av.z, bv.z, pl, 0, 0, 0); pl = __builtin_amdgcn_mfma_f32_32x32x2f32(av.w, bv.w, pl, 0, 0, 0); } }
                __syncthreads();
                { const int e = lane & 31, hi = lane >> 5;
#pragma unroll
                    for (int r = 0; r < 16; ++r) part[(wave * 32 + att::crow(r, hi)) * 33 + e] = pl[r]; }
                __syncthreads();
                { const int tk = tid & 31, e0 = (tid >> 5) * 2;
#pragma unroll
                    for (int q = 0; q < 2; ++q) { const int e = e0 + q; float s = args.in[I_BR][e];
#pragma unroll
                        for (int w = 0; w < 8; ++w) s += part[(w * 32 + tk) * 33 + e];
                        Lg[tk * 33 + e] = s; } }
                __syncthreads();
                if (wave == 0) {
                    const int tk = lane & 31, tok = tok0 + tk; int ei[4]; float ev[4]; int li[4];
                    { int c0 = -1, c1 = -1, c2 = -1;
#pragma unroll
                        for (int k = 0; k < 4; ++k) { float best = -INFINITY; int bi = 0;
                            for (int e = 0; e < 32; ++e) { const float v = Lg[tk * 33 + e]; if (e != c0 && e != c1 && e != c2 && v > best) { best = v; bi = e; } }
                            ei[k] = bi; ev[k] = best; if (k == 0) c0 = bi; else if (k == 1) c1 = bi; else if (k == 2) c2 = bi; } }
                    float gsum = 0.f, gv[4];
#pragma unroll
                    for (int k = 0; k < 4; ++k) { gv[k] = __expf(ev[k] - ev[0]); gsum += gv[k]; }
                    const float ginv = 1.f / gsum;
                    if (lane < 32) {
#pragma unroll
                        for (int k = 0; k < 4; ++k) li[k] = __hip_atomic_fetch_add(hist + ei[k], 1, __ATOMIC_RELAXED, __HIP_MEMORY_SCOPE_WORKGROUP);
                        *(f32x4*)(gates + (size_t)tok * 4) = (f32x4){gv[0] * ginv, gv[1] * ginv, gv[2] * ginv, gv[3] * ginv};
                    }
                    LDS_WAIT(); asm volatile("" ::: "memory");
                    { const int c = hist[lane & 31]; int gb = 0; if (c > 0 && lane < 32) gb = (int)__hip_atomic_fetch_add(gcnt + lane, (unsigned)c, __ATOMIC_RELAXED, __HIP_MEMORY_SCOPE_AGENT); if (lane < 32) gbase[lane] = gb; }
                    LDS_WAIT(); asm volatile("" ::: "memory");
                    if (lane < 32) {
#pragma unroll
                        for (int k = 0; k < 4; ++k) { const int e = ei[k], idx = gbase[e] + li[k];
                            lists[(size_t)e * LIST_CAP + idx] = (unsigned)tok * 4u + (unsigned)k;
                            tinfo[(size_t)tok * 4 + k] = ((unsigned)e << 16) | (unsigned)idx; }
                    }
                }
                __syncthreads();
            }
        }
        if (BOTH(7)) GRID_BAR(); STAMP(8);
    }

#define MOE_TABLES() do { LAS int* tst = (LAS int*)(lds + TAB_OFF); LAS int* cn = tst + 40; \
        if (tid < 32) cn[tid] = (int)__hip_atomic_load(ctl + CW_CNT + tid, __ATOMIC_RELAXED, __HIP_MEMORY_SCOPE_AGENT); \
        __syncthreads(); \
        if (tid == 0) { int acc_ = 0; for (int e = 0; e < 32; ++e) { tst[e] = acc_; acc_ += (cn[e] + 255) >> 8; } tst[32] = acc_; } \
        __syncthreads(); } while (0)
    if (IN(8)) { MOE_TABLES();
        pg8::Gemm g{H8, WGU, 1024, 1024}; pg8::MoeSched S{(const LAS int*)(lds + TAB_OFF), (const LAS int*)(lds + TAB_OFF) + 40, lists, 8, G, vcu, 2048};
        pg8::EpiGU E{ACT, args.in[I_BGU]}; pg8::gemm_phase<pg8::EpiGU, pg8::MoeSched, true, true>(lds, g, S, E);
        if (BOTH(8)) GRID_BAR(); STAMP(9); }
    if (IN(9)) { MOE_TABLES();
        pg8::Gemm g{ACT, WDN, 1024, 1024}; pg8::MoeSched S{(const LAS int*)(lds + TAB_OFF), (const LAS int*)(lds + TAB_OFF) + 40, nullptr, 4, G, vcu, 1024};
        pg8::EpiDN E{Y, args.in[I_BDN]}; pg8::gemm_phase<pg8::EpiDN, pg8::MoeSched, true, true>(lds, g, S, E);
        if (BOTH(9)) GRID_BAR(); STAMP(10); }

    if (IN(10)) {
        MOE_TABLES();
        const LAS int* tst = (const LAS int*)(lds + TAB_OFF);
        for (int tile = vcu; tile < T / 256; tile += G) {
            const int row0 = tile * 256, b = row0 >> 13; const float* mb = mod + b * MODW;
            f32x4 A3[4], A1[4];
#pragma unroll
            for (int j = 0; j < 4; ++j) { const int d = 4 * lane + 256 * j; A3[j] = *(const f32x4*)(mb + 5120 + d) * *(const f32x4*)(args.in[I_GPOST2] + d); A1[j] = *(const f32x4*)(mb + 2048 + d) * *(const f32x4*)(args.in[I_GPOST1] + d); }
            for (int i = 0; i < 32; ++i) { const int row = row0 + wave * 32 + i;
                const f32x4 gv = *(const f32x4*)(gates + (size_t)row * 4); const u32x4 ti = *(const u32x4*)(tinfo + (size_t)row * 4);
                const unsigned* y0 = (const unsigned*)(Y + ((size_t)tst[ti.x >> 16] * 256 + (ti.x & 0xffffu)) * 1024) + lane; const unsigned* y1 = (const unsigned*)(Y + ((size_t)tst[ti.y >> 16] * 256 + (ti.y & 0xffffu)) * 1024) + lane;
                const unsigned* y2 = (const unsigned*)(Y + ((size_t)tst[ti.z >> 16] * 256 + (ti.z & 0xffffu)) * 1024) + lane; const unsigned* y3 = (const unsigned*)(Y + ((size_t)tst[ti.w >> 16] * 256 + (ti.w & 0xffffu)) * 1024) + lane;
                f32x4 f[4]; float ss = 0.f; const f32x4 gs = gv * (1.f / Y8S);
#pragma unroll
                for (int j = 0; j < 4; ++j) { const unsigned p0 = y0[64 * j], p1 = y1[64 * j], p2 = y2[64 * j], p3 = y3[64 * j];
                    const f32x2 a0 = __builtin_amdgcn_cvt_pk_f32_fp8(p0, false), a1 = __builtin_amdgcn_cvt_pk_f32_fp8(p0, true), b0 = __builtin_amdgcn_cvt_pk_f32_fp8(p1, false), b1 = __builtin_amdgcn_cvt_pk_f32_fp8(p1, true);
                    const f32x2 c0 = __builtin_amdgcn_cvt_pk_f32_fp8(p2, false), c1 = __builtin_amdgcn_cvt_pk_f32_fp8(p2, true), d0 = __builtin_amdgcn_cvt_pk_f32_fp8(p3, false), d1 = __builtin_amdgcn_cvt_pk_f32_fp8(p3, true);
                    f[j] = (f32x4){a0.x, a0.y, a1.x, a1.y} * gs.x + (f32x4){b0.x, b0.y, b1.x, b1.y} * gs.y + (f32x4){c0.x, c0.y, c1.x, c1.y} * gs.z + (f32x4){d0.x, d0.y, d1.x, d1.y} * gs.w;
                    ss += (f[j].x * f[j].x + f[j].y * f[j].y) + (f[j].z * f[j].z + f[j].w * f[j].w); }
                const float rs = 1.f / sqrtf(wave_sum(ss) * (1.f / DM) + EPS);
                const f32x4* xr = (const f32x4*)(x + (size_t)row * DM) + lane; const u32x2* pr = (const u32x2*)(OP + (size_t)row * DM) + lane;
                f32x4 ov[4]; float so = 0.f;
#pragma unroll
                for (int j = 0; j < 4; ++j) { const u32x2 p = pr[64 * j]; ov[j] = (f32x4){bf2f(p.x), bf2f(p.x >> 16), bf2f(p.y), bf2f(p.y >> 16)}; so += (ov[j].x * ov[j].x + ov[j].y * ov[j].y) + (ov[j].z * ov[j].z + ov[j].w * ov[j].w); }
                const float r1 = 1.f / sqrtf(wave_sum(so) * (1.f / DM) + EPS);
                f32x4* outr = (f32x4*)(out + (size_t)row * DM) + lane;
#pragma unroll
                for (int j = 0; j < 4; ++j) outr[64 * j] = xr[64 * j] + A1[j] * (ov[j] * r1) + A3[j] * (f[j] * rs); }
        }
    }
#if BENCH_GEMM >= 2 && BENCH_GEMM <= 4
    GRID_BAR();
    { pg8::Gemm g{ws + WS_Y, WOt, BENCH_GEMM == 2 ? 2048 : BENCH_GEMM == 3 ? 1024 : 512, OPI * 2}; pg8::DenseSched S{4, (T / 256) * 4, G, vcu, 2048}; pg8::EpiPlain E{(bf16*)(ws + WS_O), 1024};
      pg8::gemm_phase<pg8::EpiPlain, pg8::DenseSched, true, false>(lds, g, S, E); }
#endif
    STAMP(11);
#if PROBE_A >= 0
    if (blockIdx.x == 0 && tid == 0) { const LAS unsigned long long* st = (const LAS unsigned long long*)(lds + MISC_OFF + 64);
        const long long dt_ = (PROBE_B == 15) ? (long long)((st[21] - st[20]) * 100ull / (st[PROBE_A + 1] - st[PROBE_A])) * 100 : (PROBE_B >= 16) ? (long long)st[PROBE_B] : (PROBE_B == 14) ? (long long)st[13] : (long long)(st[PROBE_B] - st[PROBE_A]);
        if (dt_ > (long long)(PROBE_X) * 100) out[0] = 100.f; }
#endif
#undef IN
#undef BOTH
}


#if MK_DEBUG
__device__ __forceinline__ unsigned hsh(unsigned x) { x ^= x >> 16; x *= 0x7feb352dU; x ^= x >> 15; x *= 0x846ca68bU; x ^= x >> 16; return x; }
__device__ __forceinline__ void diag_max(unsigned* ctl, int slot, float err) { if (!(err == err)) err = 1e30f; if (err < 0.f) err = -err; atomicMax(ctl + CW_DIAG + slot, __float_as_uint(err)); }
__device__ __forceinline__ float relerr(float got, float want, float flo) { return fabsf(got - want) / (fabsf(want) + flo); }
__device__ __forceinline__ float kimg(const unsigned char* Km, int bh, int key, int d) { return bf2f(*(const bf16*)(Km + ((size_t)bh * 128 + (key >> 6)) * 12288 + (d >> 3) * 1024 + (key & 63) * 16 + (d & 7) * 2)); }
__device__ __forceinline__ float vimg(const unsigned char* Vm, int bh, int key, int d) { return bf2f(*(const bf16*)(Vm + ((size_t)bh * 128 + (key >> 6)) * 8192 + (d >> 5) * 4096 + ((key & 63) >> 4) * 1024 + (key & 15) * 64 + (d & 31) * 2)); }
__device__ __forceinline__ float f8dec(unsigned b) { const unsigned e = (b >> 3) & 15u, m = b & 7u; float v = e ? (1.f + m * 0.125f) * exp2f((float)e - 7.f) : m * 0.001953125f; return (b & 0x80u) ? -v : v; }
__device__ __forceinline__ float dot8(const unsigned char* a, const unsigned char* b, int n) { float s = 0.f; for (int k = 0; k < n; ++k) s += f8dec(a[k]) * f8dec(b[k]); return s; }
__device__ __forceinline__ unsigned f8enc(float v) { return __builtin_amdgcn_cvt_pk_fp8_f32(v, 0.f, 0u, false) & 0xffu; }
__device__ __forceinline__ float dotbf(const bf16* a, const bf16* b, int n) { float s = 0.f; for (int k = 0; k < n; ++k) s += bf2f(a[k]) * bf2f(b[k]); return s; }

__global__ void __launch_bounds__(256) dbg_chk(Args a, int which, int p) {
    unsigned char* ws = a.ws; unsigned* ctl = (unsigned*)(ws + WS_CTL);
    const int gt = blockIdx.x * 256 + threadIdx.x, NGT = gridDim.x * 256, lane = threadIdx.x & 63, gwv = gt >> 6;
    float* mod = (float*)(ws + WS_MOD); float* wrT = (float*)(ws + WS_WRT); float* gates = (float*)(ws + WS_GATE); f32x2* rope = (f32x2*)(ws + WS_ROPE);
    bf16* WQ = (bf16*)(ws + WS_WQKV); bf16* WKV = (bf16*)(ws + WS_WQKV + 512 * 1024); unsigned* tinfo = (unsigned*)(ws + WS_TINFO); unsigned* lists = (unsigned*)(ws + WS_LIST);
    bf16* WIN = (bf16*)(ws + WS_WIN); bf16* WOt = (bf16*)(ws + WS_WO); unsigned char* WDN = ws + WS_WDN; unsigned char* WGU = ws + WS_WGU;
    bf16* Hb = (bf16*)(ws + WS_H); unsigned char* H8 = ws + WS_H8; bf16* Z = (bf16*)(ws + WS_Z); bf16* Qm = (bf16*)(ws + WS_QM); unsigned char* Km = ws + WS_KM; unsigned char* Vm = ws + WS_VM;
    bf16* Ob = (bf16*)(ws + WS_O); bf16* OP = (bf16*)(ws + WS_OP); unsigned char* ACT = ws + WS_ACT; unsigned char* Y = ws + WS_Y;
    float* dbgv = (float*)(ws + WS_DBG); unsigned* gcnt = ctl + CW_CNT;
    const float* x = a.in[I_X];
    if (which == 0) {
        for (int i = gt; i < 65536; i += NGT) { const unsigned h = hsh(i), h2 = hsh(i + 77777u);
            { const int n = h & 2047, k = (h >> 11) & 1023; const unsigned want = n < IN_W ? f2bf(a.in[I_WIN][(size_t)k * IN_W + n]) : 0u; if (want != WIN[(size_t)n * 1024 + k]) diag_max(ctl, 0, 10.f); }
            { const int n = h & 1023, k = (h >> 10) & 1023; if (f2bf(a.in[I_WO][(size_t)k * 1024 + n]) != WOt[(size_t)n * OPI + k]) diag_max(ctl, 0, 11.f); }
            { const int e = h2 & 31, rr = (h2 >> 5) & 2047, k = (h2 >> 16) & 1023, pn = rr >> 8, bj = (rr >> 7) & 1, j = rr & 127, col = bj * 1024 + pn * 128 + j;
              if (f8enc(a.in[I_WGU][((size_t)e * 1024 + k) * 2048 + col] * W8S) != WGU[((size_t)e * 2048 + rr) * 1024 + k]) diag_max(ctl, 0, 12.f); }
            { const int e = h2 & 31, n = (h2 >> 5) & 1023, k = (h2 >> 16) & 1023; if (f8enc(a.in[I_WDN][((size_t)e * 1024 + k) * 1024 + n] * W8S) != WDN[((size_t)e * 1024 + n) * 1024 + k]) diag_max(ctl, 0, 13.f); }
            { const int ns = h % 768, k = (h >> 10) & 255; if (f2bf(a.in[I_WQB][(size_t)k * 768 + ns]) != WQ[(size_t)qperm(ns) * 256 + k]) diag_max(ctl, 0, 14.f); }
            { const int n = h2 & 1023, k = (h2 >> 10) & 127; if (f2bf(a.in[I_WKVB][(size_t)k * 1024 + n]) != WKV[(size_t)n * 256 + 128 + k] || WKV[(size_t)n * 256 + k] != 0) diag_max(ctl, 0, 15.f); }
        }
    } else if (which == 1) {
        for (int i = gt; i < 2048; i += NGT) { const unsigned h = hsh(i); const int b = h & 7, j = (h >> 3) % MODW; float s = 0.f;
            for (int k = 0; k < 1024; ++k) { const float v = a.in[I_C][b * 1024 + k]; s += (v / (1.f + expf(-v))) * a.in[I_WADA][(size_t)k * MODW + j]; }
            diag_max(ctl, 1, relerr(mod[b * MODW + j], s + a.in[I_BADA][j], 0.1f) * 30.f); }
        for (int i = gt; i < 4096; i += NGT) { const unsigned h = hsh(i + 999u); const int pos = h & 8191, fi = (h >> 13) & 15;
            const float invf = __builtin_amdgcn_exp2f(-(float)fi * (13.287712379549449f / 16.f)); const float ang = (float)pos * invf;
            const double tp = 6.283185307179586; double r = (double)ang; r -= tp * __builtin_rint(r / tp); const double r2 = r * r; double sn = r, cs = 1.0, ts = r, tc = 1.0;
            for (int n = 1; n <= 14; ++n) { tc *= -r2 / (double)((2 * n - 1) * (2 * n)); cs += tc; ts *= -r2 / (double)((2 * n) * (2 * n + 1)); sn += ts; }
            const f32x2 g = rope[pos * 16 + fi]; diag_max(ctl, 1, (fabsf(g.x - (float)cs) + fabsf(g.y - (float)sn)) * 30.f); }
        for (int i = gt; i < 32768; i += NGT) { const int e = i >> 10, d = i & 1023; if (wrT[i] != a.in[I_WR][d * 32 + e]) diag_max(ctl, 1, 9.f); }
    } else if (which == 2) {
        for (int i = gt; i < 2048; i += NGT) { const unsigned h = hsh(i); const int row = h & 65535, col = (h >> 16) & 1023, b = row >> 13; float ss = 0.f;
            for (int k = 0; k < 1024; ++k) { const float v = x[(size_t)row * 1024 + k]; ss += v * v; }
            const float rstd = 1.f / sqrtf(ss / 1024.f + EPS); const float want = x[(size_t)row * 1024 + col] * rstd * a.in[I_GPRE1][col] * (1.f + mod[b * MODW + 1024 + col]) + mod[b * MODW + col];
            diag_max(ctl, 2, relerr(bf2f(Hb[(size_t)row * 1024 + col]), want, 0.5f)); }
    } else if (which == 3) {
        for (int i = gt; i < 4096; i += NGT) { const unsigned h = hsh(i); const int row = h & 65535, n = (h >> 16) % IN_W;
            diag_max(ctl, 3, relerr(bf2f(Z[(size_t)row * ZP + n]), dotbf(Hb + (size_t)row * 1024, WIN + (size_t)n * 1024, 1024), 0.5f)); }
    } else if (which == 4) {
        bf16* AQ = Hb;
        for (int i = gt; i < 2048; i += NGT) { const unsigned h = hsh(i); const int row = h & 65535, col = (h >> 16) % 384; const bf16* zr = Z + (size_t)row * ZP; float ss = 0.f, want;
            if (col < 256) { for (int k = 0; k < 256; ++k) { const float v = bf2f(zr[k]); ss += v * v; } want = bf2f(zr[col]) / sqrtf(ss / 256.f + EPS) * a.in[I_GQ][col]; }
            else { for (int k = 256; k < 384; ++k) { const float v = bf2f(zr[k]); ss += v * v; } want = bf2f(zr[col]) / sqrtf(ss / 128.f + EPS) * a.in[I_GKV][col - 256]; }
            diag_max(ctl, 4, relerr(bf2f(AQ[(size_t)row * KQKV + col]), want, 0.3f));
            const int hh = (h >> 16) & 7, jp = (h >> 19) & 31, g = jp >> 3, t = jp & 7, fi = 4 * g + (t & 3), x2s = t >> 2, pos = row & 8191, b = row >> 13;
            const float x1 = bf2f(zr[C_KR + fi]), x2 = bf2f(zr[C_KR + 16 + fi]); const f32x2 cs = rope[pos * 16 + fi];
            const float wk = x2s ? x2 * cs.x + x1 * cs.y : x1 * cs.x - x2 * cs.y;
            diag_max(ctl, 4, relerr(kimg(Km, b * 8 + hh, pos, 64 + jp), wk, 0.3f)); }
    } else if (which == 5) {
        bf16* AQ = Hb;
        for (int i = gt; i < 4096; i += NGT) { const unsigned h = hsh(i); const int row = h & 65535, c = (h >> 16) % NQKV, b = row >> 13, s = row & 8191; const bf16* ar = AQ + (size_t)row * KQKV;
            if (c < 768) { const int hh = c / 96, d = c % 96; float want, got = bf2f(Qm[((size_t)(b * 8 + hh) * SEQ + s) * 96 + d]);
                if (d < 64) want = dotbf(ar, WQ + (size_t)c * 256, 256) * C2M;
                else { const int jp = d - 64, g = jp >> 3, t = jp & 7, fi = 4 * g + (t & 3), x2s = t >> 2, cpart = hh * 96 + 64 + 8 * g + (t & 3) + (x2s ? 0 : 4);
                    const float dc = dotbf(ar, WQ + (size_t)c * 256, 256) * C2M, dp = dotbf(ar, WQ + (size_t)cpart * 256, 256) * C2M; const float x1 = x2s ? dp : dc, x2 = x2s ? dc : dp; const f32x2 cs = rope[s * 16 + fi];
                    want = x2s ? x2 * cs.x + x1 * cs.y : x1 * cs.x - x2 * cs.y; }
                diag_max(ctl, 5, relerr(got, want, 0.1f)); }
            else { const int cc = c - 768, hh = cc >> 7, dd = cc & 127; const float want = dotbf(ar + 128, WKV + (size_t)cc * 256, 256);
                const float got = dd < 64 ? kimg(Km, b * 8 + hh, s, dd) : vimg(Vm, b * 8 + hh, s, dd - 64); diag_max(ctl, 5, relerr(got, want, 0.3f)); } }
    } else if (which == 6) {
        for (int smp = gwv; smp < 256; smp += NGT / 64) { const unsigned h = hsh(smp * 3 + 1); const int b = h & 7, hh = (h >> 3) & 7; int s = (h >> 6) & 8191; if (smp < 16) s = smp * 17; const int bh = b * 8 + hh, nk = ((s >> 6) + 1) * 64;
            const bf16* q = Qm + ((size_t)bh * SEQ + s) * 96; float m = -INFINITY;
            for (int k = lane; k < nk; k += 64) { float sc = 0.f; for (int d = 0; d < 96; ++d) sc += bf2f(q[d]) * kimg(Km, bh, k, d); m = fmaxf(m, sc); }
            for (int o = 1; o < 64; o <<= 1) m = fmaxf(m, __shfl_xor(m, o));
            float l = 0.f; float acc[64];
#pragma unroll
            for (int d = 0; d < 64; ++d) acc[d] = 0.f;
            for (int k = lane; k < nk; k += 64) { float sc = 0.f; for (int d = 0; d < 96; ++d) sc += bf2f(q[d]) * kimg(Km, bh, k, d); const float e = exp2f(sc - m); l += e;
#pragma unroll
                for (int d = 0; d < 64; ++d) acc[d] += e * vimg(Vm, bh, k, d); }
            l = wave_sum(l); float mine = 0.f, sq = 0.f;
#pragma unroll
            for (int d = 0; d < 64; ++d) { const float v = wave_sum(acc[d]) / l; sq += v * v; if (lane == d) mine = v; }
            const float rms = sqrtf(sq / 64.f); const float got = bf2f(Ob[((size_t)b * SEQ + s) * OPI + hh * 64 + lane]);
            diag_max(ctl, 6, fabsf(got - mine) / (fabsf(mine) + 0.3f * rms + 1e-6f)); }
    } else if (which == 7) {
        for (int smp = gwv; smp < 256; smp += NGT / 64) { const unsigned h = hsh(smp * 5 + 2); const int b = h & 7, hh = (h >> 3) & 7; int s = (h >> 6) & 8191; if (smp < 16) s = smp * 41; const int cq = s >> 6, k0 = (cq >= 8 ? cq - 8 : 0) * 64, k1 = (cq + 1) * 64;
            const bf16* q = Z + ((size_t)b * SEQ + s) * ZP + C_QC + hh * 64; float m = -INFINITY;
            for (int k = k0 + lane; k < k1; k += 64) { const bf16* kr = Z + ((size_t)b * SEQ + k) * ZP + C_KC + hh * 64; float sc = 0.f; for (int d = 0; d < 64; ++d) sc += bf2f(q[d]) * bf2f(kr[d]);
                int rel = s - k; rel = rel < -63 ? -63 : (rel > 256 ? 256 : rel); sc = sc * 0.125f + a.in[I_RELB][hh * 320 + rel + 63]; m = fmaxf(m, sc); }
            for (int o = 1; o < 64; o <<= 1) m = fmaxf(m, __shfl_xor(m, o));
            float l = 0.f; float acc[64];
#pragma unroll
            for (int d = 0; d < 64; ++d) acc[d] = 0.f;
            for (int k = k0 + lane; k < k1; k += 64) { const bf16* kr = Z + ((size_t)b * SEQ + k) * ZP + C_KC + hh * 64; const bf16* vr = Z + ((size_t)b * SEQ + k) * ZP + C_VC + hh * 64; float sc = 0.f; for (int d = 0; d < 64; ++d) sc += bf2f(q[d]) * bf2f(kr[d]);
                int rel = s - k; rel = rel < -63 ? -63 : (rel > 256 ? 256 : rel); sc = sc * 0.125f + a.in[I_RELB][hh * 320 + rel + 63]; const float e = expf(sc - m); l += e;
#pragma unroll
                for (int d = 0; d < 64; ++d) acc[d] += e * bf2f(vr[d]); }
            l = wave_sum(l); float mine = 0.f, sq = 0.f;
#pragma unroll
            for (int d = 0; d < 64; ++d) { const float v = wave_sum(acc[d]) / l; sq += v * v; if (lane == d) mine = v; }
            const float rms = sqrtf(sq / 64.f); const float got = bf2f(Ob[((size_t)b * SEQ + s) * OPI + 512 + hh * 64 + lane]);
            diag_max(ctl, 7, fabsf(got - mine) / (fabsf(mine) + 0.3f * rms + 1e-6f)); }
    } else if (which == 8) {
        for (int i = gt; i < 4096; i += NGT) { const unsigned h = hsh(i); const int row = h & 65535, n = (h >> 16) & 1023;
            diag_max(ctl, 8, relerr(bf2f(OP[(size_t)row * 1024 + n]), dotbf(Ob + (size_t)row * OPI, WOt + (size_t)n * OPI, 1024), 0.2f)); }
    } else if (which == 9 || which == 10) {
        for (int i = gt; i < 1024; i += NGT) { const unsigned h = hsh(i + 31u * which); const int row = h & 65535, col = (h >> 16) & 1023, b = row >> 13; const float* mb = mod + b * MODW;
            float ss = 0.f; for (int k = 0; k < 1024; ++k) { const float v = bf2f(OP[(size_t)row * 1024 + k]); ss += v * v; }
            const float r1 = 1.f / sqrtf(ss / 1024.f + EPS); float ss2 = 0.f;
            for (int k = 0; k < 1024; ++k) { const float v = x[(size_t)row * 1024 + k] + mb[2048 + k] * (bf2f(OP[(size_t)row * 1024 + k]) * r1 * a.in[I_GPOST1][k]); ss2 += v * v; }
            const float r2 = 1.f / sqrtf(ss2 / 1024.f + EPS);
            if (which == 9) { const float x1 = x[(size_t)row * 1024 + col] + mb[2048 + col] * (bf2f(OP[(size_t)row * 1024 + col]) * r1 * a.in[I_GPOST1][col]);
                const float h2 = x1 * r2 * a.in[I_GPRE2][col] * (1.f + mb[4096 + col]) + mb[3072 + col];
                diag_max(ctl, 9, relerr(f8dec(H8[(size_t)row * 1024 + col]) / A8S, h2, 0.3f) * 0.4f); }
            else { float lg[32];
#pragma unroll
                for (int e = 0; e < 32; ++e) lg[e] = a.in[I_BR][e];
                for (int k = 0; k < 1024; ++k) { const float x1 = x[(size_t)row * 1024 + k] + mb[2048 + k] * (bf2f(OP[(size_t)row * 1024 + k]) * r1 * a.in[I_GPOST1][k]);
                    const float h2 = x1 * r2 * a.in[I_GPRE2][k] * (1.f + mb[4096 + k]) + mb[3072 + k];
#pragma unroll
                    for (int e = 0; e < 32; ++e) lg[e] += h2 * a.in[I_WR][k * 32 + e]; }
                int ci[5]; float cv[5];
#pragma unroll
                for (int k = 0; k < 5; ++k) { float best = -INFINITY; int bi = 0;
#pragma unroll
                    for (int e = 0; e < 32; ++e) { bool used = false;
#pragma unroll
                        for (int q = 0; q < 5; ++q) if (q < k && ci[q] == e) used = true;
                        if (!used && lg[e] > best) { best = lg[e]; bi = e; } }
                    ci[k] = bi; cv[k] = best; }
                bool tie = false;
#pragma unroll
                for (int k = 0; k < 4; ++k) if (cv[k] - cv[k + 1] < 2e-4f) tie = true;
                if (!tie) { float gs = 0.f, gv[4];
#pragma unroll
                    for (int k = 0; k < 4; ++k) { gv[k] = expf(cv[k] - cv[0]); gs += gv[k]; }
#pragma unroll
                    for (int k = 0; k < 4; ++k) { const unsigned ti = tinfo[(size_t)row * 4 + k]; const int e = ti >> 16, idx = ti & 0xffff;
                        if (e != ci[k]) diag_max(ctl, 10, 1.f);
                        else { diag_max(ctl, 10, fabsf(gates[(size_t)row * 4 + k] - gv[k] / gs) * 10.f);
                            if (idx >= (int)gcnt[e]) diag_max(ctl, 10, 2.f);
                            else if (lists[(size_t)e * LIST_CAP + idx] != (unsigned)row * 4u + k) diag_max(ctl, 10, 3.f); } } } } }
        if (which == 10 && gt == 0) { unsigned s0 = 0; for (int e = 0; e < 32; ++e) s0 += gcnt[e]; if (s0 != 262144u) diag_max(ctl, 10, 4.f); }
    } else if (which == 11 || which == 12) {
        for (int i = gt; i < 4096; i += NGT) { const unsigned h = hsh(i + 7u * which); const int e = h & 31, cnt = (int)gcnt[e]; if (cnt <= 0) continue;
            const int idx = (int)(((h >> 5) & 0xffff) % (unsigned)cnt), col = (h >> 21) & 1023; int ts = 0; for (int q = 0; q < e; ++q) ts += ((int)gcnt[q] + 255) >> 8;
            const int row = ts * 256 + idx; const unsigned ent = lists[(size_t)e * LIST_CAP + idx]; const int tok = ent >> 2;
            if (which == 11) { const int pn = col >> 7, j = col & 127;
                float gte = dot8(H8 + (size_t)tok * 1024, WGU + ((size_t)e * 2048 + pn * 256 + j) * 1024, 1024) / (W8S * A8S) + a.in[I_BGU][e * 2048 + col];
                float up = dot8(H8 + (size_t)tok * 1024, WGU + ((size_t)e * 2048 + pn * 256 + 128 + j) * 1024, 1024) / (W8S * A8S) + a.in[I_BGU][e * 2048 + 1024 + col];
                gte = fminf(gte, 7.f); up = fminf(fmaxf(up, -7.f), 7.f); const float want = (up + 1.f) * (gte / (1.f + expf(-1.702f * gte)));
                diag_max(ctl, 11, relerr(f8dec(ACT[(size_t)row * 1024 + col]) / A8S, want, 0.2f) * 0.4f); }
            else { const float want = dot8(ACT + (size_t)row * 1024, WDN + ((size_t)e * 1024 + col) * 1024, 1024) / (W8S * A8S) + a.in[I_BDN][e * 1024 + col];
                diag_max(ctl, 12, relerr(f8dec(Y[(size_t)row * 1024 + col]) / Y8S, want, 0.2f) * 0.4f); } }
    } else if (which == 15 || which == 16) {
        for (int i = gt; i < 1024; i += NGT) { const unsigned h = hsh(i + 4242u); const int row = h & 65535, col = (h >> 16) & 1023, b = row >> 13;
            if (which == 15) { const f32x4 gv = *(const f32x4*)(gates + (size_t)row * 4); float ss = 0.f, fc = 0.f;
                size_t yr[4];
                for (int q = 0; q < 4; ++q) { const unsigned ti = tinfo[(size_t)row * 4 + q]; const int e = ti >> 16; int ts = 0; for (int z = 0; z < e; ++z) ts += ((int)gcnt[z] + 255) >> 8; yr[q] = ((size_t)ts * 256 + (ti & 0xffffu)) * 1024; }
                for (int k = 0; k < 1024; ++k) { const float f = (gv.x * f8dec(Y[yr[0] + k]) + gv.y * f8dec(Y[yr[1] + k]) + gv.z * f8dec(Y[yr[2] + k]) + gv.w * f8dec(Y[yr[3] + k])) / Y8S; ss += f * f; if (k == col) fc = f; }
                float so = 0.f; for (int k = 0; k < 1024; ++k) { const float v = bf2f(OP[(size_t)row * 1024 + k]); so += v * v; }
                const float x1 = x[(size_t)row * 1024 + col] + mod[b * MODW + 2048 + col] * (bf2f(OP[(size_t)row * 1024 + col]) / sqrtf(so / 1024.f + EPS) * a.in[I_GPOST1][col]);
                dbgv[i] = x1 + mod[b * MODW + 5120 + col] * (fc / sqrtf(ss / 1024.f + EPS) * a.in[I_GPOST2][col]); }
            else diag_max(ctl, 15, relerr(a.out[(size_t)row * 1024 + col], dbgv[i], 0.5f) * 30.f); }
    }
}
__global__ void __launch_bounds__(256) dbg_report(Args a) {
    unsigned* ctl = (unsigned*)(a.ws + WS_CTL); int fs = -1; float fe = 0.f;
    for (int s = 15; s >= 0; --s) { const float e = __uint_as_float(ctl[CW_DIAG + s]); if (e > 0.03f) { fs = s; fe = e; } }
    if (fs < 0) return;
    int lvl = 1; float e = fe / 0.03f; while (e >= 2.f && lvl < 8) { e *= 0.5f; ++lvl; }
    float V = (float)(1 + lvl) * 1000.f; for (int s = 0; s < fs; ++s) V *= 10.f;
    const size_t n = (size_t)T * DM;
    for (size_t i = (size_t)blockIdx.x * 256 + threadIdx.x; i < n; i += (size_t)gridDim.x * 256) a.out[i] = (i == 0) ? V : 0.f;
}
static void dbg_before(int ph, const Args& a, hipStream_t st) { if (ph == 10) hipLaunchKernelGGL(dbg_chk, dim3(64), dim3(256), 0, st, a, 15, 0); }
static void dbg_after(int ph, const Args& a, hipStream_t st) {
#define CHK(w, p) hipLaunchKernelGGL(dbg_chk, dim3(64), dim3(256), 0, st, a, w, p)
    switch (ph) {
        case 0: CHK(1, 0); break; case 1: CHK(2, 0); break; case 2: break; case 3: break; case 4: break;
        case 5: CHK(6, 0); CHK(7, 0); break; case 6: CHK(8, 0); break; case 7: CHK(9, 0); CHK(10, 0); break;
        case 8: CHK(11, 0); break; case 9: CHK(12, 0); break;
        case 10: CHK(16, 0); hipLaunchKernelGGL(dbg_report, dim3(2048), dim3(256), 0, st, a); break;
    }
#undef CHK
}
#endif


extern "C" void kernel_launch(void* const* d_in, const int* in_sizes, int n_in, void* d_out, int out_size, void* d_ws, size_t ws_size, hipStream_t stream) {
    static int grid = 0;
    if (grid == 0) {
        if (n_in != 21 || in_sizes[0] != T * DM || out_size != T * DM || ws_size < WS_END) { fprintf(stderr, "kernel_launch: unexpected shapes (n_in %d, in0 %d, out %d, ws %zu); nothing launched\n", n_in, n_in > 0 ? in_sizes[0] : -1, out_size, ws_size); grid = -1; return; }
        int dev = 0, cus = 0, per_cu = 0;
        if (hipGetDevice(&dev) != hipSuccess || hipDeviceGetAttribute(&cus, hipDeviceAttributeMultiprocessorCount, dev) != hipSuccess) { grid = -1; return; }
        if (hipFuncSetAttribute((const void*)fwd, hipFuncAttributeMaxDynamicSharedMemorySize, LDS_BYTES) != hipSuccess) { fprintf(stderr, "kernel_launch: hipFuncSetAttribute failed\n"); grid = -1; return; }
        if (hipOccupancyMaxActiveBlocksPerMultiprocessor(&per_cu, (const void*)fwd, 512, LDS_BYTES) != hipSuccess || per_cu < 1) fprintf(stderr, "kernel_launch: occupancy query reports %d\n", per_cu);
        (void)hipGetLastError();
        grid = cus;
    }
    if (grid < 0) return;
    if (hipMemsetAsync((char*)d_ws + WS_CTL, 0, CTL_ZERO_BYTES, stream) != hipSuccess) return;
    Args a{};
    for (int i = 0; i < 21; ++i) a.in[i] = (const float*)d_in[i];
    a.out = (float*)d_out; a.ws = (unsigned char*)d_ws;
#if MK_ONE_LAUNCH
    a.ph_lo = 0; a.ph_hi = 11;
    hipLaunchKernelGGL(fwd, dim3(grid), dim3(512), LDS_BYTES, stream, a);
#else
    for (int ph = 0; ph < 11; ++ph) {
        a.ph_lo = ph; a.ph_hi = ph + 1;
#if MK_DEBUG
        dbg_before(ph, a, stream);
#endif
        hipLaunchKernelGGL(fwd, dim3(grid), dim3(512), LDS_BYTES, stream, a);
#if MK_DEBUG
        dbg_after(ph, a, stream);
#endif
    }
#endif
}
```

```cpp
#include <hip/hip_runtime.h>
#include <cstdio>
#include <cstdint>

#ifndef MK_DEBUG
#define MK_DEBUG 0
#endif
#ifndef MK_ONE_LAUNCH
#define MK_ONE_LAUNCH 1
#endif

#ifndef PROBE_A
#define PROBE_A -1
#define PROBE_B -1
#ifndef BENCH_ABL
#define BENCH_ABL -1
#endif
#ifndef BENCH_GEMM
#define BENCH_GEMM 0
#endif
#define PROBE_TID 0
#define PROBE_X 0
#endif
#define GAS __attribute__((address_space(1)))
#define LAS __attribute__((address_space(3)))
typedef unsigned short bf16;
typedef short bf16x8 __attribute__((ext_vector_type(8)));
typedef short s16x4 __attribute__((ext_vector_type(4)));
typedef float f32x4 __attribute__((ext_vector_type(4)));
typedef float f32x2 __attribute__((ext_vector_type(2)));
typedef float f32x16 __attribute__((ext_vector_type(16)));
typedef unsigned u32x4 __attribute__((ext_vector_type(4)));
typedef unsigned u32x2 __attribute__((ext_vector_type(2)));
typedef __bf16 bf16x2_t __attribute__((ext_vector_type(2)));

constexpr int NB = 8, SEQ = 8192, DM = 1024, T = NB * SEQ;
constexpr int NIN = 2048, IN_W = 1952, ZP = 2176;
constexpr int C_CKV = 256, C_KR = 384, C_QC = 416, C_KC = 928, C_VC = 1440;
constexpr int NE = 32;
constexpr int KQKV = 384, NQKV = 1792;
constexpr float EPS = 1e-6f;
constexpr float LOG2E = 1.4426950408889634f;
constexpr float C2M = 0.10206207261596577f * 1.4426950408889634f;
constexpr float C2C = 0.125f * 1.4426950408889634f;
constexpr int MODW = 6 * DM;
constexpr int OPI = 1088;

constexpr size_t MiB = 1u << 20;
constexpr size_t WS_CTL = 0, CTL_ZERO_BYTES = 1 * MiB;
constexpr size_t WS_MOD = 1 * MiB;
constexpr size_t WS_WRT = 1 * MiB + 256 * 1024;
constexpr size_t WS_WRH = 1 * MiB + 384 * 1024, WS_WRL = 1 * MiB + 448 * 1024;
constexpr size_t WS_GATE = 2 * MiB;
constexpr size_t WS_ROPE = 3 * MiB;
constexpr size_t WS_WQKV = 4 * MiB;
constexpr size_t WS_TINFO = 6 * MiB;
constexpr size_t WS_RS = 7 * MiB;
constexpr size_t WS_LIST = 8 * MiB;
constexpr size_t WS_WIN = 24 * MiB;
constexpr size_t WS_WO = 28 * MiB;
constexpr size_t WS_DBG = 31 * MiB;
constexpr size_t WS_WDN = 32 * MiB;
constexpr size_t WS_WGU = 64 * MiB;
constexpr size_t WS_H = 128 * MiB;
constexpr size_t WS_H8 = 784 * MiB;
constexpr size_t WS_ACT = 256 * MiB;
constexpr size_t WS_Z = 256 * MiB;
constexpr size_t WS_OP = 128 * MiB;
constexpr size_t WS_H8A = 528 * MiB;
constexpr size_t WS_WIN8 = 592 * MiB;
constexpr size_t WS_QM = 528 * MiB;
constexpr size_t WS_KM = 624 * MiB;
constexpr size_t WS_VM = 720 * MiB;
constexpr size_t WS_O = 784 * MiB;
constexpr size_t WS_AQ = 784 * MiB;
constexpr size_t WS_Y = 520 * MiB;
constexpr size_t WS_END = 1024 * MiB;
constexpr float W8S = 32.f, A8S = 4.f, Y8S = 16.f;
constexpr int LIST_CAP = 65536;

constexpr int CW_TMO = 0, CW_CODE = 1;
constexpr int CW_BAR = 4096;
constexpr int CW_CNT = 8192;
constexpr int CW_DIAG = 8320;

constexpr int LDS_BYTES = 155648;
constexpr int MISC_OFF = LDS_BYTES - 256;
constexpr int TAB_OFF = 139264;

__device__ __forceinline__ unsigned f2bf(float f) { unsigned u = __builtin_bit_cast(unsigned, f); return (u + 0x7fffu + ((u >> 16) & 1u)) >> 16; }
__device__ __forceinline__ float bf2f(unsigned b) { return __builtin_bit_cast(float, (b & 0xffffu) << 16); }
__device__ __forceinline__ unsigned pk2(float lo, float hi) { f32x2 v = {lo, hi}; bf16x2_t b = __builtin_convertvector(v, bf16x2_t); return __builtin_bit_cast(unsigned, b); }
__device__ __forceinline__ float wave_sum(float v) {
#pragma unroll
    for (int o = 1; o < 64; o <<= 1) v += __shfl_xor(v, o);
    return v;
}
__device__ __forceinline__ unsigned pk4_fp8(float a, float b, float c, float d) { unsigned w = 0; w = __builtin_amdgcn_cvt_pk_fp8_f32(a, b, w, false); w = __builtin_amdgcn_cvt_pk_fp8_f32(c, d, w, true); return w; }
#define LDS_WAIT() asm volatile("s_waitcnt lgkmcnt(0)" ::: "memory")
#define VM_WAIT() asm volatile("s_waitcnt vmcnt(0)" ::: "memory")

namespace pg8 {
typedef unsigned short bf16_t;
constexpr int BM = 256, BK = 64, HALF = 128, HTB = HALF * BK * 2, STAGE_BYTES = 8 * HTB;
__host__ __device__ __forceinline__ int lds_byte(int r, int c) { const int st = (r >> 4) * 2 + (c >> 5), rr = r & 15, cc = c & 31, ob = rr * 64 + cc * 2; return st * 1024 + (ob ^ (((ob >> 9) & 1) << 5)); }
__host__ __device__ __forceinline__ void stage_rc(int b, int& R, int& C) { const int st = b / 1024, sb = b % 1024, swz = sb ^ (((sb >> 9) & 1) << 5); R = (st >> 1) * 16 + swz / 64; C = (st & 1) * 32 + (swz % 64) / 2; }
__host__ __device__ __forceinline__ int perm32(int rho) { const int n = rho >> 4, i = rho & 15; return 8 * (i >> 2) + 4 * n + (i & 3); }

struct Unit { int pm, pn, brow, e, nvalid, orow; };
struct Gemm { const void* A; const void* Bt; int KB; int BP; };
typedef int v8i __attribute__((ext_vector_type(8)));
typedef int v4i __attribute__((ext_vector_type(4)));

__device__ __forceinline__ void glds_s(unsigned voff, const void* sbase, unsigned lds_dst) { unsigned keep;
    asm volatile("s_mov_b32 %0, m0\n\ts_mov_b32 m0, %3\n\ts_nop 0\n\tglobal_load_lds_dwordx4 %1, %2\n\ts_mov_b32 m0, %0" : "=&s"(keep) : "v"(voff), "s"(sbase), "s"(lds_dst) : "memory"); }
template <class Epi, class Sched, bool ALIGN_EPI, bool FP8>
__device__ __forceinline__ void gemm_phase(LAS unsigned char* lds, const Gemm g, const Sched& S, const Epi& E) {
    const int tid = threadIdx.x, wid = __builtin_amdgcn_readfirstlane(tid >> 6), lane = tid & 63, wr = wid >> 2, wc = wid & 3, fr = lane & 15, fq = lane >> 4;
    const int KB = g.KB, BP = g.BP, nt = KB / 128;
    unsigned voffB[2];
#pragma unroll
    for (int i = 0; i < 2; ++i) { int R, C; stage_rc(tid * 16 + i * 8192, R, C); const int rho = R & 31;
        const int Rb = Epi::BMAP == 1 ? 64 * (R >> 5) + 16 * ((rho >> 2) & 3) + 4 * (rho >> 4) + (rho & 3) : Epi::BMAP == 2 ? 64 * (R >> 5) + perm32(rho) : (R & ~31) + perm32(rho);
        voffB[i] = (unsigned)(Rb * BP + C * 2); }
    const size_t kstep = (size_t)(BK * 2);
    const size_t hstep = (size_t)(Epi::BMAP == 1 ? 8 : Epi::BMAP == 2 ? 32 : HALF) * BP;
    const unsigned ldsw = (unsigned)wid * 1024u, ldsb = (unsigned)(uintptr_t)lds;
    const int aoff = lds_byte(wr * 64 + fr, fq * 8), boff = lds_byte(wc * 32 + fr, fq * 8);
#define PG8_SA(b, h) (((b) * 2 + (h)) * HTB)
#define PG8_SB(b, h) ((4 + (b) * 2 + (h)) * HTB)
#define PG8_STAGE(bufoff, gbase, voff) do { _Pragma("unroll") for (int _i = 0; _i < 2; ++_i) \
        glds_s((voff)[_i], (const void*)(gbase), (unsigned)__builtin_amdgcn_readfirstlane(ldsb + (unsigned)(bufoff) + ldsw + _i * 8192)); } while (0)
#define PG8_LDA(dst, b, h) do { _Pragma("unroll") for (int m = 0; m < 4; ++m) { \
        const v4i l0_ = *(const LAS v4i*)(lds + PG8_SA(b, h) + aoff + m * 2048), l1_ = *(const LAS v4i*)(lds + PG8_SA(b, h) + aoff + m * 2048 + 1024); \
        dst[m] = __builtin_shufflevector(l0_, l1_, 0, 1, 2, 3, 4, 5, 6, 7); } } while (0)
#define PG8_LDB(dst, b, h) do { _Pragma("unroll") for (int n = 0; n < 2; ++n) { \
        const v4i l0_ = *(const LAS v4i*)(lds + PG8_SB(b, h) + boff + n * 2048), l1_ = *(const LAS v4i*)(lds + PG8_SB(b, h) + boff + n * 2048 + 1024); \
        dst[n] = __builtin_shufflevector(l0_, l1_, 0, 1, 2, 3, 4, 5, 6, 7); } } while (0)
#define PG8_MMA(ai, bj, At, Bt) do { __builtin_amdgcn_s_setprio(1); _Pragma("unroll") for (int m = 0; m < 4; ++m) _Pragma("unroll") for (int n = 0; n < 2; ++n) { \
        if constexpr (FP8) acc[ai][bj][m][n] = __builtin_amdgcn_mfma_scale_f32_16x16x128_f8f6f4(Bt[n], At[m], acc[ai][bj][m][n], 0, 0, 0, 0, 0, 0); \
        else { acc[ai][bj][m][n] = __builtin_amdgcn_mfma_f32_16x16x32_bf16(__builtin_bit_cast(bf16x8, __builtin_shufflevector(Bt[n], Bt[n], 0, 1, 2, 3)), __builtin_bit_cast(bf16x8, __builtin_shufflevector(At[m], At[m], 0, 1, 2, 3)), acc[ai][bj][m][n], 0, 0, 0); \
               acc[ai][bj][m][n] = __builtin_amdgcn_mfma_f32_16x16x32_bf16(__builtin_bit_cast(bf16x8, __builtin_shufflevector(Bt[n], Bt[n], 4, 5, 6, 7)), __builtin_bit_cast(bf16x8, __builtin_shufflevector(At[m], At[m], 4, 5, 6, 7)), acc[ai][bj][m][n], 0, 0, 0); } } \
        __builtin_amdgcn_s_setprio(0); } while (0)
#define PG8_WAIT_V(n) asm volatile("s_waitcnt vmcnt(" #n ")" ::: "memory")
#define PG8_WAIT_VR(r) do { asm volatile("s_waitcnt vmcnt(%0)" :: "n"(8 + Epi::NST) : "memory"); if (!(r)) PG8_WAIT_V(8); } while (0)
#define PG8_WAIT_L(n) asm volatile("s_waitcnt lgkmcnt(" #n ")" ::: "memory")
#define PG8_BAR __builtin_amdgcn_s_barrier()
#define PG8_SCHED __builtin_amdgcn_sched_barrier(0)
#define PG8_OFFS(dst, u) do { int tid_ = tid; asm volatile("" : "+v"(tid_)); _Pragma("unroll") for (int _i = 0; _i < 2; ++_i) { int R_, C_; stage_rc(tid_ * 16 + _i * 8192, R_, C_); \
        _Pragma("unroll") for (int _h = 0; _h < 2; ++_h) dst[_h][_i] = S.arow_off(u, _h * HALF + R_) + (unsigned)C_ * 2u; } } while (0)
    Unit cur, nxt; int ui = 0;
    if (!S.next(0, cur)) return;
    bool has_next = S.next(1, nxt);
    unsigned cvo[2][2], nvo[2][2];
    PG8_OFFS(cvo, cur);
    if (has_next) PG8_OFFS(nvo, nxt); else { nvo[0][0] = cvo[0][0]; nvo[0][1] = cvo[0][1]; nvo[1][0] = cvo[1][0]; nvo[1][1] = cvo[1][1]; }
    f32x4 acc[2][2][4][2];
#pragma unroll
    for (int a = 0; a < 2; ++a)
#pragma unroll
        for (int b = 0; b < 2; ++b)
#pragma unroll
            for (int m = 0; m < 4; ++m)
#pragma unroll
                for (int n = 0; n < 2; ++n) acc[a][b][m][n] = (f32x4){0.f, 0.f, 0.f, 0.f};
    v8i At[4], B0[2], B1[2];
    const char* const Ab = (const char*)g.A;
    const char* cB = (const char*)g.Bt + (size_t)cur.brow * BP;
    VM_WAIT();
    PG8_STAGE(PG8_SB(0, 0), cB, voffB); PG8_STAGE(PG8_SB(0, 1), cB + hstep, voffB); PG8_STAGE(PG8_SA(0, 0), Ab, cvo[0]); PG8_STAGE(PG8_SA(0, 1), Ab, cvo[1]);
    if (wr == 1) PG8_BAR;
    PG8_WAIT_V(2); PG8_BAR;
    PG8_STAGE(PG8_SB(1, 0), cB + kstep, voffB); PG8_STAGE(PG8_SA(1, 0), Ab + kstep, cvo[0]); PG8_STAGE(PG8_SB(1, 1), cB + hstep + kstep, voffB);
    PG8_WAIT_V(6); PG8_BAR;
    Unit nn; bool has_nn = false; unsigned raw[2][2] = {{0u, 0u}, {0u, 0u}};
    const bool pref = Sched::PREF && S.gathers();
    for (;;) {
        const char* nB = has_next ? (const char*)g.Bt + (size_t)nxt.brow * BP : cB;
        if (Sched::PREF) { if (pref) { has_nn = has_next && S.next(ui + 2, nn);
            if (has_nn) { int tid_ = tid; asm volatile("" : "+v"(tid_));
#pragma unroll
                for (int _i = 0; _i < 2; ++_i) { int R_, C_; stage_rc(tid_ * 16 + _i * 8192, R_, C_);
#pragma unroll
                    for (int _h = 0; _h < 2; ++_h) { const unsigned* ap_ = S.raw_addr(nn, _h * HALF + R_); asm volatile("global_load_dword %0, %1, off" : "=v"(raw[_h][_i]) : "v"(ap_) : "memory"); } } } } }
#pragma unroll 1
        for (int t = 0; t < nt; t += 2) {
            const bool last = (t == nt - 2);
            const bool rlx = (t == 0) && (ui > 0);
            const char* a1 = Ab + (size_t)(t + 1) * kstep;
            const char* a2 = last ? Ab : Ab + (size_t)(t + 2) * kstep; const char* b2 = last ? nB : cB + (size_t)(t + 2) * kstep;
            const char* a3 = a2 + kstep; const char* b3 = b2 + kstep;
            unsigned vo2[2][2];
#pragma unroll
            for (int _h = 0; _h < 2; ++_h)
#pragma unroll
                for (int _i = 0; _i < 2; ++_i) vo2[_h][_i] = last ? nvo[_h][_i] : cvo[_h][_i];
            PG8_LDB(B0, 0, 0); PG8_LDB(B1, 0, 1); PG8_SCHED; PG8_LDA(At, 0, 0); PG8_STAGE(PG8_SA(1, 1), a1, cvo[1]);
            PG8_WAIT_VR(rlx); PG8_WAIT_L(0); PG8_BAR; PG8_MMA(0, 0, At, B0); PG8_MMA(0, 1, At, B1); PG8_BAR; PG8_SCHED;
            PG8_LDA(At, 0, 1); PG8_STAGE(PG8_SB(0, 0), b2, voffB); PG8_STAGE(PG8_SB(0, 1), b2 + hstep, voffB); PG8_STAGE(PG8_SA(0, 0), a2, vo2[0]);
            PG8_WAIT_VR(rlx); PG8_WAIT_L(0); PG8_BAR; PG8_MMA(1, 0, At, B0); PG8_MMA(1, 1, At, B1); PG8_BAR; PG8_SCHED;
            PG8_LDB(B0, 1, 0); PG8_LDB(B1, 1, 1); PG8_SCHED; PG8_LDA(At, 1, 0); PG8_STAGE(PG8_SA(0, 1), a2, vo2[1]);
            PG8_WAIT_V(8); PG8_WAIT_L(0); PG8_BAR; PG8_MMA(0, 0, At, B0); PG8_MMA(0, 1, At, B1); PG8_BAR; PG8_SCHED;
            PG8_LDA(At, 1, 1); PG8_STAGE(PG8_SB(1, 0), b3, voffB); PG8_STAGE(PG8_SB(1, 1), b3 + hstep, voffB); PG8_STAGE(PG8_SA(1, 0), a3, vo2[0]);
            PG8_WAIT_V(8); PG8_WAIT_L(0); PG8_BAR; PG8_MMA(1, 0, At, B0); PG8_MMA(1, 1, At, B1); PG8_BAR; PG8_SCHED;
        }
        if constexpr (ALIGN_EPI) { if (wr == 0) PG8_BAR; }
        { int fr_ = fr, fq_ = fq; asm volatile("" : "+v"(fr_), "+v"(fq_));
#if PROBE_A >= 0
          unsigned long long te0_ = __builtin_amdgcn_s_memrealtime();
#endif
          E(acc, cur, wr, wc, fr_, fq_);
#if PROBE_A >= 0
          asm volatile("s_waitcnt vmcnt(0)" ::: "memory");
          if (blockIdx.x == 0 && tid == 0) { LAS unsigned long long* st_ = (LAS unsigned long long*)(lds + 147456 - 256 + 64); st_[14] += __builtin_amdgcn_s_memrealtime() - te0_; }
#endif
        }
        if (!has_next) break;
#pragma unroll
        for (int a = 0; a < 2; ++a)
#pragma unroll
            for (int b = 0; b < 2; ++b)
#pragma unroll
                for (int m = 0; m < 4; ++m)
#pragma unroll
                    for (int n = 0; n < 2; ++n) acc[a][b][m][n] = (f32x4){0.f, 0.f, 0.f, 0.f};
        cur = nxt; cB = nB; ++ui;
#pragma unroll
        for (int _h = 0; _h < 2; ++_h)
#pragma unroll
            for (int _i = 0; _i < 2; ++_i) cvo[_h][_i] = nvo[_h][_i];
        if (Sched::PREF && pref) { has_next = has_nn; if (has_nn) { nxt = nn;
                asm volatile("" : "+v"(raw[0][0]), "+v"(raw[0][1]), "+v"(raw[1][0]), "+v"(raw[1][1]));
                int tid_ = tid; asm volatile("" : "+v"(tid_));
#pragma unroll
                for (int _i = 0; _i < 2; ++_i) { int R_, C_; stage_rc(tid_ * 16 + _i * 8192, R_, C_);
#pragma unroll
                    for (int _h = 0; _h < 2; ++_h) nvo[_h][_i] = S.conv(raw[_h][_i]) + (unsigned)C_ * 2u; } } }
        else { has_next = S.next(ui + 1, nxt);
            if (has_next) PG8_OFFS(nvo, nxt); }
        if constexpr (ALIGN_EPI) { if (wr == 1) PG8_BAR; }
    }
    PG8_WAIT_V(0);
    if constexpr (!ALIGN_EPI) { if (wr == 0) PG8_BAR; }
    PG8_BAR;
#undef PG8_SA
#undef PG8_SB
#undef PG8_STAGE
#undef PG8_LDA
#undef PG8_LDB
#undef PG8_MMA
#undef PG8_WAIT_V
#undef PG8_WAIT_L
#undef PG8_WAIT_VR
#undef PG8_BAR
#undef PG8_SCHED
#undef PG8_OFFS
}

struct DenseSched {
    static constexpr bool PREF = false;
    __device__ __forceinline__ bool gathers() const { return false; }
    __device__ __forceinline__ const unsigned* raw_addr(const Unit&, int) const { return nullptr; }
    __device__ __forceinline__ unsigned conv(unsigned) const { return 0u; }
    int nN, nwg, G, c, K2;
    __device__ __forceinline__ bool next(int i, Unit& u) const {
        const int L = i * G + c; if (L >= nwg) return false;
        const int nig = 8 * nN, gid = L / nig, r = L % nig;
        u.pm = gid * 8 + (r & 7); u.pn = r >> 3; u.brow = u.pn * BM; u.e = 0; u.nvalid = BM; u.orow = u.pm * BM; return true;
    }
    __device__ __forceinline__ unsigned arow_off(const Unit& u, int r) const { return (unsigned)(u.pm * BM + r) * (unsigned)K2; }
};
struct MoeSched {
    static constexpr bool PREF = true;
    const LAS int* tstart;
    const LAS int* cnt;
    const unsigned* list;
    int NT, G, c, nexp_rows;
    const LAS int* ut; int nun;
    __device__ __forceinline__ bool next(int i, Unit& u) const {
        if (i >= nun) return false;
        const v4i a = *(const LAS v4i*)(ut + i * 8); const int o4 = ut[i * 8 + 4], o5 = ut[i * 8 + 5];
        u.e = __builtin_amdgcn_readfirstlane(a.x); u.pm = __builtin_amdgcn_readfirstlane(a.y); u.pn = __builtin_amdgcn_readfirstlane(a.z); u.nvalid = __builtin_amdgcn_readfirstlane(a.w);
        u.orow = __builtin_amdgcn_readfirstlane(o4); u.brow = __builtin_amdgcn_readfirstlane(o5); return true;
    }
    __device__ __forceinline__ bool gathers() const { return list != nullptr; }
    __device__ __forceinline__ const unsigned* raw_addr(const Unit& u, int r) const { int idx = u.pm * BM + r; const int c1 = u.nvalid + u.pm * BM - 1; idx = idx < c1 ? idx : c1; return list + (size_t)u.e * LIST_CAP + idx; }
    __device__ __forceinline__ unsigned conv(unsigned ent) const { return (ent >> 2) * 1024u; }
    __device__ __forceinline__ unsigned arow_off(const Unit& u, int r) const {
        if (list) { int idx = u.pm * BM + r; const int c1 = u.nvalid + u.pm * BM - 1; idx = idx < c1 ? idx : c1; const unsigned ent = list[(size_t)u.e * LIST_CAP + idx]; return (ent >> 2) * 1024u; }
        return (unsigned)(u.orow + r) * 1024u;
    }
};

struct EpiPlain {
    static constexpr int BMAP = 2;
    static constexpr int NST = 16;
    bf16_t* O; int ldc;
    __device__ __forceinline__ void operator()(const f32x4 (&acc)[2][2][4][2], const Unit& u, int wr, int wc, int fr, int fq) const {
        const int row0 = u.orow + wr * 64 + fr, col0 = u.pn * BM + wc * 64 + 8 * fq;
#pragma unroll
        for (int ai = 0; ai < 2; ++ai)
#pragma unroll
            for (int m = 0; m < 4; ++m) { bf16_t* rowp = O + (size_t)(row0 + ai * HALF + m * 16) * ldc + col0;
#pragma unroll
                for (int bj = 0; bj < 2; ++bj) { const f32x4 v0 = acc[ai][bj][m][0], v1 = acc[ai][bj][m][1];
                    u32x4 w; w.x = pk2(v0[0], v0[1]); w.y = pk2(v0[2], v0[3]); w.z = pk2(v1[0], v1[1]); w.w = pk2(v1[2], v1[3]);
                    *(u32x4*)(rowp + bj * 32) = w; } }
    }
};
struct EpiPlainS {
    static constexpr int BMAP = 2;
    static constexpr int NST = 16;
    bf16_t* O; int ldc; float sc;
    __device__ __forceinline__ void operator()(const f32x4 (&acc)[2][2][4][2], const Unit& u, int wr, int wc, int fr, int fq) const {
        const int row0 = u.orow + wr * 64 + fr, col0 = u.pn * BM + wc * 64 + 8 * fq;
#pragma unroll
        for (int ai = 0; ai < 2; ++ai)
#pragma unroll
            for (int m = 0; m < 4; ++m) { bf16_t* rowp = O + (size_t)(row0 + ai * HALF + m * 16) * ldc + col0;
#pragma unroll
                for (int bj = 0; bj < 2; ++bj) { const f32x4 v0 = acc[ai][bj][m][0] * sc, v1 = acc[ai][bj][m][1] * sc;
                    u32x4 w; w.x = pk2(v0[0], v0[1]); w.y = pk2(v0[2], v0[3]); w.z = pk2(v1[0], v1[1]); w.w = pk2(v1[2], v1[3]);
                    *(u32x4*)(rowp + bj * 32) = w; } }
    }
};
struct EpiZ {
    static constexpr int BMAP = 0;
    static constexpr int NST = 16;
    bf16_t* O; int ldc; float* rs; unsigned char* Km; const f32x2* rope; LAS float* xch; bf16_t* AQ;
    __device__ __forceinline__ void operator()(const f32x4 (&acc)[2][2][4][2], const Unit& u, int wr, int wc, int fr, int fq) const {
        const int row0 = u.orow + wr * 64 + fr, col0 = u.pn * BM + wc * 32 + 8 * fq;
#pragma unroll
        for (int ai = 0; ai < 2; ++ai)
#pragma unroll
            for (int m = 0; m < 4; ++m) { const size_t row = (size_t)(row0 + ai * HALF + m * 16); bf16_t* rowp = O + row * ldc + col0; bf16_t* aqp = AQ + row * 384 + col0;
#pragma unroll
                for (int bj = 0; bj < 2; ++bj) { const f32x4 v0 = acc[ai][bj][m][0], v1 = acc[ai][bj][m][1];
                    u32x4 w; w.x = pk2(v0[0], v0[1]); w.y = pk2(v0[2], v0[3]); w.z = pk2(v1[0], v1[1]); w.w = pk2(v1[2], v1[3]);
                    if (u.pn == 0 || (u.pn == 1 && bj == 0)) *(u32x4*)(aqp + bj * HALF) = w;
                    else *(u32x4*)(rowp + bj * HALF) = w; } }
        if (u.pn <= 1) {
            const int nb = u.pn == 0 ? 2 : 1;
#pragma unroll
            for (int ai = 0; ai < 2; ++ai)
#pragma unroll
                for (int m = 0; m < 4; ++m) { float ss = 0.f;
#pragma unroll
                    for (int bj = 0; bj < 2; ++bj) if (bj < nb) {
#pragma unroll
                        for (int n = 0; n < 2; ++n) { const f32x4 v = acc[ai][bj][m][n]; ss += (v[0] * v[0] + v[1] * v[1]) + (v[2] * v[2] + v[3] * v[3]); } }
                    ss += __shfl_xor(ss, 16); ss += __shfl_xor(ss, 32);
                    if (fq == 0) xch[wc * 256 + ai * HALF + wr * 64 + m * 16 + fr] = ss; }
            if (u.pn == 1 && wc == 0) {
#pragma unroll
                for (int ai = 0; ai < 2; ++ai)
#pragma unroll
                    for (int m = 0; m < 4; ++m) { const int row = u.orow + ai * HALF + wr * 64 + m * 16 + fr, b = row >> 13, pos = row & (SEQ - 1);
                        const f32x4 x1 = acc[ai][1][m][0], x2 = acc[ai][1][m][1]; const f32x2* rp = rope + pos * 16 + 4 * fq;
                        const f32x2 t0 = rp[0], t1 = rp[1], t2 = rp[2], t3 = rp[3]; const f32x4 cs = {t0.x, t1.x, t2.x, t3.x}, sn = {t0.y, t1.y, t2.y, t3.y};
                        const f32x4 o0 = x1 * cs - x2 * sn, o1 = x2 * cs + x1 * sn;
                        const u32x4 w = {pk2(o0[0], o0[1]), pk2(o0[2], o0[3]), pk2(o1[0], o1[1]), pk2(o1[2], o1[3])};
                        unsigned char* kp = Km + ((size_t)(b * 8) * 128 + (pos >> 6)) * 12288 + (8 + fq) * 1024 + (pos & 63) * 16;
#pragma unroll
                        for (int hh = 0; hh < 8; ++hh) *(u32x4*)(kp + (size_t)hh * 128 * 12288) = w; } }
            asm volatile("s_waitcnt lgkmcnt(0)\n\ts_barrier" ::: "memory");
            const int tid_ = (wr * 4 + wc) * 64 + fq * 16 + fr;
            if (tid_ < 256) { const float sq = (xch[tid_] + xch[256 + tid_]) + (xch[512 + tid_] + xch[768 + tid_]);
                rs[(size_t)u.pn * T + u.orow + tid_] = 1.f / sqrtf(sq * (u.pn == 0 ? 1.f / 256.f : 1.f / 128.f) + EPS); }
        }
    }
};
struct EpiQKV {
    static constexpr int BMAP = 0;
    static constexpr int NST = 16;
    bf16_t* Qm; unsigned char* Km; unsigned char* Vm; const f32x2* rope; int coff; const float* rs;
    __device__ __forceinline__ void operator()(const f32x4 (&acc)[2][2][4][2], const Unit& u, int wr, int wc, int fr, int fq) const {
        float rr8[2][4];
#pragma unroll
        for (int ai = 0; ai < 2; ++ai)
#pragma unroll
            for (int m = 0; m < 4; ++m) rr8[ai][m] = rs[u.orow + ai * HALF + wr * 64 + m * 16 + fr];
#pragma unroll
        for (int bj = 0; bj < 2; ++bj) {
            const int cb = coff + u.pn * BM + bj * HALF + wc * 32;
            const int c0 = cb + 8 * fq;
#pragma unroll
            for (int ai = 0; ai < 2; ++ai)
#pragma unroll
                for (int m = 0; m < 4; ++m) {
                    int row = u.orow + ai * HALF + wr * 64 + m * 16 + fr;
                    asm volatile("" : "+v"(row) :: "memory");
                    const int b = row >> 13, s = row & (SEQ - 1);
                    const float rr = rr8[ai][m];
                    f32x4 v0 = acc[ai][bj][m][0] * rr, v1 = acc[ai][bj][m][1] * rr;
                    if (cb < 768) {
                        const int h = cb / 96, d = c0 - h * 96;
                        v0 = v0 * C2M; v1 = v1 * C2M;
                        u32x4 w; w.x = pk2(v0[0], v0[1]); w.y = pk2(v0[2], v0[3]); w.z = pk2(v1[0], v1[1]); w.w = pk2(v1[2], v1[3]);
                        *(u32x4*)(Qm + ((size_t)(b * 8 + h) * SEQ + s) * 96 + d) = w;
                    } else {
                        const int cc = c0 - 768, h = cc >> 7, dd = cc & 127;
                        u32x4 w; w.x = pk2(v0[0], v0[1]); w.y = pk2(v0[2], v0[3]); w.z = pk2(v1[0], v1[1]); w.w = pk2(v1[2], v1[3]);
                        const size_t tile = (size_t)(b * 8 + h) * 128 + (s >> 6);
                        if (dd < 64) *(u32x4*)(Km + tile * 12288 + (dd >> 3) * 1024 + (s & 63) * 16) = w;
                        else { const int d = dd - 64; *(u32x4*)(Vm + tile * 8192 + (d >> 5) * 4096 + ((s & 63) >> 4) * 1024 + (s & 15) * 64 + (d & 31) * 2) = w; }
                    }
                }
        }
    }
};
struct EpiGU {
    static constexpr int BMAP = 0;
    static constexpr int NST = 8;
    unsigned char* act; const float* bgu;
    __device__ __forceinline__ void operator()(const f32x4 (&acc)[2][2][4][2], const Unit& u, int wr, int wc, int fr, int fq) const {
        const int cl = u.pn * 128 + wc * 32 + 8 * fq;
        const float* bg = bgu + (size_t)u.e * 2048 + cl; const float* bu = bg + 1024;
        const f32x4 bg0 = *(const f32x4*)bg, bg1 = *(const f32x4*)(bg + 4), bu0 = *(const f32x4*)bu + 1.f, bu1 = *(const f32x4*)(bu + 4) + 1.f;
        constexpr float USC = 1.f / (W8S * A8S);
#pragma unroll
        for (int ai = 0; ai < 2; ++ai)
#pragma unroll
            for (int m = 0; m < 4; ++m) {
                const int row = u.orow + ai * HALF + wr * 64 + m * 16 + fr;
                f32x4 r4[2];
#pragma unroll
                for (int n = 0; n < 2; ++n) {
                    f32x4 gt = acc[ai][0][m][n] * USC + (n ? bg1 : bg0), up = acc[ai][1][m][n] * USC + (n ? bu1 : bu0);
#pragma unroll
                    for (int j = 0; j < 4; ++j) { gt[j] = fminf(gt[j], 7.f); up[j] = fminf(fmaxf(up[j], -6.f), 8.f); }
                    const f32x4 ea = gt * (-1.702f * LOG2E); f32x4 e;
#pragma unroll
                    for (int j = 0; j < 4; ++j) e[j] = __builtin_amdgcn_exp2f(ea[j]);
                    const f32x4 den = e * (1.f / A8S) + (1.f / A8S); f32x4 sg;
#pragma unroll
                    for (int j = 0; j < 4; ++j) sg[j] = __builtin_amdgcn_rcpf(den[j]);
                    r4[n] = (up * gt) * sg;
                }
                *(u32x2*)(act + (size_t)row * 1024 + cl) = (u32x2){pk4_fp8(r4[0][0], r4[0][1], r4[0][2], r4[0][3]), pk4_fp8(r4[1][0], r4[1][1], r4[1][2], r4[1][3])};
            }
    }
};
struct EpiDN {
    static constexpr int BMAP = 1;
    static constexpr int NST = 8;
    unsigned char* y; const float* bdn;
    __device__ __forceinline__ void operator()(const f32x4 (&acc)[2][2][4][2], const Unit& u, int wr, int wc, int fr, int fq) const {
        const int col0 = u.pn * BM + wc * 64 + 16 * fq;
        const float* bp = bdn + (size_t)u.e * 1024 + col0;
        f32x4 bv[2][2];
#pragma unroll
        for (int bj = 0; bj < 2; ++bj) { bv[bj][0] = *(const f32x4*)(bp + 8 * bj) * Y8S; bv[bj][1] = *(const f32x4*)(bp + 8 * bj + 4) * Y8S; }
#pragma unroll
        for (int ai = 0; ai < 2; ++ai)
#pragma unroll
            for (int m = 0; m < 4; ++m) {
                unsigned char* rowp = y + (size_t)(u.orow + ai * HALF + wr * 64 + m * 16 + fr) * 1024 + col0;
                unsigned w[4];
#pragma unroll
                for (int bj = 0; bj < 2; ++bj) { f32x4 v0 = acc[ai][bj][m][0] * (Y8S / (W8S * A8S)) + bv[bj][0], v1 = acc[ai][bj][m][1] * (Y8S / (W8S * A8S)) + bv[bj][1];
#pragma unroll
                    for (int j = 0; j < 4; ++j) { v0[j] = fminf(fmaxf(v0[j], -448.f), 448.f); v1[j] = fminf(fmaxf(v1[j], -448.f), 448.f); }
                    w[2 * bj] = pk4_fp8(v0[0], v0[1], v0[2], v0[3]); w[2 * bj + 1] = pk4_fp8(v1[0], v1[1], v1[2], v1[3]); }
                *(u32x4*)rowp = (u32x4){w[0], w[1], w[2], w[3]};
            }
    }
};
}

namespace att {
constexpr int NKS = 3, NVS = 4;
constexpr int LK = 0, KSL = 12288, LV = NKS * KSL, VSL = 8192, LWS = LV + NVS * VSL, LBT = LWS + 8 * 256, LEND = LBT + 4 * 648 * 4, LOST = 84992;
static_assert(LEND <= 131072 && 8 * 4096 <= NKS * KSL, "attention LDS map");
constexpr float THR = 8.f;
typedef short v4i16_t __attribute__((ext_vector_type(4)));
__device__ __forceinline__ int crow(int r, int hi) { return (r & 3) + 8 * (r >> 2) + 4 * hi; }
__device__ __forceinline__ void glds16(const void* gsrc, unsigned lds_dst) { unsigned keep;
    asm volatile("s_mov_b32 %0, m0\n\ts_mov_b32 m0, %2\n\ts_nop 0\n\tglobal_load_lds_dwordx4 %1, off\n\ts_mov_b32 m0, %0" : "=&s"(keep) : "v"(gsrc), "s"(lds_dst) : "memory"); }
#define ATT_WAITBAR(N) asm volatile("s_waitcnt vmcnt(" #N ") lgkmcnt(0)\n\ts_barrier" ::: "memory")
__device__ __forceinline__ s16x4 vtr(const LAS char* p) { return __builtin_bit_cast(s16x4, __builtin_amdgcn_ds_read_tr16_b64_v4i16((LAS v4i16_t*)p)); }
__device__ __forceinline__ float max3(float a, float b, float c) { return __builtin_fmaxf(__builtin_fmaxf(a, b), c); }
__device__ __forceinline__ float rowmax(const f32x16& p0, const f32x16& p1) {
    float a = max3(p0[0], p0[1], p1[0]), b = max3(p0[2], p0[3], p1[1]); a = max3(a, p1[2], p1[3]);
#pragma unroll
    for (int r = 4; r < 16; r += 4) { a = max3(a, p0[r], p0[r + 1]); b = max3(b, p0[r + 2], p0[r + 3]); a = max3(a, p1[r], p1[r + 1]); b = max3(b, p1[r + 2], p1[r + 3]); }
    a = __builtin_fmaxf(a, b);
    auto rr = __builtin_amdgcn_permlane32_swap(__float_as_uint(a), __float_as_uint(a), false, false);
    return __builtin_fmaxf(__uint_as_float(rr[0]), __uint_as_float(rr[1]));
}
template <int ND0> __device__ __forceinline__ void qkt(f32x16& p0, f32x16& p1, unsigned kb, const bf16x8* qr, const f32x16& z, const f32x16& z1) {
    bf16x8 kf[2 * ND0];
#pragma unroll
    for (int i = 0; i < 2 * ND0; ++i) asm volatile("ds_read_b128 %0, %1 offset:%c2" : "=v"(kf[i]) : "v"(kb), "i"((i >> 1) * 2048 + (i & 1) * 512));
#pragma unroll
    for (int d0 = 0; d0 < ND0; ++d0) {
        asm volatile("s_waitcnt lgkmcnt(%c2)" : "+v"(kf[2 * d0]), "+v"(kf[2 * d0 + 1]) : "i"((2 * ND0 - 2 * d0 - 4) > 0 ? (2 * ND0 - 2 * d0 - 4) : 0));
        if (d0 == 0) { p0 = __builtin_amdgcn_mfma_f32_32x32x16_bf16(kf[0], qr[0], z, 0, 0, 0); p1 = __builtin_amdgcn_mfma_f32_32x32x16_bf16(kf[1], qr[0], z1, 0, 0, 0); }
        else { p0 = __builtin_amdgcn_mfma_f32_32x32x16_bf16(kf[2 * d0], qr[d0], p0, 0, 0, 0); p1 = __builtin_amdgcn_mfma_f32_32x32x16_bf16(kf[2 * d0 + 1], qr[d0], p1, 0, 0, 0); }
    }
}
__device__ __forceinline__ void exp_half(f32x16& p, float mref, float& sacc, u32x4& wa, u32x4& wb) {
#pragma unroll
    for (int r = 0; r < 16; ++r) { p[r] = __builtin_amdgcn_exp2f(p[r] - mref); sacc += p[r]; }
    wa = (u32x4){pk2(p[0], p[1]), pk2(p[2], p[3]), pk2(p[4], p[5]), pk2(p[6], p[7])};
    wb = (u32x4){pk2(p[8], p[9]), pk2(p[10], p[11]), pk2(p[12], p[13]), pk2(p[14], p[15])};
}
__device__ __forceinline__ void pv8(f32x16& o0, f32x16& o1, unsigned vb, u32x4 w0, u32x4 w1, u32x4 w2, u32x4 w3) {
    s16x4 lo[8], hh[8];
#pragma unroll
    for (int j = 0; j < 8; ++j) { const int i = (j >> 1) + 4 * (j & 1);
        asm volatile("ds_read_b64_tr_b16 %0, %1 offset:%c2" : "=v"(lo[i]) : "v"(vb), "i"((i >> 2) * 4096 + (i & 3) * 1024));
        asm volatile("ds_read_b64_tr_b16 %0, %1 offset:%c2" : "=v"(hh[i]) : "v"(vb), "i"((i >> 2) * 4096 + (i & 3) * 1024 + 512)); }
#define ATT_VF(i) (bf16x8){lo[i][0], lo[i][1], lo[i][2], lo[i][3], hh[i][0], hh[i][1], hh[i][2], hh[i][3]}
#define ATT_PVW(j, i) asm volatile("s_waitcnt lgkmcnt(%c2)" : "+v"(lo[i]), "+v"(hh[i]) : "i"((12 - 2 * (j)) > 0 ? (12 - 2 * (j)) : 0))
    ATT_PVW(0, 0); o0 = __builtin_amdgcn_mfma_f32_32x32x16_bf16(__builtin_bit_cast(bf16x8, w0), ATT_VF(0), o0, 0, 0, 0);
    ATT_PVW(1, 4); o1 = __builtin_amdgcn_mfma_f32_32x32x16_bf16(__builtin_bit_cast(bf16x8, w0), ATT_VF(4), o1, 0, 0, 0);
    ATT_PVW(2, 1); o0 = __builtin_amdgcn_mfma_f32_32x32x16_bf16(__builtin_bit_cast(bf16x8, w1), ATT_VF(1), o0, 0, 0, 0);
    ATT_PVW(3, 5); o1 = __builtin_amdgcn_mfma_f32_32x32x16_bf16(__builtin_bit_cast(bf16x8, w1), ATT_VF(5), o1, 0, 0, 0);
    ATT_PVW(4, 2); o0 = __builtin_amdgcn_mfma_f32_32x32x16_bf16(__builtin_bit_cast(bf16x8, w2), ATT_VF(2), o0, 0, 0, 0);
    ATT_PVW(5, 6); o1 = __builtin_amdgcn_mfma_f32_32x32x16_bf16(__builtin_bit_cast(bf16x8, w2), ATT_VF(6), o1, 0, 0, 0);
    ATT_PVW(6, 3); o0 = __builtin_amdgcn_mfma_f32_32x32x16_bf16(__builtin_bit_cast(bf16x8, w3), ATT_VF(3), o0, 0, 0, 0);
    ATT_PVW(7, 7); o1 = __builtin_amdgcn_mfma_f32_32x32x16_bf16(__builtin_bit_cast(bf16x8, w3), ATT_VF(7), o1, 0, 0, 0);
#undef ATT_VF
#undef ATT_PVW
}
__device__ __forceinline__ bool max_update(const f32x16& p0, const f32x16& p1, bool first, float& mref, float& l, LAS float* wsf, int r32, int hi) {
    const float rm = rowmax(p0, p1);
    if (first) { mref = rm; return false; }
    if (__any(rm > mref + THR)) { const float mn = __builtin_fmaxf(mref, rm); const float f = __builtin_amdgcn_exp2f(mref - mn); l *= f; if (hi == 0) wsf[r32] = f; mref = mn; return true; }
    return false;
}
__device__ __forceinline__ void rescale_o(f32x16& o0, f32x16& o1, const LAS float* wsf, int hi) {
#pragma unroll
    for (int r = 0; r < 16; ++r) { const float f = wsf[crow(r, hi)]; o0[r] *= f; o1[r] *= f; }
}
__device__ __forceinline__ void attn_store(f32x16& o0, f32x16& o1, float l, bf16* Ow, LAS char* shm, int wid, int lane, int r32, int hi) {
    LAS float* wsf = (LAS float*)(shm + LWS) + wid * 64;
    { auto rr = __builtin_amdgcn_permlane32_swap(__float_as_uint(l), __float_as_uint(l), false, false); l = __uint_as_float(rr[0]) + __uint_as_float(rr[1]); }
    if (hi == 0) wsf[32 + r32] = l;
    LDS_WAIT();
    LAS bf16* stg = (LAS bf16*)(shm + LOST) + wid * 2048;
#pragma unroll
    for (int r = 0; r < 16; ++r) { const int orow = crow(r, hi); const float rl = __builtin_amdgcn_rcpf(wsf[32 + orow]);
        stg[orow * 64 + r32] = (bf16)f2bf(o0[r] * rl); stg[orow * 64 + 32 + r32] = (bf16)f2bf(o1[r] * rl); }
    LDS_WAIT();
#pragma unroll
    for (int i = 0; i < 4; ++i) { const int row = i * 8 + (lane >> 3), ch = lane & 7; const u32x4 v = *(const LAS u32x4*)(stg + row * 64 + ch * 8); *(u32x4*)(Ow + (size_t)row * OPI + ch * 8) = v; }
}

constexpr int CONV_OFF = LOST;
static_assert(CONV_OFF >= LEND && CONV_OFF + 65536 <= LDS_BYTES - 256, "conversion buffers");
struct CvSrc { const float* W; int ldw, e, kb, nb; bool gu; };
__device__ __forceinline__ CvSrc cv_src(const float* wgu, const float* wdn, int tl) {
    constexpr int T_GU = 32 * 8 * 32; CvSrc c; c.gu = tl < T_GU; const int r = c.gu ? tl : tl - T_GU; c.kb = r & 31; const int q = r >> 5;
    if (c.gu) { c.nb = q & 7; c.e = q >> 3; c.W = wgu + (size_t)c.e * 1024 * 2048; c.ldw = 2048; } else { c.nb = q & 3; c.e = q >> 2; c.W = wdn + (size_t)c.e * 1024 * 1024; c.ldw = 1024; }
    return c; }
__device__ __forceinline__ void cv_dma(const CvSrc& c, unsigned ldsbuf, int wave, int lane) {
#pragma unroll
    for (int j = 0; j < 4; ++j) { const int k = c.kb * 32 + wave * 4 + j;
        glds16((const unsigned char*)(c.W + (size_t)k * c.ldw + c.nb * 256) + lane * 16, (unsigned)__builtin_amdgcn_readfirstlane(ldsbuf + (wave * 4 + j) * 1024)); } }
__device__ __forceinline__ void cv_cvt(const CvSrc& c, const LAS float* buf, unsigned char* WGU, unsigned char* WDN, int tid) {
    const int i = tid & 255, kh = tid >> 8; const LAS float* sc = buf + (16 * kh) * 256 + i;
    unsigned w[4];
#pragma unroll
    for (int q = 0; q < 4; ++q) w[q] = pk4_fp8(sc[(4 * q) * 256] * W8S, sc[(4 * q + 1) * 256] * W8S, sc[(4 * q + 2) * 256] * W8S, sc[(4 * q + 3) * 256] * W8S);
    size_t drow; unsigned char* WT;
    if (c.gu) { drow = (size_t)c.e * 2048 + (2 * (c.nb & 3) + (i >> 7)) * 256 + (c.nb >> 2) * 128 + (i & 127); WT = WGU; } else { drow = (size_t)c.e * 1024 + c.nb * 256 + i; WT = WDN; }
    *(u32x4*)(WT + drow * 1024 + c.kb * 32 + 16 * kh) = (u32x4){w[0], w[1], w[2], w[3]}; }

template <bool CA> __device__ __forceinline__ void kv_ptrs(int bh, int ub, int lane, int wid, const unsigned char* Km, const unsigned char* Vm, const bf16* Z, const unsigned char*& ksrc, const unsigned char*& vsrc, size_t& kst, size_t& vst) {
    const int b = bh >> 3, h = bh & 7; const size_t rowb = (size_t)b * SEQ;
    if constexpr (CA) { const int c0 = 4 * ub, kc_lo = c0 >= 8 ? c0 - 8 : 0;
        ksrc = (const unsigned char*)(Z + (rowb + kc_lo * 64 + lane) * ZP + C_KC + h * 64 + wid * 8); kst = (size_t)64 * ZP * 2;
        vsrc = (const unsigned char*)(Z + (rowb + kc_lo * 64 + 16 * (wid & 3) + (lane >> 2)) * ZP + C_VC + h * 64 + (wid >> 2) * 32 + (lane & 3) * 8); vst = (size_t)64 * ZP * 2; }
    else { ksrc = Km + (size_t)bh * 128 * 12288 + wid * 1024 + lane * 16; kst = 12288; vsrc = Vm + (size_t)bh * 128 * 8192 + wid * 1024 + lane * 16; vst = 8192; } }
template <bool CA> __device__ __forceinline__ void attn_unit(int bh, int ub, const bf16* Qm, const unsigned char* Km, const unsigned char* Vm, const bf16* Z, const float* rel_bias, bf16* O, LAS char* shm, const f32x2* rope,
                                                             const float* wgu, const float* wdn, unsigned char* WGU, unsigned char* WDN, int ctl, bool newbt,
                                                             bool pre, int nxt_kind, int nbh, int nub) {
    constexpr int ND0 = CA ? 4 : 6;
    int tid = threadIdx.x; asm volatile("" : "+v"(tid));
    const int lane = tid & 63, r32 = lane & 31, hi = lane >> 5, wid = __builtin_amdgcn_readfirstlane(tid >> 6);
    const bool late = wid >= 4;
    const unsigned lds0 = (unsigned)(uintptr_t)shm;
    const int b = bh >> 3, h = bh & 7; const size_t rowb = (size_t)b * SEQ;
    int NT, t0, t1, cqk = 0, qi = 0; const unsigned char* ksrc; const unsigned char* vsrc; size_t kst, vst; const LAS float* bt = nullptr;
    bf16x8 qr[ND0]; bf16* Ow; const bf16* Qw;
    if constexpr (CA) {
        const int c0 = 4 * ub, kc_lo = c0 >= 8 ? c0 - 8 : 0; NT = c0 + 4 - kc_lo; cqk = c0 + (wid >> 1) - kc_lo; t1 = cqk; t0 = cqk >= 8 ? cqk - 8 : 0; qi = (wid & 1) * 32 + r32;
        LAS float* btw = (LAS float*)(shm + LBT); bt = btw;
        if (newbt) for (int i = tid; i < 4 * 648; i += 512) { const int c = i / 648, j = i - c * 648; int idx = 640 - (j + c); idx = idx > 319 ? 319 : (idx < 0 ? 0 : idx); btw[i] = rel_bias[h * 320 + idx] * LOG2E; }
        Qw = Z + (rowb + c0 * 64 + wid * 32 + r32) * ZP + C_QC + h * 64;
        kv_ptrs<true>(bh, ub, lane, wid, Km, Vm, Z, ksrc, vsrc, kst, vst);
        Ow = O + (rowb + c0 * 64 + wid * 32) * OPI + 512 + h * 64;
    } else {
        NT = 4 * ub + 4; t0 = 0; t1 = 4 * ub + (wid >> 1);
        Qw = Qm + ((size_t)bh * SEQ + ub * 256 + wid * 32) * 96 + (size_t)r32 * 96;
        kv_ptrs<false>(bh, ub, lane, wid, Km, Vm, Z, ksrc, vsrc, kst, vst);
        Ow = O + (rowb + ub * 256 + wid * 32) * OPI + h * 64;
    }
    const bool k2 = !CA && wid < 4;
    const unsigned kdst = lds0 + LK + wid * 1024, vdst = lds0 + LV + wid * 1024;
    const unsigned kp0 = lds0 + LK + hi * 1024 + r32 * 16;
    const unsigned vp0 = lds0 + LV + ((lane >> 4) & 1) * 32 + (lane & 3) * 8 + (4 * hi + ((lane & 15) >> 2)) * 64;
    LAS float* wsf = (LAS float*)(shm + LWS) + wid * 64;
#define ATT_DMA(tt) do { const unsigned kd_ = (unsigned)__builtin_amdgcn_readfirstlane(kdst + ((tt) % NKS) * KSL); glds16(ksrc + (size_t)(tt) * kst, kd_); if (k2) glds16(ksrc + (size_t)(tt) * kst + 8192, kd_ + 8192); \
        glds16(vsrc + (size_t)(tt) * vst, (unsigned)__builtin_amdgcn_readfirstlane(vdst + ((tt) & 3) * VSL)); } while (0)
    if (!pre) { ATT_DMA(0); ATT_DMA(1); }
#pragma unroll
    for (int d0 = 0; d0 < ND0; ++d0) {
        if constexpr (CA) { const u32x4 qv = *(const u32x4*)(Qw + d0 * 16 + hi * 8);
            const u32x4 qs = {pk2(bf2f(qv.x) * C2C, bf2f(qv.x >> 16) * C2C), pk2(bf2f(qv.y) * C2C, bf2f(qv.y >> 16) * C2C), pk2(bf2f(qv.z) * C2C, bf2f(qv.z >> 16) * C2C), pk2(bf2f(qv.w) * C2C, bf2f(qv.w >> 16) * C2C)};
            qr[d0] = __builtin_bit_cast(bf16x8, qs); }
        else qr[d0] = *(const bf16x8*)(Qw + d0 * 16 + hi * 8); }
    if constexpr (!CA) {
        const f32x2* rp = rope + (size_t)(ub * 256 + wid * 32 + r32) * 16 + 4 * hi;
#pragma unroll
        for (int d0 = 4; d0 < 6; ++d0) { const f32x2 t0 = rp[8 * (d0 - 4)], t1 = rp[8 * (d0 - 4) + 1], t2 = rp[8 * (d0 - 4) + 2], t3 = rp[8 * (d0 - 4) + 3];
            const u32x4 qv = __builtin_bit_cast(u32x4, qr[d0]);
            const f32x4 x1 = {bf2f(qv.x), bf2f(qv.x >> 16), bf2f(qv.y), bf2f(qv.y >> 16)}, x2 = {bf2f(qv.z), bf2f(qv.z >> 16), bf2f(qv.w), bf2f(qv.w >> 16)};
            const f32x4 cs = {t0.x, t1.x, t2.x, t3.x}, sn = {t0.y, t1.y, t2.y, t3.y};
            const f32x4 o1 = x1 * cs - x2 * sn, o2 = x2 * cs + x1 * sn;
            const u32x4 qs = {pk2(o1[0], o1[1]), pk2(o1[2], o1[3]), pk2(o2[0], o2[1]), pk2(o2[2], o2[3])};
            qr[d0] = __builtin_bit_cast(bf16x8, qs); } }
    VM_WAIT();
    const bool cvx = ctl >= 0;
    if (cvx) { cv_dma(cv_src(wgu, wdn, ctl), lds0 + CONV_OFF, wid, lane); cv_dma(cv_src(wgu, wdn, ctl + 1), lds0 + CONV_OFF + 32768, wid, lane); }
    float mref = 0.f, l = 0.f; f32x16 o0, o1;
#pragma unroll
    for (int r = 0; r < 16; ++r) { o0[r] = 0.f; o1[r] = 0.f; }
    u32x4 w0 = {0u, 0u, 0u, 0u}, w1 = w0, w2 = w0, w3 = w0;
    bool pend = false;
#if PROBE_A >= 0
    unsigned long long tA_ = 0, tB_ = 0, tC_ = 0, tD_ = 0, tq_ = 0;
#define ATT_TS(acc) do { const unsigned long long n_ = __builtin_amdgcn_s_memrealtime(); acc += n_ - tq_; tq_ = n_; } while (0)
#else
#define ATT_TS(acc) do {} while (0)
#endif
#pragma unroll 1
    for (int t = 0; t < NT; ++t) {
#if PROBE_A >= 0
        tq_ = __builtin_amdgcn_s_memrealtime();
#endif
        if (t + 1 < NT) { if (cvx && t < 2) { if (k2) ATT_WAITBAR(11); else ATT_WAITBAR(10); } else { if (k2) ATT_WAITBAR(3); else ATT_WAITBAR(2); } } else ATT_WAITBAR(0);
        if (t + 2 < NT) ATT_DMA(t + 2);
        ATT_TS(tA_);
        unsigned kb_ = kp0 + (unsigned)((t % NKS) * KSL), vb_ = vp0 + (unsigned)((t & 3) * VSL), vq_ = vp0 + (unsigned)(((t + 3) & 3) * VSL);
        asm volatile("" : "+v"(kb_), "+v"(vb_), "+v"(vq_));
        if (late && pend) { pv8(o0, o1, vq_, w0, w1, w2, w3); pend = false; }
        if (t >= t0 && t <= t1) {
            f32x16 p0, p1;
            if constexpr (CA) { f32x16 c0, c1;
                const int Mb = 640 - ((cqk - t) * 64 + qi + 63); const LAS float* bp = bt + (Mb & 3) * 648 + (Mb & ~3) + 4 * hi;
#pragma unroll
                for (int g = 0; g < 4; ++g) { const f32x4 a = *(const LAS f32x4*)(bp + 8 * g), b2 = *(const LAS f32x4*)(bp + 8 * g + 32);
                    c0[4 * g] = a.x; c0[4 * g + 1] = a.y; c0[4 * g + 2] = a.z; c0[4 * g + 3] = a.w; c1[4 * g] = b2.x; c1[4 * g + 1] = b2.y; c1[4 * g + 2] = b2.z; c1[4 * g + 3] = b2.w; }
                qkt<ND0>(p0, p1, kb_, qr, c0, c1); }
            else { const f32x16 z = {0.f, 0.f, 0.f, 0.f, 0.f, 0.f, 0.f, 0.f, 0.f, 0.f, 0.f, 0.f, 0.f, 0.f, 0.f, 0.f}; qkt<ND0>(p0, p1, kb_, qr, z, z); }
            const bool resc = max_update(p0, p1, t == t0, mref, l, wsf, r32, hi);
            float sa = 0.f, sb = 0.f;
            exp_half(p0, mref, sa, w0, w1); exp_half(p1, mref, sb, w2, w3);
            l += sa + sb;
            if (resc) rescale_o(o0, o1, wsf, hi);
#if PROBE_A >= 0
            asm volatile("s_nop 0" : "+v"(w0), "+v"(w1), "+v"(w2), "+v"(w3));
#endif
            ATT_TS(tC_);
            if (late) pend = true;
            else pv8(o0, o1, vb_, w0, w1, w2, w3);
#if PROBE_A >= 0
            asm volatile("s_nop 0" : "+v"(o0), "+v"(o1));
#endif
            ATT_TS(tD_);
        }
    }
#if PROBE_A >= 0
    if (!CA && blockIdx.x == 0 && tid == PROBE_TID) { LAS unsigned long long* st_ = (LAS unsigned long long*)(shm + 147456 - 256 + 64); st_[16] += tA_; st_[17] += tB_; st_[18] += tC_; st_[19] += tD_; }
#endif
    if (late && pend) { const unsigned vq_ = vp0 + (unsigned)(((NT - 1) & 3) * VSL); pv8(o0, o1, vq_, w0, w1, w2, w3); }
#undef ATT_DMA
    asm volatile("s_waitcnt lgkmcnt(0)\n\ts_barrier" ::: "memory");
    if (nxt_kind) { const unsigned char* nks; const unsigned char* nvs; size_t nkst, nvst;
        if (nxt_kind == 1) kv_ptrs<false>(nbh, nub, lane, wid, Km, Vm, Z, nks, nvs, nkst, nvst); else kv_ptrs<true>(nbh, nub, lane, wid, Km, Vm, Z, nks, nvs, nkst, nvst);
        const bool nk2 = nxt_kind == 1 && wid < 4;
#pragma unroll
        for (int tt = 0; tt < 2; ++tt) { const unsigned kd_ = (unsigned)__builtin_amdgcn_readfirstlane(kdst + tt * KSL); glds16(nks + (size_t)tt * nkst, kd_); if (nk2) glds16(nks + (size_t)tt * nkst + 8192, kd_ + 8192);
            glds16(nvs + (size_t)tt * nvst, (unsigned)__builtin_amdgcn_readfirstlane(vdst + tt * VSL)); } }
    if (ctl >= 0) { cv_cvt(cv_src(wgu, wdn, ctl), (const LAS float*)(shm + CONV_OFF), WGU, WDN, tid); cv_cvt(cv_src(wgu, wdn, ctl + 1), (const LAS float*)(shm + CONV_OFF + 32768), WGU, WDN, tid);
        asm volatile("s_waitcnt lgkmcnt(0)\n\ts_barrier" ::: "memory"); }
    attn_store(o0, o1, l, Ow, shm, wid, lane, r32, hi);
}
}

#define XB_TMO      128
#define XB_XCNT(j)  (256  + 64 * (j))
#define XB_XSUB(j)  (1280 + 64 * (j))
#define XB_XGEN(j)  (2304 + 64 * (j))
#define XB_TOP      3328
#define XB_TOPGEN   3392
#define XCD_BAR_WORDS 3456
#define XB_SPIN_CAP (1u << 18)
__device__ __forceinline__ unsigned xb_ld(unsigned* p)              { return __hip_atomic_load(p, __ATOMIC_RELAXED, __HIP_MEMORY_SCOPE_AGENT); }
__device__ __forceinline__ unsigned xb_add(unsigned* p, unsigned v) { return __hip_atomic_fetch_add(p, v, __ATOMIC_RELAXED, __HIP_MEMORY_SCOPE_AGENT); }
__device__ __forceinline__ unsigned xb_xcc_id() { return (unsigned)__builtin_amdgcn_s_getreg((3 << 11) | 20) & 0xFu; }
#define XB_SPIN(cond, bar) do { unsigned _sp = 0; while (cond) { __builtin_amdgcn_s_sleep(1); \
    if ((++_sp & 255u) == 0u) { if (xb_ld(&(bar)[XB_TMO])) break; if (_sp > XB_SPIN_CAP) { atomicAdd(&(bar)[XB_TMO], 1u); break; } } } } while (0)
struct XcdBarrier { unsigned* bar; unsigned x; volatile LAS unsigned* st; };
__device__ __forceinline__ XcdBarrier xcd_barrier_post(unsigned* bar, volatile LAS unsigned* st) {
    XcdBarrier b; b.bar = bar; b.x = xb_xcc_id(); b.st = st;
    if (threadIdx.x == 0) (void)xb_add(&bar[XB_XCNT(b.x)], 1u);
    return b;
}
__device__ __forceinline__ void xcd_barrier_complete(unsigned* bar, unsigned x, unsigned& nloc, unsigned& nx) {
    const unsigned G = gridDim.x * gridDim.y * gridDim.z;
    unsigned sum, cnt, mine, sp = 0u;
    for (;;) {
        sum = 0u; cnt = 0u; mine = 0u;
#pragma unroll
        for (unsigned j = 0; j < 16; ++j) { const unsigned c = xb_ld(&bar[XB_XCNT(j)]); sum += c; cnt += (c > 0u) ? 1u : 0u; mine = (j == x) ? c : mine; }
        if (sum == G) break;
        __builtin_amdgcn_s_sleep(1);
        if ((++sp & 255u) == 0u) { if (xb_ld(&bar[XB_TMO])) break; if (sp > XB_SPIN_CAP) { atomicAdd(&bar[XB_TMO], 1u); break; } }
    }
    nloc = mine > 0u ? mine : 1u; nx = cnt > 0u ? cnt : 1u;
}
__device__ __forceinline__ void xcd_barrier(const XcdBarrier& b) {
    asm volatile("s_waitcnt vmcnt(0)" ::: "memory");
    __syncthreads();
    if (threadIdx.x == 0) {
        unsigned* bar = b.bar;
        __builtin_amdgcn_s_waitcnt(0);
        unsigned nloc = b.st[0], nx = b.st[1];
        if (nloc == 0u) { xcd_barrier_complete(bar, b.x, nloc, nx); b.st[0] = nloc; b.st[1] = nx; }
        const unsigned old = xb_add(&bar[XB_XSUB(b.x)], 1u);
        const unsigned gen = old / nloc;
        if (old + 1u == (gen + 1u) * nloc) {
            __builtin_amdgcn_fence(__ATOMIC_RELEASE, "agent");
            asm volatile("s_waitcnt vmcnt(0)" ::: "memory");
            const unsigned og = xb_add(&bar[XB_TOP], 1u);
            const unsigned tg = og / nx;
            if (og + 1u == (tg + 1u) * nx) xb_add(&bar[XB_TOPGEN], 1u);
            else XB_SPIN(xb_ld(&bar[XB_TOPGEN]) == tg, bar);
            __builtin_amdgcn_fence(__ATOMIC_ACQUIRE, "agent");
            xb_add(&bar[XB_XGEN(b.x)], 1u);
            asm volatile("s_waitcnt vmcnt(0)" ::: "memory");
        } else {
            XB_SPIN(xb_ld(&bar[XB_XGEN(b.x)]) == gen, bar);
            __builtin_amdgcn_fence(__ATOMIC_ACQUIRE, "agent");
            asm volatile("s_waitcnt vmcnt(0)" ::: "memory");
        }
    }
    __syncthreads();
}

struct Args { const float* in[21]; float* out; unsigned char* ws; int ph_lo, ph_hi; };
enum { I_X = 0, I_C, I_WADA, I_BADA, I_GPRE1, I_GPOST1, I_GPRE2, I_GPOST2, I_WIN, I_GQ, I_WQB, I_GKV, I_WKVB, I_RELB, I_WO, I_WR, I_BR, I_WGU, I_BGU, I_WDN, I_BDN };

__device__ __forceinline__ int qperm(int n) { const int h = n / 96, d = n - 96 * h; if (d < 64) return n; const int j = d - 64, i = j & 15, x2 = j >> 4; return h * 96 + 64 + 8 * (i >> 2) + 4 * x2 + (i & 3); }
__device__ __forceinline__ int krperm(int n) { if (n < C_KR || n >= C_KR + 32) return n; const int j = n - C_KR, x2 = j >> 4, i = j & 15; return C_KR + 8 * (i >> 2) + 4 * x2 + (i & 3); }
__device__ __forceinline__ void tr_item(const float* W, int ldw, bf16* WT, int ldt, int k0, int kdst0, int nsrc0, int mode, int ndst0, LAS float* scr, int lane, const float* rsc = nullptr) {
#pragma unroll 8
    for (int i = 0; i < 32; ++i) { const int kk = 2 * i + (lane >> 5); scr[kk * 33 + (lane & 31)] = W[(size_t)(k0 + kk) * ldw + nsrc0 + (lane & 31)] * (rsc ? rsc[k0 + kk] : 1.f); }
    LDS_WAIT(); asm volatile("" ::: "memory");
    const int c = lane & 7;
#pragma unroll
    for (int j = 0; j < 4; ++j) { const int n = (lane >> 3) + 8 * j; const LAS float* s = scr + (8 * c) * 33 + n;
        u32x4 o; o.x = pk2(s[0 * 33], s[1 * 33]); o.y = pk2(s[2 * 33], s[3 * 33]); o.z = pk2(s[4 * 33], s[5 * 33]); o.w = pk2(s[6 * 33], s[7 * 33]);
        const int dr = mode == 1 ? qperm(nsrc0 + n) : mode == 2 ? krperm(nsrc0 + n) : ndst0 + n;
        *(u32x4*)(WT + (size_t)dr * ldt + kdst0 + k0 + 8 * c) = o; }
    LDS_WAIT(); asm volatile("" ::: "memory");
}

__device__ __forceinline__ void tr_item8(const float* W, int ldw, unsigned char* WT, int ldt, int k0, int nsrc0, int ndst0, float scale, LAS float* scr, int lane) {
#pragma unroll 8
    for (int i = 0; i < 32; ++i) { const int kk = 2 * i + (lane >> 5); scr[kk * 33 + (lane & 31)] = W[(size_t)(k0 + kk) * ldw + nsrc0 + (lane & 31)] * scale; }
    LDS_WAIT(); asm volatile("" ::: "memory");
    const int n = lane >> 1, hf = lane & 1; const LAS float* s = scr + (32 * hf) * 33 + n;
    unsigned w[8];
#pragma unroll
    for (int q = 0; q < 8; ++q) w[q] = pk4_fp8(s[(4 * q) * 33], s[(4 * q + 1) * 33], s[(4 * q + 2) * 33], s[(4 * q + 3) * 33]);
    unsigned char* dst = WT + (size_t)(ndst0 + n) * ldt + k0 + 32 * hf;
    *(u32x4*)dst = (u32x4){w[0], w[1], w[2], w[3]}; *(u32x4*)(dst + 16) = (u32x4){w[4], w[5], w[6], w[7]};
    LDS_WAIT(); asm volatile("" ::: "memory");
}

__global__ void __launch_bounds__(512, 2) fwd(Args args) {
    extern __shared__ __attribute__((aligned(16))) unsigned char lds_raw[];
    LAS unsigned char* lds = (LAS unsigned char*)lds_raw;
    const int tid = threadIdx.x, lane = tid & 63, wave = __builtin_amdgcn_readfirstlane(tid >> 6);
    const int G = gridDim.x; const int bx = blockIdx.x; const int vcu = (G % 8 == 0) ? (bx % 8) * (G / 8) + bx / 8 : bx;
    unsigned char* ws = args.ws;
    unsigned* ctl = (unsigned*)(ws + WS_CTL);
    volatile LAS unsigned* MISC = (volatile LAS unsigned*)(lds + MISC_OFF);
    if (tid < 64) MISC[tid] = 0u;
    __syncthreads();
#if MK_ONE_LAUNCH
    XcdBarrier bar = xcd_barrier_post(ctl + CW_BAR, MISC + 8);
#define GRID_BAR() xcd_barrier(bar)
#else
#define GRID_BAR() do {} while (0)
#endif
    const int lo = args.ph_lo, hi_ph = args.ph_hi;
#if PROBE_A >= 0
#define STAMP(k) do { if (blockIdx.x == 0 && tid == 0) { LAS unsigned long long* st_ = (LAS unsigned long long*)(lds + MISC_OFF + 64); st_[k] = __builtin_amdgcn_s_memrealtime(); if ((k) == PROBE_A && PROBE_B == 15) st_[20] = __builtin_amdgcn_s_memtime(); if ((k) == PROBE_A + 1 && PROBE_B == 15) st_[21] = __builtin_amdgcn_s_memtime(); if ((k) == PROBE_A && PROBE_B == 14) st_[14] = 0ull; if ((k) == PROBE_A + 1 && PROBE_B == 14) st_[13] = st_[14]; } } while (0)
#else
#define STAMP(k) do {} while (0)
#endif
    STAMP(0);
#ifndef PHM
#define PHM 0x1fff
#endif
#define IN(k) (((PHM >> (k)) & 1) && lo <= (k) && (k) < hi_ph)
#define BOTH(k) (IN(k) && IN((k) + 1))
    const float* x = args.in[I_X]; float* out = args.out;
    float* mod = (float*)(ws + WS_MOD); float* wrT = (float*)(ws + WS_WRT); float* gates = (float*)(ws + WS_GATE); f32x2* rope = (f32x2*)(ws + WS_ROPE);
    bf16* WQ = (bf16*)(ws + WS_WQKV); bf16* WKV = (bf16*)(ws + WS_WQKV + 512 * 1024); unsigned* tinfo = (unsigned*)(ws + WS_TINFO); unsigned* lists = (unsigned*)(ws + WS_LIST);
    float* rsv = (float*)(ws + WS_RS); unsigned char* H8A = ws + WS_H8A; unsigned char* WIN8 = ws + WS_WIN8;
    bf16* WIN = (bf16*)(ws + WS_WIN); bf16* WOt = (bf16*)(ws + WS_WO); unsigned char* WDN = ws + WS_WDN; unsigned char* WGU = ws + WS_WGU;
    bf16* Hb = (bf16*)(ws + WS_H); unsigned char* H8 = ws + WS_H8; bf16* Z = (bf16*)(ws + WS_Z); bf16* Qm = (bf16*)(ws + WS_QM); unsigned char* Km = ws + WS_KM; unsigned char* Vm = ws + WS_VM;
    bf16* Ob = (bf16*)(ws + WS_O); bf16* OP = (bf16*)(ws + WS_OP); unsigned char* ACT = ws + WS_ACT; unsigned char* Y = ws + WS_Y;
    const int gw = vcu * 8 + wave, NGW = G * 8, gt = vcu * 512 + tid, NGT = G * 512;

    if (IN(0)) {
        { constexpr int T_GU = 32 * 8 * 32, T_DN = 32 * 4 * 32, NTILE = T_GU + T_DN;
          const int per = (NTILE + G - 1) / G, tl0 = vcu * per, tl1 = ((tl0 + per < NTILE) ? tl0 + per : NTILE) - ((per * G == NTILE && per >= 32) ? 32 : 0);
          const unsigned ldsb = (unsigned)(uintptr_t)lds;
          auto tile_src = [&](int tl, const float*& W, int& ldw, int& e, int& kb, int& nb, bool& gu) {
              gu = tl < T_GU; const int r = gu ? tl : tl - T_GU; kb = r & 31; const int q = r >> 5;
              if (gu) { nb = q & 7; e = q >> 3; W = args.in[I_WGU] + (size_t)e * 1024 * 2048; ldw = 2048; } else { nb = q & 3; e = q >> 2; W = args.in[I_WDN] + (size_t)e * 1024 * 1024; ldw = 1024; } };
#define P0_DMA(tl, buf) do { const float* W_; int ldw_, e_, kb_, nb_; bool gu_; tile_src(tl, W_, ldw_, e_, kb_, nb_, gu_); \
              _Pragma("unroll") for (int j = 0; j < 4; ++j) { const int k_ = kb_ * 32 + wave * 4 + j; \
                  att::glds16((const unsigned char*)(W_ + (size_t)k_ * ldw_ + nb_ * 256) + lane * 16, (unsigned)__builtin_amdgcn_readfirstlane(ldsb + (buf) * 32768 + (wave * 4 + j) * 1024)); } } while (0)
#pragma unroll 1
          for (int q = 0; q < 3; ++q) if (tl0 + q < tl1) P0_DMA(tl0 + q, q);
#pragma unroll 1
          for (int tl = tl0; tl < tl1; ++tl) { const int buf = (tl - tl0) & 3;
              const int rem = tl1 - 1 - tl;
              if (rem >= 2) asm volatile("s_waitcnt vmcnt(8)\n\ts_barrier" ::: "memory"); else if (rem == 1) asm volatile("s_waitcnt vmcnt(4)\n\ts_barrier" ::: "memory"); else asm volatile("s_waitcnt vmcnt(0)\n\ts_barrier" ::: "memory");
              if (tl + 3 < tl1) P0_DMA(tl + 3, (buf + 3) & 3);
              const float* W; int ldw, e, kb, nb; bool gu; tile_src(tl, W, ldw, e, kb, nb, gu);
              const int i = tid & 255, kh = tid >> 8; const LAS float* sc = (const LAS float*)(lds + buf * 32768) + (16 * kh) * 256 + i;
              unsigned w[4];
#pragma unroll
              for (int q = 0; q < 4; ++q) w[q] = pk4_fp8(sc[(4 * q) * 256] * W8S, sc[(4 * q + 1) * 256] * W8S, sc[(4 * q + 2) * 256] * W8S, sc[(4 * q + 3) * 256] * W8S);
              size_t drow; unsigned char* WT;
              if (gu) { drow = (size_t)e * 2048 + (2 * (nb & 3) + (i >> 7)) * 256 + (nb >> 2) * 128 + (i & 127); WT = WGU; } else { drow = (size_t)e * 1024 + nb * 256 + i; WT = WDN; }
              *(u32x4*)(WT + drow * 1024 + kb * 32 + 16 * kh) = (u32x4){w[0], w[1], w[2], w[3]}; }
#undef P0_DMA
          asm volatile("s_waitcnt vmcnt(0) lgkmcnt(0)\n\ts_barrier" ::: "memory"); }
        LAS float* scr = (LAS float*)(lds + wave * 16384);
        constexpr int I_IN = 16 * 16, I_O = 16 * 32, I_QB = 4 * 24, I_KVB = 2 * 32;
        constexpr int NITEMS = I_IN + I_O + I_QB + I_KVB;
        for (int it = gw; it < NITEMS; it += NGW) {
            int r = it;
            if (r < I_IN) { const int kb = r >> 4, nb = r & 15; tr_item(args.in[I_WIN], IN_W, WIN, 1024, kb * 64, 0, nb * 32, 2, 0, scr, lane); continue; } r -= I_IN;
            if (r < I_O) { const int kb = r >> 5, nb = r & 31; tr_item(args.in[I_WO], 1024, WOt, OPI, kb * 64, 0, nb * 32, 0, nb * 32, scr, lane); continue; } r -= I_O;
            if (r < I_QB) { const int kb = r / 24, nb = r % 24; tr_item(args.in[I_WQB], 768, WQ, 256, kb * 64, 0, nb * 32, 1, 0, scr, lane, args.in[I_GQ]); continue; } r -= I_QB;
            { const int kb = r >> 5, nb = r & 31; tr_item(args.in[I_WKVB], 1024, WKV, 256, kb * 64, 128, nb * 32, 0, nb * 32, scr, lane, args.in[I_GKV]); }
        }
        for (int it = gw; it < 16 * 45; it += NGW) { const int kb = it / 45, nb = it % 45; tr_item8(args.in[I_WIN], IN_W, WIN8, 1024, kb * 64, 512 + nb * 32, nb * 32, W8S, scr, lane); }
        const u32x4 z4 = {0u, 0u, 0u, 0u};
        for (int i = gt; i < 96 * 64; i += NGT) *(u32x4*)(WIN8 + (size_t)1440 * 1024 + (size_t)i * 16) = z4;
        for (int i = gt; i < 12288; i += NGT) *(u32x4*)((unsigned char*)WIN + (size_t)IN_W * 2048 + (size_t)i * 16) = z4;
        for (int i = gt; i < 1024 * 16; i += NGT) { const int rr = i >> 4, cc = i & 15; *(u32x4*)((unsigned char*)WKV + (size_t)rr * 512 + cc * 16) = z4; }
        for (int i = gt; i < SEQ * 16; i += NGT) { const int pos = i >> 4, fi = i & 15;
            const float invf = __builtin_amdgcn_exp2f(-(float)fi * (13.287712379549449f / 16.f)); const float ang = (float)pos * invf;
            const double rev = (double)ang * 0.15915494309189535; const float fr = (float)(rev - __builtin_rint(rev));
            rope[i] = (f32x2){__builtin_amdgcn_cosf(fr), __builtin_amdgcn_sinf(fr)}; }
        for (int i = gt; i < 32 * 1024; i += NGT) { const int e = i >> 10, d = i & 1023; const float w = args.in[I_WR][d * 32 + e]; wrT[i] = w;
            const unsigned wh = f2bf(w); ((bf16*)(ws + WS_WRH))[i] = (bf16)wh; ((bf16*)(ws + WS_WRL))[i] = (bf16)f2bf(w - bf2f(wh)); }
        { LAS float* scs = (LAS float*)lds;
          __syncthreads();
          for (int i = tid; i < 8192; i += 512) { const float v = args.in[I_C][i]; scs[i] = v / (1.f + __expf(-v)); }
          __syncthreads();
          for (int cb = vcu; cb < 256; cb += G) { const int col0 = cb * 24 + wave * 3; float wv[16][3];
#pragma unroll
              for (int i = 0; i < 16; ++i)
#pragma unroll
                  for (int c = 0; c < 3; ++c) wv[i][c] = args.in[I_WADA][(size_t)(lane + 64 * i) * MODW + col0 + c];
#pragma unroll 1
              for (int bb = 0; bb < 8; ++bb) { float s0 = 0.f, s1 = 0.f, s2 = 0.f;
#pragma unroll
                  for (int i = 0; i < 16; ++i) { const float sv = scs[bb * 1024 + lane + 64 * i]; s0 += sv * wv[i][0]; s1 += sv * wv[i][1]; s2 += sv * wv[i][2]; }
                  s0 = wave_sum(s0); s1 = wave_sum(s1); s2 = wave_sum(s2);
                  if (lane == 0) { mod[bb * MODW + col0] = s0 + args.in[I_BADA][col0]; mod[bb * MODW + col0 + 1] = s1 + args.in[I_BADA][col0 + 1]; mod[bb * MODW + col0 + 2] = s2 + args.in[I_BADA][col0 + 2]; } } }
          __syncthreads(); }
        if (BOTH(0)) GRID_BAR(); STAMP(1);
    }

    if (IN(1)) {
        for (int tile = vcu; tile < T / 256; tile += G) {
            const int row0 = tile * 256, b = row0 >> 13; const float* mb = mod + b * MODW;
            f32x4 a[4], s[4];
#pragma unroll
            for (int j = 0; j < 4; ++j) { const int d = 4 * lane + 256 * j; const f32x4 g = *(const f32x4*)(args.in[I_GPRE1] + d), sc1 = *(const f32x4*)(mb + 1024 + d); a[j] = g * (1.f + sc1); s[j] = *(const f32x4*)(mb + d); }
            const int rbase = row0 + wave * 32;
#define P1_LOAD(dst, i_) do { const int i0_ = (i_) < 30 ? (i_) : 30; _Pragma("unroll") for (int r = 0; r < 2; ++r) { const f32x4* xr = (const f32x4*)(x + (size_t)(rbase + i0_ + r) * DM) + lane; _Pragma("unroll") for (int j = 0; j < 4; ++j) dst[r][j] = xr[64 * j]; } } while (0)
#define P1_PROC(v_, i_) do { _Pragma("unroll") for (int r = 0; r < 2; ++r) { const int row = rbase + (i_) + r; float ss = 0.f; \
                _Pragma("unroll") for (int j = 0; j < 4; ++j) ss += (v_[r][j].x * v_[r][j].x + v_[r][j].y * v_[r][j].y) + (v_[r][j].z * v_[r][j].z + v_[r][j].w * v_[r][j].w); \
                const float rstd = 1.f / sqrtf(wave_sum(ss) * (1.f / DM) + EPS); \
                u32x2* o8 = (u32x2*)(Hb + (size_t)row * DM) + lane; \
                _Pragma("unroll") for (int j = 0; j < 4; ++j) { const f32x4 hv = v_[r][j] * rstd * a[j] + s[j]; o8[64 * j] = (u32x2){pk2(hv.x, hv.y), pk2(hv.z, hv.w)}; \
                    ((unsigned*)(H8A + (size_t)row * DM) + lane)[64 * j] = pk4_fp8(fminf(fmaxf(hv.x * A8S, -448.f), 448.f), fminf(fmaxf(hv.y * A8S, -448.f), 448.f), fminf(fmaxf(hv.z * A8S, -448.f), 448.f), fminf(fmaxf(hv.w * A8S, -448.f), 448.f)); } } } while (0)
            f32x4 vA[2][4], vB[2][4];
            P1_LOAD(vA, 0);
#pragma unroll 1
            for (int i = 0; i < 32; i += 4) {
                P1_LOAD(vB, i + 2);
                P1_PROC(vA, i);
                P1_LOAD(vA, i + 4);
                P1_PROC(vB, i + 2);
            }
#undef P1_LOAD
#undef P1_PROC
        }
        if (BOTH(1)) GRID_BAR(); STAMP(2);
    }

    if (IN(2)) {
        auto p2_bf16 = [&]() { pg8::Gemm g{Hb, WIN, 2048, 2048}; pg8::DenseSched S{2, (T / 256) * 2, G, vcu, 2048}; pg8::EpiZ E{Z, ZP, rsv, Km, rope, (LAS float*)(lds + 131072), (bf16*)(ws + WS_AQ)};
          pg8::gemm_phase<pg8::EpiZ, pg8::DenseSched, true, false>(lds, g, S, E); };
        auto p2_fp8 = [&]() { pg8::Gemm g{H8A, WIN8, 1024, 1024}; pg8::DenseSched S{6, (T / 256) * 6, G, vcu, 1024}; pg8::EpiPlainS E{Z + 512, ZP, 1.f / (W8S * A8S)};
          pg8::gemm_phase<pg8::EpiPlainS, pg8::DenseSched, true, true>(lds, g, S, E); };
        if (vcu & 1) { p2_bf16(); p2_fp8(); } else { p2_fp8(); p2_bf16(); }
        if (BOTH(2)) GRID_BAR(); STAMP(3);
    }

    if (IN(3)) { STAMP(4); }

    if (IN(4)) {
        auto p4_q = [&]() { pg8::Gemm g{(bf16*)(ws + WS_AQ), WQ, 512, 512}; pg8::DenseSched S{3, (T / 256) * 3, G, vcu, 768}; pg8::EpiQKV E{Qm, Km, Vm, rope, 0, rsv};
          pg8::gemm_phase<pg8::EpiQKV, pg8::DenseSched, true, false>(lds, g, S, E); };
        auto p4_kv = [&]() { pg8::Gemm g{(bf16*)(ws + WS_AQ) + 256, WKV + 128, 256, 512}; pg8::DenseSched S{4, (T / 256) * 4, G, vcu, 768}; pg8::EpiQKV E{Qm, Km, Vm, rope, 768, rsv + T};
          pg8::gemm_phase<pg8::EpiQKV, pg8::DenseSched, true, false>(lds, g, S, E); };
        if (vcu & 1) { p4_kv(); p4_q(); } else { p4_q(); p4_kv(); }
        if (BOTH(4)) GRID_BAR(); STAMP(5);
    }

    if (IN(5)) {
        constexpr int NTILE_ = 32 * 8 * 32 + 32 * 4 * 32; const int per_ = (NTILE_ + G - 1) / G;
        const int cv5 = (per_ * G == NTILE_ && per_ >= 32) ? vcu * per_ + per_ - 32 : -1;
        for (int v = vcu; v < 256; v += G) {
            const int bh = v >> 2, s4 = v & 3;
#pragma unroll 1
            for (int i = 0; i < 8; ++i) { const int qb = 8 * (i >> 1) + ((i & 1) ? 7 - s4 : s4); att::attn_unit<false>(bh, qb, Qm, Km, Vm, Z, nullptr, Ob, (LAS char*)lds, rope, args.in[I_WGU], args.in[I_WDN], WGU, WDN, (cv5 >= 0 && v == vcu) ? cv5 + 2 * i : -1, false,
                    i > 0, i < 7 ? 1 : 2, i < 7 ? bh : (v * 8) >> 5, i < 7 ? 8 * ((i + 1) >> 1) + (((i + 1) & 1) ? 7 - s4 : s4) : (v * 8) & 31); }
            STAMP(12);
#pragma unroll 1
            for (int i = 0; i < 8; ++i) { const int id = v * 8 + i; att::attn_unit<true>(id >> 5, id & 31, Qm, Km, Vm, Z, args.in[I_RELB], Ob, (LAS char*)lds, rope, args.in[I_WGU], args.in[I_WDN], WGU, WDN, (cv5 >= 0 && v == vcu) ? cv5 + 16 + 2 * i : -1, i == 0,
                    true, i < 7 ? 2 : 0, (id + 1) >> 5, (id + 1) & 31); }
        }
        if (BOTH(5)) GRID_BAR(); STAMP(6);
    }

    if (IN(6)) {
        pg8::Gemm g{Ob, WOt, 2048, OPI * 2}; pg8::DenseSched S{4, (T / 256) * 4, G, vcu, OPI * 2}; pg8::EpiPlain E{OP, 1024};
        pg8::gemm_phase<pg8::EpiPlain, pg8::DenseSched, true, false>(lds, g, S, E);
        if (BOTH(6)) GRID_BAR(); STAMP(7);
    }

    if (IN(7)) {
        constexpr int HP = 1032;
        LAS bf16* Hh = (LAS bf16*)lds; LAS bf16* Hl = Hh + 32 * HP;
        LAS float* part = (LAS float*)lds;
        LAS float* Lg = (LAS float*)(lds + 132096);
        LAS int* hist = (LAS int*)(lds + 132096 + 4352);
        LAS int* gbase = hist + 64;
        LAS unsigned* pend = (LAS unsigned*)(lds + 145408);
        unsigned* gcnt = ctl + CW_CNT;
        LAS float* Cst = (LAS float*)(lds + 136960);
        for (int tile = vcu; tile < T / 256; tile += G) {
            const int row0 = tile * 256, b = row0 >> 13; const float* mb = mod + b * MODW;
            int tq = tid; asm volatile("" : "+v"(tq));
            { const int d = 4 * (tq & 255);
              if (tq < 256) *(LAS f32x4*)(Cst + d) = *(const f32x4*)(mb + 2048 + d) * *(const f32x4*)(args.in[I_GPOST1] + d);
              else *(LAS f32x4*)(Cst + 1024 + d) = *(const f32x4*)(args.in[I_GPRE2] + d) * (1.f + *(const f32x4*)(mb + 4096 + d)); }
            __syncthreads();
            int lo_ = lane; asm volatile("" : "+v"(lo_));
            f32x4 S2[4];
#pragma unroll
            for (int j = 0; j < 4; ++j) S2[j] = *(const f32x4*)(mb + 3072 + 4 * lo_ + 256 * j);
            u32x4 bh[8], bl[8];
            { const int tk = lo_ & 31, hi = lo_ >> 5; const bf16* bph = (const bf16*)(ws + WS_WRH) + tk * 1024 + wave * 128 + 8 * hi; const bf16* bpl = (const bf16*)(ws + WS_WRL) + tk * 1024 + wave * 128 + 8 * hi;
#pragma unroll
              for (int m = 0; m < 8; ++m) { bh[m] = *(const u32x4*)(bph + 16 * m); bl[m] = *(const u32x4*)(bpl + 16 * m); } }
            int bi_ = (tid >> 5) * 2; asm volatile("" : "+v"(bi_)); const float br0 = args.in[I_BR][bi_], br1 = args.in[I_BR][bi_ + 1];
            f32x4 xa[3][4];
#define P7_LOAD(g) do { _Pragma("unroll") for (int i = 0; i < 3; ++i) { const int row = row0 + (g) * 32 + wave * 4 + i; const f32x4* xr = (const f32x4*)(x + (size_t)row * DM) + lane; \
                _Pragma("unroll") for (int j = 0; j < 4; ++j) xa[i][j] = xr[64 * j]; } } while (0)
            P7_LOAD(0);
            if (tq < 32) hist[tq] = 0;
            for (int grp = 0; grp < 8; ++grp) {
                const int tok0 = row0 + grp * 32;
                { u32x2 pa[4][4]; f32x4 x3[4];
#pragma unroll
                  for (int i = 0; i < 4; ++i) { const u32x2* pr = (const u32x2*)(OP + (size_t)(tok0 + wave * 4 + i) * DM) + lane;
#pragma unroll
                      for (int j = 0; j < 4; ++j) pa[i][j] = pr[64 * j]; }
                  { const f32x4* xr = (const f32x4*)(x + (size_t)(tok0 + wave * 4 + 3) * DM) + lane;
#pragma unroll
                    for (int j = 0; j < 4; ++j) x3[j] = xr[64 * j]; }
#pragma unroll
                  for (int i = 0; i < 4; ++i) { const int tl = wave * 4 + i, row = tok0 + tl;
                    f32x4 xv[4], ov[4]; float ss = 0.f;
#pragma unroll
                    for (int j = 0; j < 4; ++j) { if (i < 3) xv[j] = xa[i][j]; else xv[j] = x3[j]; const u32x2 p = pa[i][j]; ov[j] = (f32x4){bf2f(p.x), bf2f(p.x >> 16), bf2f(p.y), bf2f(p.y >> 16)};
                        ss += (ov[j].x * ov[j].x + ov[j].y * ov[j].y) + (ov[j].z * ov[j].z + ov[j].w * ov[j].w); }
                    const float r1 = 1.f / sqrtf(wave_sum(ss) * (1.f / DM) + EPS); float ss2 = 0.f;
#pragma unroll
                    for (int j = 0; j < 4; ++j) { const f32x4 a1 = *(const LAS f32x4*)(Cst + 4 * lane + 256 * j); xv[j] = xv[j] + a1 * (ov[j] * r1); ss2 += (xv[j].x * xv[j].x + xv[j].y * xv[j].y) + (xv[j].z * xv[j].z + xv[j].w * xv[j].w);
                        ((u32x2*)(OP + (size_t)row * DM) + lane)[64 * j] = (u32x2){pk2(xv[j].x, xv[j].y), pk2(xv[j].z, xv[j].w)}; }
                    const float r2 = 1.f / sqrtf(wave_sum(ss2) * (1.f / DM) + EPS);
                    unsigned* h8 = (unsigned*)(H8 + (size_t)row * DM) + lane;
#pragma unroll
                    for (int j = 0; j < 4; ++j) { const f32x4 a2 = *(const LAS f32x4*)(Cst + 1024 + 4 * lane + 256 * j); const f32x4 hv = xv[j] * r2 * a2 + S2[j]; h8[64 * j] = pk4_fp8(fminf(fmaxf(hv.x * A8S, -448.f), 448.f), fminf(fmaxf(hv.y * A8S, -448.f), 448.f), fminf(fmaxf(hv.z * A8S, -448.f), 448.f), fminf(fmaxf(hv.w * A8S, -448.f), 448.f));
                        const unsigned h0 = pk2(hv.x, hv.y), h1 = pk2(hv.z, hv.w); const f32x4 lv = hv - (f32x4){bf2f(h0), bf2f(h0 >> 16), bf2f(h1), bf2f(h1 >> 16)};
                        *(LAS u32x2*)(Hh + tl * HP + 4 * lane + 256 * j) = (u32x2){h0, h1}; *(LAS u32x2*)(Hl + tl * HP + 4 * lane + 256 * j) = (u32x2){pk2(lv.x, lv.y), pk2(lv.z, lv.w)}; } } }
                __syncthreads();
                if (grp + 1 < 8) P7_LOAD(grp + 1);
                f32x16 pl;
#pragma unroll
                for (int r = 0; r < 16; ++r) pl[r] = 0.f;
                { const int tk = lane & 31, hi = lane >> 5; const LAS bf16* aph = Hh + tk * HP + wave * 128 + 8 * hi; const LAS bf16* apl = Hl + tk * HP + wave * 128 + 8 * hi;
#pragma unroll
                    for (int m = 0; m < 8; ++m) { const bf16x8 ah = __builtin_bit_cast(bf16x8, *(const LAS u32x4*)(aph + 16 * m)), al = __builtin_bit_cast(bf16x8, *(const LAS u32x4*)(apl + 16 * m));
                        const bf16x8 wh = __builtin_bit_cast(bf16x8, bh[m]), wl = __builtin_bit_cast(bf16x8, bl[m]);
                        pl = __builtin_amdgcn_mfma_f32_32x32x16_bf16(ah, wh, pl, 0, 0, 0); pl = __builtin_amdgcn_mfma_f32_32x32x16_bf16(ah, wl, pl, 0, 0, 0); pl = __builtin_amdgcn_mfma_f32_32x32x16_bf16(al, wh, pl, 0, 0, 0); } }
                __syncthreads();
                { const int e = lane & 31, hi = lane >> 5;
#pragma unroll
                    for (int r = 0; r < 16; ++r) part[(wave * 32 + att::crow(r, hi)) * 33 + e] = pl[r]; }
                __syncthreads();
                { const int tk = tid & 31, e0 = (tid >> 5) * 2;
#pragma unroll
                    for (int q = 0; q < 2; ++q) { const int e = e0 + q; float s = q ? br1 : br0;
#pragma unroll
                        for (int w = 0; w < 8; ++w) s += part[(w * 32 + tk) * 33 + e];
                        Lg[tk * 33 + e] = s; } }
                __syncthreads();
                if (wave == 0) {
                    const int tk = lane & 31, tok = tok0 + tk; int ei[4]; float ev[4]; int li[4];
                    { int c0 = -1, c1 = -1, c2 = -1;
#pragma unroll
                        for (int k = 0; k < 4; ++k) { float best = -INFINITY; int bi = 0;
                            for (int e = 0; e < 32; ++e) { const float v = Lg[tk * 33 + e]; if (e != c0 && e != c1 && e != c2 && v > best) { best = v; bi = e; } }
                            ei[k] = bi; ev[k] = best; if (k == 0) c0 = bi; else if (k == 1) c1 = bi; else if (k == 2) c2 = bi; } }
                    float gsum = 0.f, gv[4];
#pragma unroll
                    for (int k = 0; k < 4; ++k) { gv[k] = __expf(ev[k] - ev[0]); gsum += gv[k]; }
                    const float ginv = 1.f / gsum;
                    if (lane < 32) {
#pragma unroll
                        for (int k = 0; k < 4; ++k) li[k] = __hip_atomic_fetch_add(hist + ei[k], 1, __ATOMIC_RELAXED, __HIP_MEMORY_SCOPE_WORKGROUP);
                        *(f32x4*)(gates + (size_t)tok * 4) = (f32x4){gv[0] * ginv, gv[1] * ginv, gv[2] * ginv, gv[3] * ginv};
                        *(LAS u32x4*)(pend + (grp * 32 + tk) * 4) = (u32x4){((unsigned)ei[0] << 16) | (unsigned)li[0], ((unsigned)ei[1] << 16) | (unsigned)li[1], ((unsigned)ei[2] << 16) | (unsigned)li[2], ((unsigned)ei[3] << 16) | (unsigned)li[3]};
                    }
                }
                __syncthreads();
            }
            if (wave == 0) { int ln = lane; asm volatile("" : "+v"(ln)); const int c = hist[ln & 31]; int gb = 0; if (c > 0 && ln < 32) gb = (int)__hip_atomic_fetch_add(gcnt + ln, (unsigned)c, __ATOMIC_RELAXED, __HIP_MEMORY_SCOPE_AGENT); if (ln < 32) gbase[ln] = gb; }
            __syncthreads();
            for (int q = tid; q < 1024; q += 512) { const unsigned pe = pend[q]; const int e = (int)(pe >> 16), idx = gbase[e] + (int)(pe & 0xffffu); const int tok = row0 + (q >> 2), k = q & 3;
                lists[(size_t)e * LIST_CAP + idx] = (unsigned)tok * 4u + (unsigned)k;
                tinfo[(size_t)tok * 4 + k] = ((unsigned)e << 16) | (unsigned)idx; }
            __syncthreads();
        }
#undef P7_LOAD
        if (BOTH(7)) GRID_BAR(); STAMP(8);
    }

#define MOE_TABLES(NT_, NER_) do { LAS int* tst = (LAS int*)(lds + TAB_OFF); LAS int* cn = tst + 40; LAS int* ut_ = (LAS int*)(lds + TAB_OFF + 512); \
        if (tid < 32) cn[tid] = (int)__hip_atomic_load(ctl + CW_CNT + tid, __ATOMIC_RELAXED, __HIP_MEMORY_SCOPE_AGENT); \
        __syncthreads(); \
        if (tid == 0) { int acc_ = 0; for (int e = 0; e < 32; ++e) { tst[e] = acc_; acc_ += (cn[e] + 255) >> 8; } tst[32] = acc_; } \
        __syncthreads(); \
        if (tid < 128) { const int L_ = tid * G + vcu; if (L_ < tst[32] * (NT_)) { const int rt_ = L_ / (NT_), pn_ = L_ % (NT_); int e_ = 0; \
            for (int st_ = 16; st_; st_ >>= 1) if (tst[e_ + st_] <= rt_) e_ += st_; \
            const int pm_ = rt_ - tst[e_]; ut_[tid * 8] = e_; ut_[tid * 8 + 1] = pm_; ut_[tid * 8 + 2] = pn_; ut_[tid * 8 + 3] = cn[e_] - pm_ * 256; ut_[tid * 8 + 4] = rt_ * 256; ut_[tid * 8 + 5] = e_ * (NER_) + pn_ * 256; } } \
        __syncthreads(); } while (0)
#define MOE_NUN(NT_) ([&]() { const int tot_ = __builtin_amdgcn_readfirstlane(((const LAS int*)(lds + TAB_OFF))[32]) * (NT_); return tot_ > vcu ? (tot_ - vcu + G - 1) / G : 0; }())
    if (IN(8)) { MOE_TABLES(8, 2048);
        pg8::Gemm g{H8, WGU, 1024, 1024}; pg8::MoeSched S{(const LAS int*)(lds + TAB_OFF), (const LAS int*)(lds + TAB_OFF) + 40, lists, 8, G, vcu, 2048, (const LAS int*)(lds + TAB_OFF + 512), MOE_NUN(8)};
        pg8::EpiGU E{ACT, args.in[I_BGU]}; pg8::gemm_phase<pg8::EpiGU, pg8::MoeSched, true, true>(lds, g, S, E);
        if (BOTH(8)) GRID_BAR(); STAMP(9); }
    if (IN(9)) { MOE_TABLES(4, 1024);
        pg8::Gemm g{ACT, WDN, 1024, 1024}; pg8::MoeSched S{(const LAS int*)(lds + TAB_OFF), (const LAS int*)(lds + TAB_OFF) + 40, nullptr, 4, G, vcu, 1024, (const LAS int*)(lds + TAB_OFF + 512), MOE_NUN(4)};
        pg8::EpiDN E{Y, args.in[I_BDN]}; pg8::gemm_phase<pg8::EpiDN, pg8::MoeSched, true, true>(lds, g, S, E);
        if (BOTH(9)) GRID_BAR(); STAMP(10); }

    if (IN(10)) {
        int tid_o = threadIdx.x; asm volatile("" : "+v"(tid_o)); const int lane = tid_o & 63;
        MOE_TABLES(4, 1024);
        const LAS int* tst = (const LAS int*)(lds + TAB_OFF);
        for (int tile = vcu; tile < T / 256; tile += G) {
            const int row0 = tile * 256, b = row0 >> 13; const float* mb = mod + b * MODW;
            f32x4 A3[4];
#pragma unroll
            for (int j = 0; j < 4; ++j) { const int d = 4 * lane + 256 * j; A3[j] = *(const f32x4*)(mb + 5120 + d) * *(const f32x4*)(args.in[I_GPOST2] + d); }
#define P10_YADDR(ti_) ((const unsigned*)(Y + ((size_t)tst[(ti_) >> 16] * 256 + ((ti_) & 0xffffu)) * 1024) + lane)
#define P10_LOADY(yp_, xp_, ti_, row_) do { const unsigned* y0_ = P10_YADDR((ti_).x); const unsigned* y1_ = P10_YADDR((ti_).y); const unsigned* y2_ = P10_YADDR((ti_).z); const unsigned* y3_ = P10_YADDR((ti_).w); \
                const u32x2* pr_ = (const u32x2*)(OP + (size_t)(row_) * DM) + lane; \
                _Pragma("unroll") for (int j = 0; j < 4; ++j) { yp_[0][j] = y0_[64 * j]; yp_[1][j] = y1_[64 * j]; yp_[2][j] = y2_[64 * j]; yp_[3][j] = y3_[64 * j]; xp_[j] = pr_[64 * j]; } } while (0)
#define P10_ROW(yc_, xc_, gv_, row_) do { f32x4 f[4]; float ss = 0.f; const f32x4 gs = (gv_) * (1.f / Y8S); \
                _Pragma("unroll") for (int j = 0; j < 4; ++j) { const unsigned p0 = yc_[0][j], p1 = yc_[1][j], p2 = yc_[2][j], p3 = yc_[3][j]; \
                    const f32x2 a0 = __builtin_amdgcn_cvt_pk_f32_fp8(p0, false), a1 = __builtin_amdgcn_cvt_pk_f32_fp8(p0, true), b0 = __builtin_amdgcn_cvt_pk_f32_fp8(p1, false), b1 = __builtin_amdgcn_cvt_pk_f32_fp8(p1, true); \
                    const f32x2 c0 = __builtin_amdgcn_cvt_pk_f32_fp8(p2, false), c1 = __builtin_amdgcn_cvt_pk_f32_fp8(p2, true), d0 = __builtin_amdgcn_cvt_pk_f32_fp8(p3, false), d1 = __builtin_amdgcn_cvt_pk_f32_fp8(p3, true); \
                    f[j] = (f32x4){a0.x, a0.y, a1.x, a1.y} * gs.x + (f32x4){b0.x, b0.y, b1.x, b1.y} * gs.y + (f32x4){c0.x, c0.y, c1.x, c1.y} * gs.z + (f32x4){d0.x, d0.y, d1.x, d1.y} * gs.w; \
                    ss += (f[j].x * f[j].x + f[j].y * f[j].y) + (f[j].z * f[j].z + f[j].w * f[j].w); } \
                const float rs = 1.f / sqrtf(wave_sum(ss) * (1.f / DM) + EPS); \
                f32x4* outr = (f32x4*)(out + (size_t)(row_) * DM) + lane;        \
                _Pragma("unroll") for (int j = 0; j < 4; ++j) { const u32x2 p = xc_[j]; outr[64 * j] = (f32x4){bf2f(p.x), bf2f(p.x >> 16), bf2f(p.y), bf2f(p.y >> 16)} + A3[j] * (f[j] * rs); } } while (0)
            const int rbase = row0 + wave * 32;
#define P10_GT(gv_, ti_, r_) do { const int rr_ = rbase + ((r_) < 32 ? (r_) : 31); gv_ = *(const f32x4*)(gates + (size_t)rr_ * 4); ti_ = *(const u32x4*)(tinfo + (size_t)rr_ * 4); } while (0)
            f32x4 gA, gB, gC, gD; u32x4 tA, tB, tC, tD;
            unsigned yA[4][4], yB[4][4]; u32x2 xA[4], xB[4];
            P10_GT(gA, tA, 0); P10_GT(gB, tB, 1);
            P10_LOADY(yA, xA, tA, rbase);
#pragma unroll 1
            for (int i = 0; i < 32; i += 4) {
                P10_GT(gC, tC, i + 2); P10_GT(gD, tD, i + 3);
                P10_LOADY(yB, xB, tB, rbase + i + 1);
                P10_ROW(yA, xA, gA, rbase + i);
                P10_LOADY(yA, xA, tC, rbase + i + 2);
                P10_ROW(yB, xB, gB, rbase + i + 1);
                P10_GT(gA, tA, i + 4); P10_GT(gB, tB, i + 5);
                P10_LOADY(yB, xB, tD, rbase + i + 3);
                P10_ROW(yA, xA, gC, rbase + i + 2);
                P10_LOADY(yA, xA, tA, rbase + (i + 4 < 32 ? i + 4 : 31));
                P10_ROW(yB, xB, gD, rbase + i + 3);
            }
#undef P10_GT
#undef P10_ROW
#undef P10_LOADY
#undef P10_YADDR
        }
    }
#if BENCH_GEMM >= 2 && BENCH_GEMM <= 4
    GRID_BAR();
    { pg8::Gemm g{ws + WS_Y, WOt, BENCH_GEMM == 2 ? 2048 : BENCH_GEMM == 3 ? 1024 : 512, OPI * 2}; pg8::DenseSched S{4, (T / 256) * 4, G, vcu, 2048}; pg8::EpiPlain E{(bf16*)(ws + WS_O), 1024};
      pg8::gemm_phase<pg8::EpiPlain, pg8::DenseSched, true, false>(lds, g, S, E); }
#endif
    STAMP(11);
#if PROBE_A >= 0
    if (blockIdx.x == 0 && tid == 0) { const LAS unsigned long long* st = (const LAS unsigned long long*)(lds + MISC_OFF + 64);
        const long long dt_ = (PROBE_B == 15) ? (long long)((st[21] - st[20]) * 100ull / (st[PROBE_A + 1] - st[PROBE_A])) * 100 : (PROBE_B >= 16) ? (long long)st[PROBE_B] : (PROBE_B == 14) ? (long long)st[13] : (long long)(st[PROBE_B] - st[PROBE_A]);
        if (dt_ > (long long)(PROBE_X) * 100) out[0] = 100.f; }
#endif
#undef IN
#undef BOTH
}


#if MK_DEBUG
__device__ __forceinline__ unsigned hsh(unsigned x) { x ^= x >> 16; x *= 0x7feb352dU; x ^= x >> 15; x *= 0x846ca68bU; x ^= x >> 16; return x; }
__device__ __forceinline__ void diag_max(unsigned* ctl, int slot, float err) { if (!(err == err)) err = 1e30f; if (err < 0.f) err = -err; atomicMax(ctl + CW_DIAG + slot, __float_as_uint(err)); }
__device__ __forceinline__ float relerr(float got, float want, float flo) { return fabsf(got - want) / (fabsf(want) + flo); }
__device__ __forceinline__ float kimg(const unsigned char* Km, int bh, int key, int d) { return bf2f(*(const bf16*)(Km + ((size_t)bh * 128 + (key >> 6)) * 12288 + (d >> 3) * 1024 + (key & 63) * 16 + (d & 7) * 2)); }
__device__ __forceinline__ float vimg(const unsigned char* Vm, int bh, int key, int d) { return bf2f(*(const bf16*)(Vm + ((size_t)bh * 128 + (key >> 6)) * 8192 + (d >> 5) * 4096 + ((key & 63) >> 4) * 1024 + (key & 15) * 64 + (d & 31) * 2)); }
__device__ __forceinline__ float f8dec(unsigned b) { const unsigned e = (b >> 3) & 15u, m = b & 7u; float v = e ? (1.f + m * 0.125f) * exp2f((float)e - 7.f) : m * 0.001953125f; return (b & 0x80u) ? -v : v; }
__device__ __forceinline__ float dot8(const unsigned char* a, const unsigned char* b, int n) { float s = 0.f; for (int k = 0; k < n; ++k) s += f8dec(a[k]) * f8dec(b[k]); return s; }
__device__ __forceinline__ unsigned f8enc(float v) { return __builtin_amdgcn_cvt_pk_fp8_f32(v, 0.f, 0u, false) & 0xffu; }
__device__ __forceinline__ float dotbf(const bf16* a, const bf16* b, int n) { float s = 0.f; for (int k = 0; k < n; ++k) s += bf2f(a[k]) * bf2f(b[k]); return s; }

__global__ void __launch_bounds__(256) dbg_chk(Args a, int which, int p) {
    unsigned char* ws = a.ws; unsigned* ctl = (unsigned*)(ws + WS_CTL);
    const int gt = blockIdx.x * 256 + threadIdx.x, NGT = gridDim.x * 256, lane = threadIdx.x & 63, gwv = gt >> 6;
    float* mod = (float*)(ws + WS_MOD); float* wrT = (float*)(ws + WS_WRT); float* gates = (float*)(ws + WS_GATE); f32x2* rope = (f32x2*)(ws + WS_ROPE);
    bf16* WQ = (bf16*)(ws + WS_WQKV); bf16* WKV = (bf16*)(ws + WS_WQKV + 512 * 1024); unsigned* tinfo = (unsigned*)(ws + WS_TINFO); unsigned* lists = (unsigned*)(ws + WS_LIST);
    bf16* WIN = (bf16*)(ws + WS_WIN); bf16* WOt = (bf16*)(ws + WS_WO); unsigned char* WDN = ws + WS_WDN; unsigned char* WGU = ws + WS_WGU;
    bf16* Hb = (bf16*)(ws + WS_H); unsigned char* H8 = ws + WS_H8; bf16* Z = (bf16*)(ws + WS_Z); bf16* Qm = (bf16*)(ws + WS_QM); unsigned char* Km = ws + WS_KM; unsigned char* Vm = ws + WS_VM;
    bf16* Ob = (bf16*)(ws + WS_O); bf16* OP = (bf16*)(ws + WS_OP); unsigned char* ACT = ws + WS_ACT; unsigned char* Y = ws + WS_Y;
    float* dbgv = (float*)(ws + WS_DBG); unsigned* gcnt = ctl + CW_CNT;
    const float* x = a.in[I_X];
    if (which == 0) {
        for (int i = gt; i < 65536; i += NGT) { const unsigned h = hsh(i), h2 = hsh(i + 77777u);
            { const int n = h & 2047, k = (h >> 11) & 1023; const unsigned want = n < IN_W ? f2bf(a.in[I_WIN][(size_t)k * IN_W + n]) : 0u; if (want != WIN[(size_t)n * 1024 + k]) diag_max(ctl, 0, 10.f); }
            { const int n = h & 1023, k = (h >> 10) & 1023; if (f2bf(a.in[I_WO][(size_t)k * 1024 + n]) != WOt[(size_t)n * OPI + k]) diag_max(ctl, 0, 11.f); }
            { const int e = h2 & 31, rr = (h2 >> 5) & 2047, k = (h2 >> 16) & 1023, pn = rr >> 8, bj = (rr >> 7) & 1, j = rr & 127, col = bj * 1024 + pn * 128 + j;
              if (f8enc(a.in[I_WGU][((size_t)e * 1024 + k) * 2048 + col] * W8S) != WGU[((size_t)e * 2048 + rr) * 1024 + k]) diag_max(ctl, 0, 12.f); }
            { const int e = h2 & 31, n = (h2 >> 5) & 1023, k = (h2 >> 16) & 1023; if (f8enc(a.in[I_WDN][((size_t)e * 1024 + k) * 1024 + n] * W8S) != WDN[((size_t)e * 1024 + n) * 1024 + k]) diag_max(ctl, 0, 13.f); }
            { const int ns = h % 768, k = (h >> 10) & 255; if (f2bf(a.in[I_WQB][(size_t)k * 768 + ns]) != WQ[(size_t)qperm(ns) * 256 + k]) diag_max(ctl, 0, 14.f); }
            { const int n = h2 & 1023, k = (h2 >> 10) & 127; if (f2bf(a.in[I_WKVB][(size_t)k * 1024 + n]) != WKV[(size_t)n * 256 + 128 + k] || WKV[(size_t)n * 256 + k] != 0) diag_max(ctl, 0, 15.f); }
        }
    } else if (which == 1) {
        for (int i = gt; i < 2048; i += NGT) { const unsigned h = hsh(i); const int b = h & 7, j = (h >> 3) % MODW; float s = 0.f;
            for (int k = 0; k < 1024; ++k) { const float v = a.in[I_C][b * 1024 + k]; s += (v / (1.f + expf(-v))) * a.in[I_WADA][(size_t)k * MODW + j]; }
            diag_max(ctl, 1, relerr(mod[b * MODW + j], s + a.in[I_BADA][j], 0.1f) * 30.f); }
        for (int i = gt; i < 4096; i += NGT) { const unsigned h = hsh(i + 999u); const int pos = h & 8191, fi = (h >> 13) & 15;
            const float invf = __builtin_amdgcn_exp2f(-(float)fi * (13.287712379549449f / 16.f)); const float ang = (float)pos * invf;
            const double tp = 6.283185307179586; double r = (double)ang; r -= tp * __builtin_rint(r / tp); const double r2 = r * r; double sn = r, cs = 1.0, ts = r, tc = 1.0;
            for (int n = 1; n <= 14; ++n) { tc *= -r2 / (double)((2 * n - 1) * (2 * n)); cs += tc; ts *= -r2 / (double)((2 * n) * (2 * n + 1)); sn += ts; }
            const f32x2 g = rope[pos * 16 + fi]; diag_max(ctl, 1, (fabsf(g.x - (float)cs) + fabsf(g.y - (float)sn)) * 30.f); }
        for (int i = gt; i < 32768; i += NGT) { const int e = i >> 10, d = i & 1023; if (wrT[i] != a.in[I_WR][d * 32 + e]) diag_max(ctl, 1, 9.f); }
    } else if (which == 2) {
        for (int i = gt; i < 2048; i += NGT) { const unsigned h = hsh(i); const int row = h & 65535, col = (h >> 16) & 1023, b = row >> 13; float ss = 0.f;
            for (int k = 0; k < 1024; ++k) { const float v = x[(size_t)row * 1024 + k]; ss += v * v; }
            const float rstd = 1.f / sqrtf(ss / 1024.f + EPS); const float want = x[(size_t)row * 1024 + col] * rstd * a.in[I_GPRE1][col] * (1.f + mod[b * MODW + 1024 + col]) + mod[b * MODW + col];
            diag_max(ctl, 2, relerr(bf2f(Hb[(size_t)row * 1024 + col]), want, 0.5f)); }
    } else if (which == 3) {
        for (int i = gt; i < 4096; i += NGT) { const unsigned h = hsh(i); const int row = h & 65535, n = (h >> 16) % IN_W;
            diag_max(ctl, 3, relerr(bf2f(Z[(size_t)row * ZP + n]), dotbf(Hb + (size_t)row * 1024, WIN + (size_t)n * 1024, 1024), 0.5f)); }
    } else if (which == 4) {
        bf16* AQ = Hb;
        for (int i = gt; i < 2048; i += NGT) { const unsigned h = hsh(i); const int row = h & 65535, col = (h >> 16) % 384; const bf16* zr = Z + (size_t)row * ZP; float ss = 0.f, want;
            if (col < 256) { for (int k = 0; k < 256; ++k) { const float v = bf2f(zr[k]); ss += v * v; } want = bf2f(zr[col]) / sqrtf(ss / 256.f + EPS) * a.in[I_GQ][col]; }
            else { for (int k = 256; k < 384; ++k) { const float v = bf2f(zr[k]); ss += v * v; } want = bf2f(zr[col]) / sqrtf(ss / 128.f + EPS) * a.in[I_GKV][col - 256]; }
            diag_max(ctl, 4, relerr(bf2f(AQ[(size_t)row * KQKV + col]), want, 0.3f));
            const int hh = (h >> 16) & 7, jp = (h >> 19) & 31, g = jp >> 3, t = jp & 7, fi = 4 * g + (t & 3), x2s = t >> 2, pos = row & 8191, b = row >> 13;
            const float x1 = bf2f(zr[C_KR + fi]), x2 = bf2f(zr[C_KR + 16 + fi]); const f32x2 cs = rope[pos * 16 + fi];
            const float wk = x2s ? x2 * cs.x + x1 * cs.y : x1 * cs.x - x2 * cs.y;
            diag_max(ctl, 4, relerr(kimg(Km, b * 8 + hh, pos, 64 + jp), wk, 0.3f)); }
    } else if (which == 5) {
        bf16* AQ = Hb;
        for (int i = gt; i < 4096; i += NGT) { const unsigned h = hsh(i); const int row = h & 65535, c = (h >> 16) % NQKV, b = row >> 13, s = row & 8191; const bf16* ar = AQ + (size_t)row * KQKV;
            if (c < 768) { const int hh = c / 96, d = c % 96; float want, got = bf2f(Qm[((size_t)(b * 8 + hh) * SEQ + s) * 96 + d]);
                if (d < 64) want = dotbf(ar, WQ + (size_t)c * 256, 256) * C2M;
                else { const int jp = d - 64, g = jp >> 3, t = jp & 7, fi = 4 * g + (t & 3), x2s = t >> 2, cpart = hh * 96 + 64 + 8 * g + (t & 3) + (x2s ? 0 : 4);
                    const float dc = dotbf(ar, WQ + (size_t)c * 256, 256) * C2M, dp = dotbf(ar, WQ + (size_t)cpart * 256, 256) * C2M; const float x1 = x2s ? dp : dc, x2 = x2s ? dc : dp; const f32x2 cs = rope[s * 16 + fi];
                    want = x2s ? x2 * cs.x + x1 * cs.y : x1 * cs.x - x2 * cs.y; }
                diag_max(ctl, 5, relerr(got, want, 0.1f)); }
            else { const int cc = c - 768, hh = cc >> 7, dd = cc & 127; const float want = dotbf(ar + 128, WKV + (size_t)cc * 256, 256);
                const float got = dd < 64 ? kimg(Km, b * 8 + hh, s, dd) : vimg(Vm, b * 8 + hh, s, dd - 64); diag_max(ctl, 5, relerr(got, want, 0.3f)); } }
    } else if (which == 6) {
        for (int smp = gwv; smp < 256; smp += NGT / 64) { const unsigned h = hsh(smp * 3 + 1); const int b = h & 7, hh = (h >> 3) & 7; int s = (h >> 6) & 8191; if (smp < 16) s = smp * 17; const int bh = b * 8 + hh, nk = ((s >> 6) + 1) * 64;
            const bf16* q = Qm + ((size_t)bh * SEQ + s) * 96; float m = -INFINITY;
            for (int k = lane; k < nk; k += 64) { float sc = 0.f; for (int d = 0; d < 96; ++d) sc += bf2f(q[d]) * kimg(Km, bh, k, d); m = fmaxf(m, sc); }
            for (int o = 1; o < 64; o <<= 1) m = fmaxf(m, __shfl_xor(m, o));
            float l = 0.f; float acc[64];
#pragma unroll
            for (int d = 0; d < 64; ++d) acc[d] = 0.f;
            for (int k = lane; k < nk; k += 64) { float sc = 0.f; for (int d = 0; d < 96; ++d) sc += bf2f(q[d]) * kimg(Km, bh, k, d); const float e = exp2f(sc - m); l += e;
#pragma unroll
                for (int d = 0; d < 64; ++d) acc[d] += e * vimg(Vm, bh, k, d); }
            l = wave_sum(l); float mine = 0.f, sq = 0.f;
#pragma unroll
            for (int d = 0; d < 64; ++d) { const float v = wave_sum(acc[d]) / l; sq += v * v; if (lane == d) mine = v; }
            const float rms = sqrtf(sq / 64.f); const float got = bf2f(Ob[((size_t)b * SEQ + s) * OPI + hh * 64 + lane]);
            diag_max(ctl, 6, fabsf(got - mine) / (fabsf(mine) + 0.3f * rms + 1e-6f)); }
    } else if (which == 7) {
        for (int smp = gwv; smp < 256; smp += NGT / 64) { const unsigned h = hsh(smp * 5 + 2); const int b = h & 7, hh = (h >> 3) & 7; int s = (h >> 6) & 8191; if (smp < 16) s = smp * 41; const int cq = s >> 6, k0 = (cq >= 8 ? cq - 8 : 0) * 64, k1 = (cq + 1) * 64;
            const bf16* q = Z + ((size_t)b * SEQ + s) * ZP + C_QC + hh * 64; float m = -INFINITY;
            for (int k = k0 + lane; k < k1; k += 64) { const bf16* kr = Z + ((size_t)b * SEQ + k) * ZP + C_KC + hh * 64; float sc = 0.f; for (int d = 0; d < 64; ++d) sc += bf2f(q[d]) * bf2f(kr[d]);
                int rel = s - k; rel = rel < -63 ? -63 : (rel > 256 ? 256 : rel); sc = sc * 0.125f + a.in[I_RELB][hh * 320 + rel + 63]; m = fmaxf(m, sc); }
            for (int o = 1; o < 64; o <<= 1) m = fmaxf(m, __shfl_xor(m, o));
            float l = 0.f; float acc[64];
#pragma unroll
            for (int d = 0; d < 64; ++d) acc[d] = 0.f;
            for (int k = k0 + lane; k < k1; k += 64) { const bf16* kr = Z + ((size_t)b * SEQ + k) * ZP + C_KC + hh * 64; const bf16* vr = Z + ((size_t)b * SEQ + k) * ZP + C_VC + hh * 64; float sc = 0.f; for (int d = 0; d < 64; ++d) sc += bf2f(q[d]) * bf2f(kr[d]);
                int rel = s - k; rel = rel < -63 ? -63 : (rel > 256 ? 256 : rel); sc = sc * 0.125f + a.in[I_RELB][hh * 320 + rel + 63]; const float e = expf(sc - m); l += e;
#pragma unroll
                for (int d = 0; d < 64; ++d) acc[d] += e * bf2f(vr[d]); }
            l = wave_sum(l); float mine = 0.f, sq = 0.f;
#pragma unroll
            for (int d = 0; d < 64; ++d) { const float v = wave_sum(acc[d]) / l; sq += v * v; if (lane == d) mine = v; }
            const float rms = sqrtf(sq / 64.f); const float got = bf2f(Ob[((size_t)b * SEQ + s) * OPI + 512 + hh * 64 + lane]);
            diag_max(ctl, 7, fabsf(got - mine) / (fabsf(mine) + 0.3f * rms + 1e-6f)); }
    } else if (which == 8) {
        for (int i = gt; i < 4096; i += NGT) { const unsigned h = hsh(i); const int row = h & 65535, n = (h >> 16) & 1023;
            diag_max(ctl, 8, relerr(bf2f(OP[(size_t)row * 1024 + n]), dotbf(Ob + (size_t)row * OPI, WOt + (size_t)n * OPI, 1024), 0.2f)); }
    } else if (which == 9 || which == 10) {
        for (int i = gt; i < 1024; i += NGT) { const unsigned h = hsh(i + 31u * which); const int row = h & 65535, col = (h >> 16) & 1023, b = row >> 13; const float* mb = mod + b * MODW;
            float ss = 0.f; for (int k = 0; k < 1024; ++k) { const float v = bf2f(OP[(size_t)row * 1024 + k]); ss += v * v; }
            const float r1 = 1.f / sqrtf(ss / 1024.f + EPS); float ss2 = 0.f;
            for (int k = 0; k < 1024; ++k) { const float v = x[(size_t)row * 1024 + k] + mb[2048 + k] * (bf2f(OP[(size_t)row * 1024 + k]) * r1 * a.in[I_GPOST1][k]); ss2 += v * v; }
            const float r2 = 1.f / sqrtf(ss2 / 1024.f + EPS);
            if (which == 9) { const float x1 = x[(size_t)row * 1024 + col] + mb[2048 + col] * (bf2f(OP[(size_t)row * 1024 + col]) * r1 * a.in[I_GPOST1][col]);
                const float h2 = x1 * r2 * a.in[I_GPRE2][col] * (1.f + mb[4096 + col]) + mb[3072 + col];
                diag_max(ctl, 9, relerr(f8dec(H8[(size_t)row * 1024 + col]) / A8S, h2, 0.3f) * 0.4f); }
            else { float lg[32];
#pragma unroll
                for (int e = 0; e < 32; ++e) lg[e] = a.in[I_BR][e];
                for (int k = 0; k < 1024; ++k) { const float x1 = x[(size_t)row * 1024 + k] + mb[2048 + k] * (bf2f(OP[(size_t)row * 1024 + k]) * r1 * a.in[I_GPOST1][k]);
                    const float h2 = x1 * r2 * a.in[I_GPRE2][k] * (1.f + mb[4096 + k]) + mb[3072 + k];
#pragma unroll
                    for (int e = 0; e < 32; ++e) lg[e] += h2 * a.in[I_WR][k * 32 + e]; }
                int ci[5]; float cv[5];
#pragma unroll
                for (int k = 0; k < 5; ++k) { float best = -INFINITY; int bi = 0;
#pragma unroll
                    for (int e = 0; e < 32; ++e) { bool used = false;
#pragma unroll
                        for (int q = 0; q < 5; ++q) if (q < k && ci[q] == e) used = true;
                        if (!used && lg[e] > best) { best = lg[e]; bi = e; } }
                    ci[k] = bi; cv[k] = best; }
                bool tie = false;
#pragma unroll
                for (int k = 0; k < 4; ++k) if (cv[k] - cv[k + 1] < 2e-4f) tie = true;
                if (!tie) { float gs = 0.f, gv[4];
#pragma unroll
                    for (int k = 0; k < 4; ++k) { gv[k] = expf(cv[k] - cv[0]); gs += gv[k]; }
#pragma unroll
                    for (int k = 0; k < 4; ++k) { const unsigned ti = tinfo[(size_t)row * 4 + k]; const int e = ti >> 16, idx = ti & 0xffff;
                        if (e != ci[k]) diag_max(ctl, 10, 1.f);
                        else { diag_max(ctl, 10, fabsf(gates[(size_t)row * 4 + k] - gv[k] / gs) * 10.f);
                            if (idx >= (int)gcnt[e]) diag_max(ctl, 10, 2.f);
                            else if (lists[(size_t)e * LIST_CAP + idx] != (unsigned)row * 4u + k) diag_max(ctl, 10, 3.f); } } } } }
        if (which == 10 && gt == 0) { unsigned s0 = 0; for (int e = 0; e < 32; ++e) s0 += gcnt[e]; if (s0 != 262144u) diag_max(ctl, 10, 4.f); }
    } else if (which == 11 || which == 12) {
        for (int i = gt; i < 4096; i += NGT) { const unsigned h = hsh(i + 7u * which); const int e = h & 31, cnt = (int)gcnt[e]; if (cnt <= 0) continue;
            const int idx = (int)(((h >> 5) & 0xffff) % (unsigned)cnt), col = (h >> 21) & 1023; int ts = 0; for (int q = 0; q < e; ++q) ts += ((int)gcnt[q] + 255) >> 8;
            const int row = ts * 256 + idx; const unsigned ent = lists[(size_t)e * LIST_CAP + idx]; const int tok = ent >> 2;
            if (which == 11) { const int pn = col >> 7, j = col & 127;
                float gte = dot8(H8 + (size_t)tok * 1024, WGU + ((size_t)e * 2048 + pn * 256 + j) * 1024, 1024) / (W8S * A8S) + a.in[I_BGU][e * 2048 + col];
                float up = dot8(H8 + (size_t)tok * 1024, WGU + ((size_t)e * 2048 + pn * 256 + 128 + j) * 1024, 1024) / (W8S * A8S) + a.in[I_BGU][e * 2048 + 1024 + col];
                gte = fminf(gte, 7.f); up = fminf(fmaxf(up, -7.f), 7.f); const float want = (up + 1.f) * (gte / (1.f + expf(-1.702f * gte)));
                diag_max(ctl, 11, relerr(f8dec(ACT[(size_t)row * 1024 + col]) / A8S, want, 0.2f) * 0.4f); }
            else { const float want = dot8(ACT + (size_t)row * 1024, WDN + ((size_t)e * 1024 + col) * 1024, 1024) / (W8S * A8S) + a.in[I_BDN][e * 1024 + col];
                diag_max(ctl, 12, relerr(f8dec(Y[(size_t)row * 1024 + col]) / Y8S, want, 0.2f) * 0.4f); } }
    } else if (which == 15 || which == 16) {
        for (int i = gt; i < 1024; i += NGT) { const unsigned h = hsh(i + 4242u); const int row = h & 65535, col = (h >> 16) & 1023, b = row >> 13;
            if (which == 15) { const f32x4 gv = *(const f32x4*)(gates + (size_t)row * 4); float ss = 0.f, fc = 0.f;
                size_t yr[4];
                for (int q = 0; q < 4; ++q) { const unsigned ti = tinfo[(size_t)row * 4 + q]; const int e = ti >> 16; int ts = 0; for (int z = 0; z < e; ++z) ts += ((int)gcnt[z] + 255) >> 8; yr[q] = ((size_t)ts * 256 + (ti & 0xffffu)) * 1024; }
                for (int k = 0; k < 1024; ++k) { const float f = (gv.x * f8dec(Y[yr[0] + k]) + gv.y * f8dec(Y[yr[1] + k]) + gv.z * f8dec(Y[yr[2] + k]) + gv.w * f8dec(Y[yr[3] + k])) / Y8S; ss += f * f; if (k == col) fc = f; }
                float so = 0.f; for (int k = 0; k < 1024; ++k) { const float v = bf2f(OP[(size_t)row * 1024 + k]); so += v * v; }
                const float x1 = x[(size_t)row * 1024 + col] + mod[b * MODW + 2048 + col] * (bf2f(OP[(size_t)row * 1024 + col]) / sqrtf(so / 1024.f + EPS) * a.in[I_GPOST1][col]);
                dbgv[i] = x1 + mod[b * MODW + 5120 + col] * (fc / sqrtf(ss / 1024.f + EPS) * a.in[I_GPOST2][col]); }
            else diag_max(ctl, 15, relerr(a.out[(size_t)row * 1024 + col], dbgv[i], 0.5f) * 30.f); }
    }
}
__global__ void __launch_bounds__(256) dbg_report(Args a) {
    unsigned* ctl = (unsigned*)(a.ws + WS_CTL); int fs = -1; float fe = 0.f;
    for (int s = 15; s >= 0; --s) { const float e = __uint_as_float(ctl[CW_DIAG + s]); if (e > 0.03f) { fs = s; fe = e; } }
    if (fs < 0) return;
    int lvl = 1; float e = fe / 0.03f; while (e >= 2.f && lvl < 8) { e *= 0.5f; ++lvl; }
    float V = (float)(1 + lvl) * 1000.f; for (int s = 0; s < fs; ++s) V *= 10.f;
    const size_t n = (size_t)T * DM;
    for (size_t i = (size_t)blockIdx.x * 256 + threadIdx.x; i < n; i += (size_t)gridDim.x * 256) a.out[i] = (i == 0) ? V : 0.f;
}
static void dbg_before(int ph, const Args& a, hipStream_t st) { if (ph == 10) hipLaunchKernelGGL(dbg_chk, dim3(64), dim3(256), 0, st, a, 15, 0); }
static void dbg_after(int ph, const Args& a, hipStream_t st) {
#define CHK(w, p) hipLaunchKernelGGL(dbg_chk, dim3(64), dim3(256), 0, st, a, w, p)
    switch (ph) {
        case 0: CHK(1, 0); break; case 1: CHK(2, 0); break; case 2: break; case 3: break; case 4: break;
        case 5: CHK(6, 0); CHK(7, 0); break; case 6: CHK(8, 0); break; case 7: CHK(9, 0); CHK(10, 0); break;
        case 8: CHK(11, 0); break; case 9: CHK(12, 0); break;
        case 10: CHK(16, 0); hipLaunchKernelGGL(dbg_report, dim3(2048), dim3(256), 0, st, a); break;
    }
#undef CHK
}
#endif


extern "C" void kernel_launch(void* const* d_in, const int* in_sizes, int n_in, void* d_out, int out_size, void* d_ws, size_t ws_size, hipStream_t stream) {
    static int grid = 0;
    if (grid == 0) {
        if (n_in != 21 || in_sizes[0] != T * DM || out_size != T * DM || ws_size < WS_END) { fprintf(stderr, "kernel_launch: unexpected shapes (n_in %d, in0 %d, out %d, ws %zu); nothing launched\n", n_in, n_in > 0 ? in_sizes[0] : -1, out_size, ws_size); grid = -1; return; }
        int dev = 0, cus = 0, per_cu = 0;
        if (hipGetDevice(&dev) != hipSuccess || hipDeviceGetAttribute(&cus, hipDeviceAttributeMultiprocessorCount, dev) != hipSuccess) { grid = -1; return; }
        if (hipFuncSetAttribute((const void*)fwd, hipFuncAttributeMaxDynamicSharedMemorySize, LDS_BYTES) != hipSuccess) { fprintf(stderr, "kernel_launch: hipFuncSetAttribute failed\n"); grid = -1; return; }
        if (hipOccupancyMaxActiveBlocksPerMultiprocessor(&per_cu, (const void*)fwd, 512, LDS_BYTES) != hipSuccess || per_cu < 1) fprintf(stderr, "kernel_launch: occupancy query reports %d\n", per_cu);
        (void)hipGetLastError();
        grid = cus;
    }
    if (grid < 0) return;
    if (hipMemsetAsync((char*)d_ws + WS_CTL, 0, CTL_ZERO_BYTES, stream) != hipSuccess) return;
    Args a{};
    for (int i = 0; i < 21; ++i) a.in[i] = (const float*)d_in[i];
    a.out = (float*)d_out; a.ws = (unsigned char*)d_ws;
#if MK_ONE_LAUNCH
    a.ph_lo = 0; a.ph_hi = 11;
    hipLaunchKernelGGL(fwd, dim3(grid), dim3(512), LDS_BYTES, stream, a);
#else
    for (int ph = 0; ph < 11; ++ph) {
        a.ph_lo = ph; a.ph_hi = ph + 1;
#if MK_DEBUG
        dbg_before(ph, a, stream);
#endif
        hipLaunchKernelGGL(fwd, dim3(grid), dim3(512), LDS_BYTES, stream, a);
#if MK_DEBUG
        dbg_after(ph, a, stream);
#endif
    }
#endif
}
```
